# Optimizing an MI355X kernel written in HIP

```python
import jax, jax.numpy as jnp
from jax import lax
import numpy as np

D_MODEL = 1024
BATCH = 16
SEQ = 256
DEPTH = 1
DEC_BATCH = 4
DEC_SEQ = 2048
PAST_LEN = 512

GRID_W = 64
N_HEADS = 16
HEAD_DIM = D_MODEL // N_HEADS
D_RWKV = N_HEADS * HEAD_DIM
D_POOL = D_MODEL // 2
N_POOL_GROUPS = 4
POOL_GROUP = D_POOL // N_POOL_GROUPS
POOL_OUT_GROUP = D_MODEL // N_POOL_GROUPS
POOL_WINDOWS = (2, 4, 8, 16)
D_FF = 4 * D_MODEL
DECAY_LORA = 64
AAA_LORA = 64
GATE_LORA = 128
N_DIR = 2
N_MOD = 6
D_IN = D_POOL + 3 * D_RWKV + 2 * D_MODEL
RMS_EPS = 1e-6
LNX_EPS = 64e-5
NORM_EPS = 1e-12

kernel_name = "hybrid_pool_rwkv7_diffusion_step"

LAYER_KEYS = ("w_ada", "b_ada", "g_norm1", "g_norm2", "w_in", "mu_rkv", "mu_wag",
              "w_dec0", "w_dec1", "w_dec2", "a0", "a1", "a2", "gate_w1", "gate_w2",
              "k_k", "k_a", "r_k", "ln_x_w", "ln_x_b", "pool_w", "pool_scale",
              "w_out", "w_ff1", "w_ff2")


def rmsnorm(x, g):
    xf = x.astype(jnp.float32)
    y = xf * lax.rsqrt(jnp.mean(xf * xf, axis=-1, keepdims=True) + RMS_EPS)
    return (y * g.astype(jnp.float32)).astype(x.dtype)


def centred_shift(x):
    prev = jnp.pad(x[:, :-1], ((0, 0), (1, 0), (0, 0)))
    nxt = jnp.pad(x[:, 1:], ((0, 0), (0, 1), (0, 0)))
    return 0.5 * (prev + nxt)


def window_mean(z, window):
    lr = z.shape[2]
    cs = jnp.cumsum(z.astype(jnp.float32), axis=2)
    cs = jnp.pad(cs, ((0, 0), (0, 0), (1, 0), (0, 0)))
    t = jnp.arange(lr)
    lo = jnp.clip(t - window // 2, 0, lr)
    hi = jnp.clip(t + window - window // 2, 0, lr)
    total = jnp.take(cs, hi, axis=2) - jnp.take(cs, lo, axis=2)
    cnt = (hi - lo).astype(jnp.float32)[:, None]
    return (total / cnt).astype(z.dtype)


def pool_branch(z, rows, pool_w, pool_scale):
    b, l, _ = z.shape
    zr = z.reshape(b, rows, l // rows, N_POOL_GROUPS, POOL_GROUP)
    outs = []
    for g, win in enumerate(POOL_WINDOWS):
        zg = zr[..., g, :]
        mixed = window_mean(zg, win) - zg
        outs.append(jnp.einsum('brtc,cd->brtd', mixed, pool_w[g]))
    out = jnp.concatenate(outs, axis=-1).reshape(b, l, D_MODEL)
    return out * pool_scale


def wkv_scan(r, w, k, v, kk, a, s0, reverse):
    b, l, _ = r.shape

    def heads(t):
        return jnp.transpose(t.astype(jnp.float32).reshape(b, l, N_HEADS, HEAD_DIM), (1, 0, 2, 3))

    xs = (heads(r), heads(w), heads(k), heads(v), heads(kk), heads(a))

    def step(S, inp):
        r_t, w_t, k_t, v_t, kk_t, a_t = inp
        s_kk = jnp.einsum('bhij,bhj->bhi', S, kk_t)
        S = (S * w_t[:, :, None, :]
             - s_kk[..., :, None] * (kk_t * a_t)[..., None, :]
             + v_t[..., :, None] * k_t[..., None, :])
        y_t = jnp.einsum('bhij,bhj->bhi', S, r_t)
        return S, y_t

    s_final, ys = lax.scan(step, s0.astype(jnp.float32), xs, reverse=reverse)
    return jnp.transpose(ys, (1, 0, 2, 3)).reshape(b, l, D_RWKV), s_final


def rwkv_branch(h, rkv, s0_fwd, s0_bwd, p):
    b, l, _ = h.shape
    f32 = jnp.float32
    rkv = rkv + (centred_shift(rkv) - rkv) * p["mu_rkv"].reshape(-1)
    r, k, v = jnp.split(rkv, 3, axis=-1)
    hd = centred_shift(h) - h
    xw = h + hd * p["mu_wag"][0]
    xa = h + hd * p["mu_wag"][1]
    xg = h + hd * p["mu_wag"][2]
    g = jax.nn.sigmoid(xg @ p["gate_w1"]) @ p["gate_w2"]
    kk = (k * p["k_k"]).astype(f32).reshape(b, l, N_HEADS, HEAD_DIM)
    kk = (kk * lax.rsqrt(jnp.sum(kk * kk, axis=-1, keepdims=True) + NORM_EPS)).reshape(b, l, D_RWKV)
    s0 = (s0_fwd, s0_bwd)
    ys, states = [], []
    for d in range(N_DIR):
        pre_w = (p["w_dec0"][d] + jnp.tanh(xw @ p["w_dec1"][d]) @ p["w_dec2"][d]).astype(f32)
        decay = jnp.exp(-jnp.exp(-jax.nn.softplus(-pre_w) - 0.5))
        a = jax.nn.sigmoid((p["a0"][d] + (xa @ p["a1"][d]) @ p["a2"][d]).astype(f32))
        kd = k * (1.0 + (a - 1.0) * p["k_a"])
        y_d, s_d = wkv_scan(r, decay, kd, v, kk, a, s0[d], reverse=(d == 1))
        ys.append(y_d)
        states.append(s_d)
    y = (ys[0] + ys[1]).reshape(b, l, N_HEADS, HEAD_DIM)
    mu = jnp.mean(y, axis=-1, keepdims=True)
    var = jnp.mean(jnp.square(y - mu), axis=-1, keepdims=True)
    y = ((y - mu) * lax.rsqrt(var + LNX_EPS)).reshape(b, l, D_RWKV) * p["ln_x_w"] + p["ln_x_b"]
    bonus = jnp.sum((r * k * p["r_k"].reshape(-1)).astype(f32).reshape(b, l, N_HEADS, HEAD_DIM),
                    axis=-1, keepdims=True) * v.astype(f32).reshape(b, l, N_HEADS, HEAD_DIM)
    y = y + bonus.reshape(b, l, D_RWKV)
    return (y * g).astype(h.dtype), states[0], states[1]


def mixer(h, s0_fwd, s0_bwd, rows, p):
    z = h @ p["w_in"]
    z_pool = z[..., :D_POOL]
    rkv = z[..., D_POOL:D_POOL + 3 * D_RWKV]
    gate_logits = z[..., D_POOL + 3 * D_RWKV:]
    a_out = pool_branch(z_pool, rows, p["pool_w"], p["pool_scale"])
    b_out, s_fwd, s_bwd = rwkv_branch(h, rkv, s0_fwd, s0_bwd, p)
    gate_a, gate_b = jnp.split(jax.nn.sigmoid(gate_logits), 2, axis=-1)
    out = (gate_a * a_out + gate_b * b_out) @ p["w_out"]
    return out, s_fwd, s_bwd


def layer(x, cvec, s0_fwd, s0_bwd, rows, p):
    mod = jax.nn.silu(cvec) @ p["w_ada"] + p["b_ada"]
    sh1, sc1, ga1, sh2, sc2, ga2 = jnp.split(mod[:, None, :], N_MOD, axis=-1)
    h = rmsnorm(x, p["g_norm1"]) * (1.0 + sc1) + sh1
    mix, s_fwd, s_bwd = mixer(h, s0_fwd, s0_bwd, rows, p)
    x = x + ga1 * mix
    h2 = rmsnorm(x, p["g_norm2"]) * (1.0 + sc2) + sh2
    ff = jnp.square(jax.nn.relu(h2 @ p["w_ff1"])) @ p["w_ff2"]
    x = x + ga2 * ff
    return x, s_fwd, s_bwd


def setup_inputs(seed: int = 0) -> dict:
    key = jax.random.key(seed)
    ks = iter(jax.random.split(key, 40))
    L = DEPTH
    D = D_MODEL

    def nrm(shape, scale):
        return scale * jax.random.normal(next(ks), shape, jnp.float32)

    def uni(shape, lo, hi):
        return jax.random.uniform(next(ks), shape, jnp.float32, lo, hi)

    return {
        "x_prompt": nrm((BATCH, SEQ, D), 1.0),
        "x_sample": nrm((DEC_BATCH, DEC_SEQ, D), 1.0),
        "state_rwkv": nrm((DEC_BATCH, DEPTH, N_DIR, N_HEADS, HEAD_DIM, HEAD_DIM), 0.5),
        "c": nrm((DEC_BATCH, D), 1.0),
        "c_ctx": nrm((D,), 1.0),
        "w_ada": nrm((L, D, N_MOD * D), 0.5 * D ** -0.5),
        "b_ada": nrm((L, N_MOD * D), 0.02),
        "g_norm1": 1.0 + nrm((L, D), 0.05),
        "g_norm2": 1.0 + nrm((L, D), 0.05),
        "w_in": nrm((L, D, D_IN), D ** -0.5),
        "mu_rkv": uni((L, 3, D_RWKV), 0.0, 1.0),
        "mu_wag": uni((L, 3, D), 0.0, 1.0),
        "w_dec0": uni((L, N_DIR, D_RWKV), -4.0, -1.0),
        "w_dec1": nrm((L, N_DIR, D, DECAY_LORA), D ** -0.5),
        "w_dec2": nrm((L, N_DIR, DECAY_LORA, D_RWKV), 0.5 * DECAY_LORA ** -0.5),
        "a0": nrm((L, N_DIR, D_RWKV), 0.5),
        "a1": nrm((L, N_DIR, D, AAA_LORA), D ** -0.5),
        "a2": nrm((L, N_DIR, AAA_LORA, D_RWKV), 0.5 * AAA_LORA ** -0.5),
        "gate_w1": nrm((L, D, GATE_LORA), D ** -0.5),
        "gate_w2": nrm((L, GATE_LORA, D_RWKV), GATE_LORA ** -0.5),
        "k_k": 0.85 + nrm((L, D_RWKV), 0.05),
        "k_a": 1.0 + nrm((L, D_RWKV), 0.05),
        "r_k": nrm((L, N_HEADS, HEAD_DIM), 0.1),
        "ln_x_w": 1.0 + nrm((L, D_RWKV), 0.05),
        "ln_x_b": nrm((L, D_RWKV), 0.02),
        "pool_w": nrm((L, N_POOL_GROUPS, POOL_GROUP, POOL_OUT_GROUP), POOL_GROUP ** -0.5),
        "pool_scale": 0.5 + nrm((L, D), 0.05),
        "w_out": nrm((L, D, D), D ** -0.5),
        "w_ff1": nrm((L, D, D_FF), D ** -0.5),
        "w_ff2": nrm((L, D_FF, D), D_FF ** -0.5),
        "g_final": 1.0 + nrm((D,), 0.05),
    }


def reference(x_prompt, x_sample, state_rwkv, c, c_ctx, w_ada, b_ada, g_norm1, g_norm2, w_in,
              mu_rkv, mu_wag, w_dec0, w_dec1, w_dec2, a0, a1, a2, gate_w1, gate_w2, k_k, k_a,
              r_k, ln_x_w, ln_x_b, pool_w, pool_scale, w_out, w_ff1, w_ff2, g_final):
    weights = (w_ada, b_ada, g_norm1, g_norm2, w_in, mu_rkv, mu_wag, w_dec0, w_dec1, w_dec2,
               a0, a1, a2, gate_w1, gate_w2, k_k, k_a, r_k, ln_x_w, ln_x_b, pool_w, pool_scale,
               w_out, w_ff1, w_ff2)
    rows = x_sample.shape[1] // GRID_W
    zero_state = jnp.zeros((x_prompt.shape[0], N_HEADS, HEAD_DIM, HEAD_DIM), jnp.float32)
    cvec_ctx = c_ctx[None, :]
    ctx = x_prompt
    lat = x_sample
    new_states = []
    for li in range(DEPTH):
        p = dict(zip(LAYER_KEYS, (w[li] for w in weights)))
        ctx, sf, sb = layer(ctx, cvec_ctx, zero_state, zero_state, 1, p)
        new_states.append(jnp.stack([sf, sb], axis=1))
        lat, _, _ = layer(lat, c, state_rwkv[:, li, 0], state_rwkv[:, li, 1], rows, p)
    y_prompt = rmsnorm(ctx, g_final)
    y_sample = rmsnorm(lat, g_final)
    state_rwkv_new = jnp.stack(new_states, axis=1)
    return (y_prompt, y_sample, state_rwkv_new)
```

```cpp
#include <hip/hip_runtime.h>
#include <cstdio>
#include <cstdint>
namespace pg8 {
#define PG8_LAS __attribute__((address_space(3)))
typedef unsigned short bf16_t;
typedef short bf16x8 __attribute__((ext_vector_type(8)));
typedef float f32x4 __attribute__((ext_vector_type(4)));
typedef unsigned u32x4 __attribute__((ext_vector_type(4)));
constexpr int BM = 256, BK = 64, HALF = 128, HTB = HALF * BK * 2  , STAGE_BYTES = 8 * HTB, NXCD = 8, WGM = 8;

__host__ __device__ __forceinline__ int lds_byte(int r, int c) { const int st = (r >> 4) * 2 + (c >> 5), rr = r & 15, cc = c & 31, ob = rr * 64 + cc * 2; return st * 1024 + (ob ^ (((ob >> 9) & 1) << 5)); }
__host__ __device__ __forceinline__ void stage_rc(int b, int& R, int& C) { const int st = b / 1024, sb = b % 1024, swz = sb ^ (((sb >> 9) & 1) << 5); R = (st >> 1) * 16 + swz / 64; C = (st & 1) * 32 + (swz % 64) / 2; }
__host__ __device__ __forceinline__ int perm32(int rho) { const int n = rho >> 4, i = rho & 15; return 8 * (i >> 2) + 4 * n + (i & 3); }

struct Unit { int pm, pn; };
struct Gemm { const bf16_t* A; const bf16_t* Bt; int M, N, K; };

struct StaticOrder {
    int nM, nN, nwg, G, c;
    __host__ __device__ void init(int M, int N, int G_, int c_) { nM = M / BM; nN = N / BM; nwg = nM * nN; G = G_; c = c_; }
    __host__ __device__ bool next(int i, Unit& u) const {
        const long L = (long)i * G + c; if (L >= nwg) return false;
        int wgid = (int)L; { const int q = nwg / NXCD, r = nwg % NXCD, xcd = wgid % NXCD, off = wgid / NXCD; wgid = (xcd < r ? xcd * (q + 1) : r * (q + 1) + (xcd - r) * q) + off; }
        const int nig = WGM * nN, gid = wgid / nig, fm = gid * WGM, gsz = (nM - fm) < WGM ? (nM - fm) : WGM;
        u.pm = fm + ((wgid % nig) % gsz); u.pn = (wgid % nig) / gsz; return true;
    }
    __device__ __forceinline__ void a_ready(const Unit&) const {}
    __device__ __forceinline__ void done(const Unit&) const {}
};

__device__ __forceinline__ unsigned cvt_pk_bf16(float lo, float hi) { unsigned r; asm volatile("v_cvt_pk_bf16_f32 %0, %1, %2" : "=v"(r) : "v"(lo), "v"(hi)); return r; }
typedef float f32x2 __attribute__((ext_vector_type(2)));
template <class Epi, class Sched, bool ALIGN_EPI = false, bool SP2 = false>
__device__ __forceinline__ void gemm_phase(PG8_LAS unsigned char* lds, const Gemm g, const Sched& S, const Epi& E) {
    const int tid = threadIdx.x, wid = __builtin_amdgcn_readfirstlane(tid >> 6), lane = tid & 63, wr = wid >> 2, wc = wid & 3, fr = lane & 15, fq = lane >> 4;
    const int K = g.K, nt = K / BK;
    unsigned voffA[2], voffB[2];
#pragma unroll
    for (int i = 0; i < 2; ++i) { int R, C; stage_rc(tid * 16 + i * 8192, R, C); const int Rb = Epi::PERM ? ((R & ~31) + perm32(R & 31)) : R;
        voffA[i] = (unsigned)(R * K + C) * 2u; voffB[i] = (unsigned)(Rb * K + C) * 2u; }
    const size_t kstep = (size_t)(BK * 2);
    const size_t hstep = (size_t)HALF * K * 2;
    const size_t tstep = 2 * hstep;
    const unsigned ldsw = (unsigned)wid * 1024u;
    const int aoff = lds_byte(wr * 64 + fr, fq * 8), boff = lds_byte(wc * 32 + fr, fq * 8);
#define PG8_SA(b, h) (((b) * 2 + (h)) * HTB)
#define PG8_SB(b, h) ((4 + (b) * 2 + (h)) * HTB)
#define PG8_STAGE(bufoff, gbase, voff) do { _Pragma("unroll") for (int _i = 0; _i < 2; ++_i) \
        __builtin_amdgcn_global_load_lds((const unsigned*)((const char*)(gbase) + (voff)[_i]), (PG8_LAS unsigned*)(lds + (bufoff) + ldsw + _i * 8192), 16, 0, 0); } while (0)
#define PG8_LDA(dst, b, h) do { _Pragma("unroll") for (int m = 0; m < 4; ++m) _Pragma("unroll") for (int k = 0; k < 2; ++k) dst[m][k] = *(const PG8_LAS bf16x8*)(lds + PG8_SA(b, h) + aoff + m * 2048 + k * 1024); } while (0)
#define PG8_LDB(dst, b, h) do { _Pragma("unroll") for (int n = 0; n < 2; ++n) _Pragma("unroll") for (int k = 0; k < 2; ++k) dst[n][k] = *(const PG8_LAS bf16x8*)(lds + PG8_SB(b, h) + boff + n * 2048 + k * 1024); } while (0)
#define PG8_MMA(ai, bj, At, Bt) do { __builtin_amdgcn_s_setprio(1); _Pragma("unroll") for (int m = 0; m < 4; ++m) _Pragma("unroll") for (int n = 0; n < 2; ++n) _Pragma("unroll") for (int k = 0; k < 2; ++k) \
        acc[ai][bj][m][n] = __builtin_amdgcn_mfma_f32_16x16x32_bf16(Bt[n][k], At[m][k], acc[ai][bj][m][n], 0, 0, 0); __builtin_amdgcn_s_setprio(0); } while (0)
#define PG8_WAIT_V(n) asm volatile("s_waitcnt vmcnt(" #n ")" ::: "memory")
#define PG8_WAIT_L(n) asm volatile("s_waitcnt lgkmcnt(" #n ")" ::: "memory")
#define PG8_BAR __builtin_amdgcn_s_barrier()
#define PG8_SCHED __builtin_amdgcn_sched_barrier(0)
    Unit cur, nxt; int ui = 0;
    if (!S.next(0, cur)) return;
    f32x4 acc[2][2][4][2];
#pragma unroll
    for (int a = 0; a < 2; ++a)
#pragma unroll
        for (int b = 0; b < 2; ++b)
#pragma unroll
            for (int m = 0; m < 4; ++m)
#pragma unroll
                for (int n = 0; n < 2; ++n) acc[a][b][m][n] = (f32x4){0.f, 0.f, 0.f, 0.f};
    bf16x8 At[4][2], B0[2][2], B1[2][2];
    const char* cA = (const char*)g.A + (size_t)cur.pm * tstep; const char* cB = (const char*)g.Bt + (size_t)cur.pn * tstep;
    S.a_ready(cur);
    if constexpr (SP2) {
        PG8_STAGE(PG8_SB(0, 0), cB, voffB); PG8_STAGE(PG8_SB(0, 1), cB + hstep, voffB); PG8_STAGE(PG8_SA(0, 0), cA, voffA); PG8_STAGE(PG8_SA(0, 1), cA + hstep, voffA);
        if (wr == 1) PG8_BAR;
        PG8_WAIT_V(2); PG8_BAR;
        PG8_STAGE(PG8_SB(1, 0), cB + kstep, voffB); PG8_STAGE(PG8_SA(1, 0), cA + kstep, voffA); PG8_STAGE(PG8_SB(1, 1), cB + hstep + kstep, voffB);
        PG8_WAIT_V(6); PG8_BAR;
    } else {
        PG8_STAGE(PG8_SB(0, 0), cB, voffB); PG8_STAGE(PG8_SA(0, 0), cA, voffA); PG8_STAGE(PG8_SB(0, 1), cB + hstep, voffB); PG8_STAGE(PG8_SA(0, 1), cA + hstep, voffA);
        if (wr == 1) PG8_BAR;
        PG8_WAIT_V(4); PG8_BAR;
        PG8_STAGE(PG8_SB(1, 0), cB + kstep, voffB); PG8_STAGE(PG8_SA(1, 0), cA + kstep, voffA); PG8_STAGE(PG8_SB(1, 1), cB + hstep + kstep, voffB);
        PG8_WAIT_V(6); PG8_BAR;
    }
    for (;;) {
        const bool has_next = S.next(ui + 1, nxt);
        const char* nA = has_next ? (const char*)g.A + (size_t)nxt.pm * tstep : cA; const char* nB = has_next ? (const char*)g.Bt + (size_t)nxt.pn * tstep : cB;
        for (int t = 0; t < nt; t += 2) {
            const bool last = (t == nt - 2);
            const char* a1 = cA + (size_t)(t + 1) * kstep;
            const char* a2 = last ? nA : cA + (size_t)(t + 2) * kstep; const char* b2 = last ? nB : cB + (size_t)(t + 2) * kstep;
            const char* a3 = a2 + kstep; const char* b3 = b2 + kstep;
            if (last && has_next) S.a_ready(nxt);
            if constexpr (SP2) {
            PG8_LDB(B0, 0, 0); PG8_LDB(B1, 0, 1); PG8_SCHED; PG8_LDA(At, 0, 0); PG8_STAGE(PG8_SA(1, 1), a1 + hstep, voffA);
            PG8_WAIT_V(8); PG8_WAIT_L(0); PG8_BAR; PG8_MMA(0, 0, At, B0); PG8_MMA(0, 1, At, B1); PG8_BAR; PG8_SCHED;
            PG8_LDA(At, 0, 1); PG8_STAGE(PG8_SB(0, 0), b2, voffB); PG8_STAGE(PG8_SB(0, 1), b2 + hstep, voffB); PG8_STAGE(PG8_SA(0, 0), a2, voffA);
            PG8_WAIT_V(8); PG8_WAIT_L(0); PG8_BAR; PG8_MMA(1, 0, At, B0); PG8_MMA(1, 1, At, B1); PG8_BAR; PG8_SCHED;
            PG8_LDB(B0, 1, 0); PG8_LDB(B1, 1, 1); PG8_SCHED; PG8_LDA(At, 1, 0); PG8_STAGE(PG8_SA(0, 1), a2 + hstep, voffA);
            PG8_WAIT_V(8); PG8_WAIT_L(0); PG8_BAR; PG8_MMA(0, 0, At, B0); PG8_MMA(0, 1, At, B1); PG8_BAR; PG8_SCHED;
            PG8_LDA(At, 1, 1); PG8_STAGE(PG8_SB(1, 0), b3, voffB); PG8_STAGE(PG8_SB(1, 1), b3 + hstep, voffB); PG8_STAGE(PG8_SA(1, 0), a3, voffA);
            PG8_WAIT_V(8); PG8_WAIT_L(0); PG8_BAR; PG8_MMA(1, 0, At, B0); PG8_MMA(1, 1, At, B1); PG8_BAR; PG8_SCHED;
            } else {
            PG8_LDB(B0, 0, 0); PG8_SCHED; PG8_LDA(At, 0, 0); PG8_STAGE(PG8_SA(1, 1), a1 + hstep, voffA);
            PG8_WAIT_L(8); PG8_BAR; PG8_WAIT_L(0); PG8_MMA(0, 0, At, B0); PG8_BAR; PG8_SCHED;
            PG8_LDB(B1, 0, 1); PG8_STAGE(PG8_SB(0, 0), b2, voffB);
            PG8_BAR; PG8_WAIT_L(0); PG8_MMA(0, 1, At, B1); PG8_BAR;
            PG8_LDA(At, 0, 1); PG8_STAGE(PG8_SA(0, 0), a2, voffA);
            PG8_BAR; PG8_WAIT_L(0); PG8_MMA(1, 0, At, B0); PG8_BAR; PG8_SCHED;
            PG8_STAGE(PG8_SB(0, 1), b2 + hstep, voffB);
            PG8_WAIT_V(6); PG8_BAR; PG8_MMA(1, 1, At, B1); PG8_BAR;
            PG8_LDB(B0, 1, 0); PG8_SCHED; PG8_LDA(At, 1, 0); PG8_STAGE(PG8_SA(0, 1), a2 + hstep, voffA);
            PG8_WAIT_L(8); PG8_BAR; PG8_WAIT_L(0); PG8_MMA(0, 0, At, B0); PG8_BAR; PG8_SCHED;
            PG8_LDB(B1, 1, 1); PG8_STAGE(PG8_SB(1, 0), b3, voffB);
            PG8_BAR; PG8_WAIT_L(0); PG8_MMA(0, 1, At, B1); PG8_BAR;
            PG8_LDA(At, 1, 1); PG8_STAGE(PG8_SA(1, 0), a3, voffA);
            PG8_BAR; PG8_WAIT_L(0); PG8_MMA(1, 0, At, B0); PG8_BAR; PG8_SCHED;
            PG8_STAGE(PG8_SB(1, 1), b3 + hstep, voffB);
            PG8_WAIT_V(6); PG8_BAR; PG8_MMA(1, 1, At, B1); PG8_BAR;
            }
        }
        if constexpr (ALIGN_EPI) { if (wr == 0) PG8_BAR; }
        if constexpr (!Epi::AFTER_DRAIN) { E(acc, cur, wr, wc, fr, fq); S.done(cur); }
        if (!has_next) break;
#pragma unroll
        for (int a = 0; a < 2; ++a)
#pragma unroll
            for (int b = 0; b < 2; ++b)
#pragma unroll
                for (int m = 0; m < 4; ++m)
#pragma unroll
                    for (int n = 0; n < 2; ++n) acc[a][b][m][n] = (f32x4){0.f, 0.f, 0.f, 0.f};
        cur = nxt; cA = nA; cB = nB; ++ui;
        if constexpr (ALIGN_EPI) { if (wr == 1) PG8_BAR; }
    }
    PG8_WAIT_V(0);
    if constexpr (!ALIGN_EPI) { if (wr == 0) PG8_BAR; }
    PG8_BAR;
    if constexpr (Epi::AFTER_DRAIN) { E.fused(acc, cur, wr, wc, fr, fq, lds, wid, lane); S.done(cur); }
#undef PG8_SA
#undef PG8_SB
#undef PG8_STAGE
#undef PG8_LDA
#undef PG8_LDB
#undef PG8_MMA
#undef PG8_WAIT_V
#undef PG8_WAIT_L
#undef PG8_BAR
#undef PG8_SCHED
}
}

#ifndef MK_N_LAUNCHES
#define MK_N_LAUNCHES 1
#endif
constexpr int NWAVES = 8;
constexpr int D = 1024, NH = 16, HD = 64, FF = 4096;
constexpr int M_CTX = 16 * 256, M_LAT = 4 * 2048, M = M_CTX + M_LAT;
constexpr int L_CTX = 256, L_LAT = 2048;
constexpr int NMOD = 6 * D;
constexpr int ZC_POOL = 0, ZC_R = 512, ZC_K = 1536, ZC_V = 2560, ZC_GA = 3584, ZC_GB = 4608;
constexpr int ZC_LW_A = 5632, ZC_LW_B = 5760, ZC_LA_A = 5888, ZC_LA_B = 6016, ZC_LG_A = 6144, ZC_LG_B = 6272, NZ = 6400;
constexpr int NPHASE = 9;

constexpr size_t MiB = 1u << 20;
constexpr size_t WS_CTL = 0, CTL_ZERO_BYTES = 1 * MiB;
constexpr int CW_BAR = 4096;
constexpr size_t WS_RSS1 = 256 * 1024, WS_RSS2 = 320 * 1024;
constexpr size_t WS_MOD = 1 * MiB, WS_C1 = 1 * MiB + 128 * 1024;
constexpr size_t WS_WCAT = 2 * MiB, WS_WOUT = 15 * MiB, WS_WFF1 = 17 * MiB, WS_WFF2 = 25 * MiB;
constexpr size_t WS_POOLW = 33 * MiB, WS_GW2T = 33 * MiB + 256 * 1024;
constexpr size_t WS_H = 34 * MiB;
constexpr size_t WS_Z = 58 * MiB;
constexpr size_t WS_ACT = 58 * MiB;
constexpr size_t WS_A2 = 154 * MiB;
constexpr size_t WS_END = 208 * MiB;
static_assert(WS_WCAT + (size_t)NZ * D * 2 <= WS_WOUT && WS_Z + (size_t)M * NZ * 2 <= WS_END && WS_ACT + (size_t)M * FF * 2 <= WS_A2 && WS_A2 + (size_t)M * D * 2 <= WS_END, "ws map");

constexpr int LDS_BYTES = 147456;
constexpr int RING_BYTES = 131072, MISC_OFF = RING_BYTES + 320;

#define GAS __attribute__((address_space(1)))
#define LAS __attribute__((address_space(3)))
typedef unsigned short bf16;
typedef _Float16 f16;
typedef unsigned v4u __attribute__((ext_vector_type(4)));
typedef unsigned v2u __attribute__((ext_vector_type(2)));
typedef float f32x4 __attribute__((ext_vector_type(4)));
typedef float f32x2 __attribute__((ext_vector_type(2)));
typedef short bf16x8 __attribute__((ext_vector_type(8)));
typedef _Float16 f16x4 __attribute__((ext_vector_type(4)));
typedef _Float16 f16x8 __attribute__((ext_vector_type(8)));
typedef _Float16 f16x2 __attribute__((ext_vector_type(2)));
typedef GAS unsigned gu32;
#define RLX_AGENT __ATOMIC_RELAXED, __HIP_MEMORY_SCOPE_AGENT
#define LDS_WAIT() asm volatile("s_waitcnt lgkmcnt(0)" ::: "memory")
#define VM_WAIT() asm volatile("s_waitcnt vmcnt(0)" ::: "memory")

__device__ __forceinline__ unsigned pkbf(float lo, float hi) { return pg8::cvt_pk_bf16(lo, hi); }
__device__ __forceinline__ unsigned pkh(float lo, float hi) { f16x2 v = {(f16)lo, (f16)hi}; return __builtin_bit_cast(unsigned, v); }
__device__ __forceinline__ float bf2f(unsigned short b) { return __builtin_bit_cast(float, (unsigned)b << 16); }
__device__ __forceinline__ f32x4 ld_h4(const f16* p) { const f16x4 v = *(const f16x4*)p; return __builtin_convertvector(v, f32x4); }
__device__ __forceinline__ f32x4 ld_bf4(const bf16* p) { const v2u v = *(const v2u*)p; f32x4 r; r.x = __builtin_bit_cast(float, v.x << 16); r.y = __builtin_bit_cast(float, v.x & 0xffff0000u);
    r.z = __builtin_bit_cast(float, v.y << 16); r.w = __builtin_bit_cast(float, v.y & 0xffff0000u); return r; }
__device__ __forceinline__ float frcp(float x) { return __builtin_amdgcn_rcpf(x); }
__device__ __forceinline__ float sigmoidf_(float x) { return frcp(1.0f + __expf(-x)); }
__device__ __forceinline__ float wave_sum(float v) {
#pragma unroll
    for (int o = 1; o < 64; o <<= 1) v += __shfl_xor(v, o);
    return v;
}
__device__ __forceinline__ int cvec_of_row(int m) { return m < M_CTX ? 0 : 1 + (m - M_CTX) / L_LAT; }

#define XB_TMO      128
#define XB_XCNT(j)  (256  + 64 * (j))
#define XB_XSUB(j)  (1280 + 64 * (j))
#define XB_XGEN(j)  (2304 + 64 * (j))
#define XB_TOP      3328
#define XB_TOPGEN   3392
#define XCD_BAR_WORDS 3456
#define XB_SPIN_CAP (1u << 18)
__device__ __forceinline__ unsigned xb_ld(unsigned* p)              { return __hip_atomic_load(p, __ATOMIC_RELAXED, __HIP_MEMORY_SCOPE_AGENT); }
__device__ __forceinline__ unsigned xb_add(unsigned* p, unsigned v) { return __hip_atomic_fetch_add(p, v, __ATOMIC_RELAXED, __HIP_MEMORY_SCOPE_AGENT); }
__device__ __forceinline__ unsigned xb_xcc_id() { return (unsigned)__builtin_amdgcn_s_getreg((3 << 11) | 20) & 0xFu; }
#define XB_SPIN(cond, bar) do { unsigned _sp = 0; while (cond) { __builtin_amdgcn_s_sleep(1); \
    if ((++_sp & 255u) == 0u) { if (xb_ld(&(bar)[XB_TMO])) break; if (_sp > XB_SPIN_CAP) { atomicAdd(&(bar)[XB_TMO], 1u); break; } } } } while (0)
struct XcdBarrier { unsigned* bar; unsigned x; volatile LAS unsigned* st; };
__device__ __forceinline__ XcdBarrier xcd_barrier_post(unsigned* bar, volatile LAS unsigned* st) {
    XcdBarrier b; b.bar = bar; b.x = xb_xcc_id(); b.st = st;
    if (threadIdx.x == 0) (void)xb_add(&bar[XB_XCNT(b.x)], 1u);
    return b;
}
__device__ __forceinline__ void xcd_barrier_complete(unsigned* bar, unsigned x, unsigned& nloc, unsigned& nx) {
    const unsigned G = gridDim.x * gridDim.y * gridDim.z;
    unsigned sum, cnt, mine, sp = 0u;
    for (;;) {
        sum = 0u; cnt = 0u; mine = 0u;
#pragma unroll
        for (unsigned j = 0; j < 16; ++j) { const unsigned c = xb_ld(&bar[XB_XCNT(j)]); sum += c; cnt += (c > 0u) ? 1u : 0u; mine = (j == x) ? c : mine; }
        if (sum == G) break;
        __builtin_amdgcn_s_sleep(1);
        if ((++sp & 255u) == 0u) { if (xb_ld(&bar[XB_TMO])) break; if (sp > XB_SPIN_CAP) { atomicAdd(&bar[XB_TMO], 1u); break; } }
    }
    nloc = mine > 0u ? mine : 1u; nx = cnt > 0u ? cnt : 1u;
}
__device__ __forceinline__ void xcd_barrier(const XcdBarrier& b) {
    asm volatile("s_waitcnt vmcnt(0)" ::: "memory");
    __syncthreads();
    if (threadIdx.x == 0) {
        unsigned* bar = b.bar;
        __builtin_amdgcn_s_waitcnt(0);
        unsigned nloc = b.st[0], nx = b.st[1];
        if (nloc == 0u) { xcd_barrier_complete(bar, b.x, nloc, nx); b.st[0] = nloc; b.st[1] = nx; }
        const unsigned old = xb_add(&bar[XB_XSUB(b.x)], 1u);
        const unsigned gen = old / nloc;
        if (old + 1u == (gen + 1u) * nloc) {
            __builtin_amdgcn_fence(__ATOMIC_RELEASE, "agent");
            asm volatile("s_waitcnt vmcnt(0)" ::: "memory");
            const unsigned og = xb_add(&bar[XB_TOP], 1u);
            const unsigned tg = og / nx;
            if (og + 1u == (tg + 1u) * nx) xb_add(&bar[XB_TOPGEN], 1u);
            else XB_SPIN(xb_ld(&bar[XB_TOPGEN]) == tg, bar);
            __builtin_amdgcn_fence(__ATOMIC_ACQUIRE, "agent");
            xb_add(&bar[XB_XGEN(b.x)], 1u);
            asm volatile("s_waitcnt vmcnt(0)" ::: "memory");
        } else {
            XB_SPIN(xb_ld(&bar[XB_XGEN(b.x)]) == gen, bar);
            __builtin_amdgcn_fence(__ATOMIC_ACQUIRE, "agent");
            asm volatile("s_waitcnt vmcnt(0)" ::: "memory");
        }
    }
    __syncthreads();
}

struct EpiZ {
    static constexpr bool PERM = true, AFTER_DRAIN = false;
    f16* Z;
    __device__ __forceinline__ void operator()(const f32x4 (&acc)[2][2][4][2], const pg8::Unit& u, int wr, int wc, int fr, int fq) const {
        const int row0 = u.pm * 256 + wr * 64 + fr, col0 = u.pn * 256 + wc * 32 + 8 * fq;
        const bool sig = (u.pn >= ZC_GA / 256) && (u.pn < ZC_LW_A / 256);
#pragma unroll
        for (int ai = 0; ai < 2; ++ai)
#pragma unroll
            for (int m = 0; m < 4; ++m) { f16* rowp = Z + (size_t)(row0 + ai * 128 + m * 16) * NZ + col0;
#pragma unroll
                for (int bj = 0; bj < 2; ++bj) { f32x4 v0 = acc[ai][bj][m][0], v1 = acc[ai][bj][m][1];
                    if (sig) {
#pragma unroll
                        for (int e = 0; e < 4; ++e) { v0[e] = sigmoidf_(v0[e]); v1[e] = sigmoidf_(v1[e]); } }
                    v4u w; w.x = pkh(v0[0], v0[1]); w.y = pkh(v0[2], v0[3]); w.z = pkh(v1[0], v1[1]); w.w = pkh(v1[2], v1[3]);
                    *(v4u*)(rowp + bj * 128) = w; } }
    }
};
struct EpiOut1 {
    static constexpr bool PERM = false, AFTER_DRAIN = false;
    const float* xp; const float* xs; float* X1; bf16* A2; const float* mod; const float* g2; float* rowss;
    __device__ __forceinline__ void operator()(const f32x4 (&acc)[2][2][4][2], const pg8::Unit& u, int wr, int wc, int fr, int fq) const {
        const int ci = cvec_of_row(u.pm * 256);
        const float* xb = (u.pm < M_CTX / 256) ? xp + (size_t)u.pm * 256 * D : xs + (size_t)(u.pm - M_CTX / 256) * 256 * D;
        const int col0 = u.pn * 256 + wc * 32 + 4 * fq;
        f32x4 ga[2][2], gm[2][2];
#pragma unroll
        for (int bj = 0; bj < 2; ++bj)
#pragma unroll
            for (int n = 0; n < 2; ++n) { const int c = col0 + bj * 128 + n * 16;
                ga[bj][n] = *(const f32x4*)(mod + ci * NMOD + 2 * D + c);
                const f32x4 sc = *(const f32x4*)(mod + ci * NMOD + 4 * D + c), g = *(const f32x4*)(g2 + c); gm[bj][n] = g * (sc + 1.0f); }
#pragma unroll
        for (int ai = 0; ai < 2; ++ai)
#pragma unroll
            for (int m = 0; m < 4; ++m) { const int rl = ai * 128 + wr * 64 + m * 16 + fr; const size_t r = (size_t)u.pm * 256 + rl; float ss = 0.f;
#pragma unroll
                for (int bj = 0; bj < 2; ++bj)
#pragma unroll
                    for (int n = 0; n < 2; ++n) { const int c = col0 + bj * 128 + n * 16;
                        const f32x4 x = *(const f32x4*)(xb + (size_t)rl * D + c); const f32x4 x1 = x + ga[bj][n] * acc[ai][bj][m][n];
                        *(f32x4*)(X1 + r * D + c) = x1; ss += (x1[0] * x1[0] + x1[1] * x1[1]) + (x1[2] * x1[2] + x1[3] * x1[3]);
                        const f32x4 a = x1 * gm[bj][n]; v2u w; w.x = pkbf(a[0], a[1]); w.y = pkbf(a[2], a[3]); *(v2u*)(A2 + r * D + c) = w; }
                ss += __shfl_xor(ss, 16); ss += __shfl_xor(ss, 32);
                if (fq == 0) atomicAdd(rowss + r, ss); }
    }
};
struct EpiFF1 {
    static constexpr bool PERM = true, AFTER_DRAIN = false;
    const float* rowss; const float* c1; bf16* ACT;
    __device__ __forceinline__ void operator()(const f32x4 (&acc)[2][2][4][2], const pg8::Unit& u, int wr, int wc, int fr, int fq) const {
        const int ci = cvec_of_row(u.pm * 256);
        const int row0 = u.pm * 256 + wr * 64 + fr, col0 = u.pn * 256 + wc * 32 + 8 * fq;
        f32x4 cb[2][2];
#pragma unroll
        for (int bj = 0; bj < 2; ++bj)
#pragma unroll
            for (int n = 0; n < 2; ++n) cb[bj][n] = *(const f32x4*)(c1 + ci * FF + col0 + bj * 128 + 4 * n);
#pragma unroll
        for (int ai = 0; ai < 2; ++ai)
#pragma unroll
            for (int m = 0; m < 4; ++m) { const int r = row0 + ai * 128 + m * 16; const float rstd = rsqrtf(rowss[r] * (1.0f / D) + 1e-6f);
                bf16* rowp = ACT + (size_t)r * FF + col0;
#pragma unroll
                for (int bj = 0; bj < 2; ++bj) { f32x4 v0 = acc[ai][bj][m][0] * rstd + cb[bj][0], v1 = acc[ai][bj][m][1] * rstd + cb[bj][1];
#pragma unroll
                    for (int e = 0; e < 4; ++e) { const float a = fmaxf(v0[e], 0.f), b = fmaxf(v1[e], 0.f); v0[e] = a * a; v1[e] = b * b; }
                    v4u w; w.x = pkbf(v0[0], v0[1]); w.y = pkbf(v0[2], v0[3]); w.z = pkbf(v1[0], v1[1]); w.w = pkbf(v1[2], v1[3]);
                    *(v4u*)(rowp + bj * 128) = w; } }
    }
};
struct EpiOut2 {
    static constexpr bool PERM = false, AFTER_DRAIN = false;
    float* X; const float* mod; float* rowss;
    __device__ __forceinline__ void operator()(const f32x4 (&acc)[2][2][4][2], const pg8::Unit& u, int wr, int wc, int fr, int fq) const {
        const int ci = cvec_of_row(u.pm * 256);
        const int col0 = u.pn * 256 + wc * 32 + 4 * fq;
        f32x4 ga[2][2];
#pragma unroll
        for (int bj = 0; bj < 2; ++bj)
#pragma unroll
            for (int n = 0; n < 2; ++n) ga[bj][n] = *(const f32x4*)(mod + ci * NMOD + 5 * D + col0 + bj * 128 + n * 16);
#pragma unroll
        for (int ai = 0; ai < 2; ++ai)
#pragma unroll
            for (int m = 0; m < 4; ++m) { const size_t r = (size_t)u.pm * 256 + ai * 128 + wr * 64 + m * 16 + fr; float ss = 0.f;
#pragma unroll
                for (int bj = 0; bj < 2; ++bj)
#pragma unroll
                    for (int n = 0; n < 2; ++n) { const int c = col0 + bj * 128 + n * 16;
                        const f32x4 x = *(const f32x4*)(X + r * D + c); const f32x4 x2 = x + ga[bj][n] * acc[ai][bj][m][n];
                        *(f32x4*)(X + r * D + c) = x2; ss += (x2[0] * x2[0] + x2[1] * x2[1]) + (x2[2] * x2[2] + x2[3] * x2[3]); }
                ss += __shfl_xor(ss, 16); ss += __shfl_xor(ss, 32);
                if (fq == 0) atomicAdd(rowss + r, ss); }
    }
};

struct Args { const float* in[31]; float* out; unsigned char* ws; int ph_lo, ph_hi; };
struct Frame {
    LAS unsigned char* lds;
    int tid, lane, wave, G, bid;
    const float* const* in;
    float* out; unsigned char* ws;
};

__device__ __forceinline__ void tr_item(const float* W, int ldw, const float* mu, int mode, bf16* WT, int ldk, LAS float* scr, int kb, int nb, int lane) {
    const int k0 = 64 * kb, n0 = 32 * nb;
#pragma unroll 8
    for (int i = 0; i < 32; ++i) { const int kk = 2 * i + (lane >> 5); float v = W[(size_t)(k0 + kk) * ldw + n0 + (lane & 31)];
        if (mode) { const float mm = mu[k0 + kk]; v *= (mode == 1) ? (1.0f - mm) : mm; }
        scr[kk * 33 + (lane & 31)] = v; }
    LDS_WAIT(); asm volatile("" ::: "memory");
    const int c = lane & 7;
#pragma unroll
    for (int j = 0; j < 4; ++j) { const int n = (lane >> 3) + 8 * j; const LAS float* s = scr + (8 * c) * 33 + n;
        v4u o; o.x = pkbf(s[0 * 33], s[1 * 33]); o.y = pkbf(s[2 * 33], s[3 * 33]); o.z = pkbf(s[4 * 33], s[5 * 33]); o.w = pkbf(s[6 * 33], s[7 * 33]);
        *(GAS v4u*)(WT + (size_t)(n0 + n) * ldk + k0 + 8 * c) = o; }
    LDS_WAIT(); asm volatile("" ::: "memory");
}
__device__ __forceinline__ void p0_prologue(Frame& F) {
    const float* const* in = F.in;
    {
        LAS float* sl = (LAS float*)(F.lds + 98304);
        LAS float* red = (LAS float*)(F.lds + 98304 + 20480);
        if (F.bid < 192 || F.G < 192) {
            for (int i = F.tid; i < 5 * D; i += NWAVES * 64) { const int ci = i >> 10, k = i & 1023; const float x = ci == 0 ? in[4][k] : in[3][(ci - 1) * D + k]; sl[i] = x * frcp(1.0f + __expf(-x)); }
            __syncthreads();
            float* mod = (float*)(F.ws + WS_MOD);
            for (int item = F.bid; item < 192; item += F.G) {
                const int col = F.tid & 31, ks = F.tid >> 5, n = item * 32 + col;
                float a0 = 0.f, a1 = 0.f, a2 = 0.f, a3 = 0.f, a4 = 0.f;
                const float* wp = in[5] + (size_t)(ks * 64) * NMOD + n;
#pragma unroll 8
                for (int k = 0; k < 64; ++k) { const float w = wp[(size_t)k * NMOD]; const int kk = ks * 64 + k;
                    a0 += sl[kk] * w; a1 += sl[1024 + kk] * w; a2 += sl[2048 + kk] * w; a3 += sl[3072 + kk] * w; a4 += sl[4096 + kk] * w; }
                LAS float* rp = red + (ks * 32 + col) * 5; rp[0] = a0; rp[1] = a1; rp[2] = a2; rp[3] = a3; rp[4] = a4;
                __syncthreads();
                if (F.tid < 160) { const int ci = F.tid >> 5, cc = F.tid & 31; float s = in[6][item * 32 + cc];
#pragma unroll
                    for (int q = 0; q < 16; ++q) s += red[(q * 32 + cc) * 5 + ci];
                    mod[ci * NMOD + item * 32 + cc] = s; }
                __syncthreads();
            }
        }
    }
    LAS float* scr = (LAS float*)(F.lds + F.wave * 12288);
    const int gw = F.bid * NWAVES + F.wave, NGW = F.G * NWAVES;
    bf16* WcatT = (bf16*)(F.ws + WS_WCAT); bf16* WoutT = (bf16*)(F.ws + WS_WOUT); bf16* Wff1T = (bf16*)(F.ws + WS_WFF1); bf16* Wff2T = (bf16*)(F.ws + WS_WFF2);
    bf16* poolWT = (bf16*)(F.ws + WS_POOLW); bf16* gw2T = (bf16*)(F.ws + WS_GW2T);
    constexpr int I_IN = 16 * 176, I_LORA = 6 * 64, I_OUT = 16 * 32, I_F1 = 16 * 128, I_F2 = 64 * 32, I_POOL = 4 * 16, I_G2 = 2 * 32;
    constexpr int NITEMS = I_IN + I_LORA + I_OUT + I_F1 + I_F2 + I_POOL + I_G2;
    for (int it = gw; it < NITEMS; it += NGW) {
        int r = it;
        if (r < I_IN) { tr_item(in[9], 5632, nullptr, 0, WcatT, D, scr, r / 176, r % 176, F.lane); continue; } r -= I_IN;
        if (r < I_LORA) { const int qs = r / 64, q = qs >> 1, s = qs & 1, rr = r % 64, kb = rr / 4, nb = rr % 4;
            const float* W; int ldw;
            if (q < 2) { W = (q == 0 ? in[13] : in[16]) + (size_t)(nb >> 1) * D * 64 + (nb & 1) * 32; ldw = 64; } else { W = in[18] + nb * 32; ldw = 128; }
            tr_item(W, ldw, in[11] + q * D, s + 1, WcatT + (size_t)(ZC_LW_A + q * 256 + s * 128 + nb * 32) * D, D, scr, kb, 0, F.lane); continue; } r -= I_LORA;
        if (r < I_OUT) { tr_item(in[27], D, nullptr, 0, WoutT, D, scr, r / 32, r % 32, F.lane); continue; } r -= I_OUT;
        if (r < I_F1) { tr_item(in[28], FF, nullptr, 0, Wff1T, D, scr, r / 128, r % 128, F.lane); continue; } r -= I_F1;
        if (r < I_F2) { tr_item(in[29], D, nullptr, 0, Wff2T, FF, scr, r / 32, r % 32, F.lane); continue; } r -= I_F2;
        if (r < I_POOL) { const int g = r / 16, rr = r % 16; tr_item(in[25] + (size_t)g * 128 * 256, 256, nullptr, 0, poolWT + (size_t)g * 256 * 128, 128, scr, rr / 8, rr % 8, F.lane); continue; } r -= I_POOL;
        tr_item(in[19], D, nullptr, 0, gw2T, 128, scr, r / 32, r % 32, F.lane);
    }
}

__device__ __forceinline__ void p1_hprep(Frame& F) {
    const float* const* in = F.in;
    const int gw = F.bid * NWAVES + F.wave, NGW = F.G * NWAVES;
    const float* mod = (const float*)(F.ws + WS_MOD);
    bf16* H = (bf16*)(F.ws + WS_H);
    for (int m = gw; m < M; m += NGW) {
        const float* xrow = m < M_CTX ? in[0] + (size_t)m * D : in[1] + (size_t)(m - M_CTX) * D;
        const int ci = cvec_of_row(m);
        f32x4 v[4]; float s = 0.f;
#pragma unroll
        for (int j = 0; j < 4; ++j) { v[j] = *(const f32x4*)(xrow + 4 * (F.lane + 64 * j)); s += (v[j].x * v[j].x + v[j].y * v[j].y) + (v[j].z * v[j].z + v[j].w * v[j].w); }
        const float rstd = rsqrtf(wave_sum(s) * (1.0f / D) + 1e-6f);
#pragma unroll
        for (int j = 0; j < 4; ++j) { const int c = 4 * (F.lane + 64 * j);
            const f32x4 g = *(const f32x4*)(in[7] + c), sh = *(const f32x4*)(mod + ci * NMOD + c), sc = *(const f32x4*)(mod + ci * NMOD + D + c);
            const f32x4 y = (v[j] * rstd) * g * (sc + 1.0f) + sh;
            v2u w; w.x = pkbf(y.x, y.y); w.y = pkbf(y.z, y.w); *(v2u*)(H + (size_t)m * D + c) = w; }
    }
    const bf16* Wff1T = (const bf16*)(F.ws + WS_WFF1); float* c1 = (float*)(F.ws + WS_C1);
    for (int n = gw; n < FF; n += NGW) {
        const bf16* wr = Wff1T + (size_t)n * D + F.lane * 16;
        const v4u w0 = *(const v4u*)wr, w1 = *(const v4u*)(wr + 8);
        float w[16];
#pragma unroll
        for (int e = 0; e < 4; ++e) { w[2 * e] = __builtin_bit_cast(float, w0[e] << 16); w[2 * e + 1] = __builtin_bit_cast(float, w0[e] & 0xffff0000u);
            w[8 + 2 * e] = __builtin_bit_cast(float, w1[e] << 16); w[8 + 2 * e + 1] = __builtin_bit_cast(float, w1[e] & 0xffff0000u); }
#pragma unroll
        for (int ci = 0; ci < 5; ++ci) { const float* sh = mod + ci * NMOD + 3 * D + F.lane * 16; float s = 0.f;
#pragma unroll
            for (int q = 0; q < 4; ++q) { const f32x4 x = *(const f32x4*)(sh + 4 * q); s += x.x * w[4 * q] + x.y * w[4 * q + 1] + x.z * w[4 * q + 2] + x.w * w[4 * q + 3]; }
            s = wave_sum(s); if (F.lane == 0) c1[ci * FF + n] = s; }
    }
}

constexpr int SC = 32;
__device__ __forceinline__ void p3_scan(Frame& F) {
    const float* const* in = F.in;
    const f16* Z = (const f16*)(F.ws + WS_Z);
    LAS float* OPS = (LAS float*)(F.lds);
    LAS float* HW = (LAS float*)(F.lds + 49152);
    LAS float* HA = (LAS float*)(F.lds + 57344);
    LAS float* WD2 = (LAS float*)(F.lds + 65536);
    LAS float* WA2 = (LAS float*)(F.lds + 81920);
    LAS float* YB = (LAS float*)(F.lds + 98304);
    const int tid = F.tid, i = tid >> 3, g = tid & 7;
    const int ptt = tid >> 4, pc4 = (tid & 15) * 4;
    constexpr int NLAT = 4 * NH * 2, NCTX = 16 * NH * 2, NCH = NLAT + NCTX;
    for (int slot = 0;; ++slot) {
        int chain;
        if (F.G == 256) { if (F.bid < 128) { if (slot > 0) break; chain = F.bid; } else { if (slot > 3) break; chain = NLAT + (F.bid - 128) + 128 * slot; } }
        else { chain = F.bid + slot * F.G; if (chain >= NCH) break; }
        const bool isLat = chain < NLAT; const int cid = isLat ? chain : chain - NLAT;
        const int b = cid / 32, head = (cid >> 1) & 15, d = cid & 1;
        const int L = isLat ? L_LAT : L_CTX, m0 = isLat ? M_CTX + b * L_LAT : b * L_CTX;
        bf16* Y = (bf16*)F.out + (size_t)d * M * D;
        __syncthreads();
        for (int idx = tid; idx < 4096; idx += NWAVES * 64) { const int k = idx >> 6, c = idx & 63;
            WD2[idx] = in[14][(size_t)(d * 64 + k) * D + head * 64 + c]; WA2[idx] = in[17][(size_t)(d * 64 + k) * D + head * 64 + c]; }
        float S[8];
        if (isLat) { const float* sp = in[2] + ((size_t)((b * 2 + d) * NH + head)) * 4096 + i * 64 + g * 8; const f32x4 s0 = *(const f32x4*)sp, s1 = *(const f32x4*)(sp + 4);
            S[0] = s0.x; S[1] = s0.y; S[2] = s0.z; S[3] = s0.w; S[4] = s1.x; S[5] = s1.y; S[6] = s1.z; S[7] = s1.w; }
        else {
#pragma unroll
            for (int j = 0; j < 8; ++j) S[j] = 0.f; }
        const int hc = head * 64 + pc4;
        const f32x4 mu_r = *(const f32x4*)(in[10] + hc), mu_k = *(const f32x4*)(in[10] + D + hc), mu_v = *(const f32x4*)(in[10] + 2 * D + hc);
        const f32x4 kkw = *(const f32x4*)(in[20] + hc), kaw = *(const f32x4*)(in[21] + hc);
        const f32x4 wd0 = *(const f32x4*)(in[12] + d * D + hc), a0v = *(const f32x4*)(in[15] + d * D + hc);
        const int nch = L / SC;
        for (int ch = 0; ch < nch; ++ch) {
            const int t0 = d == 0 ? SC * ch : L - SC * (ch + 1);
            f32x4 k4, kk4;
            {
                const int t = t0 + ptt; const f16* zr = Z + (size_t)(m0 + t) * NZ;
                const float fp = t > 0 ? 0.5f : 0.f, fn = t < L - 1 ? 0.5f : 0.f;
                const f16* zp = t > 0 ? zr - NZ : zr; const f16* zn = t < L - 1 ? zr + NZ : zr;
                const f32x4 rz = ld_h4(zr + ZC_R + hc), kz = ld_h4(zr + ZC_K + hc), vz = ld_h4(zr + ZC_V + hc);
                const f32x4 rs = ld_h4(zp + ZC_R + hc) * fp + ld_h4(zn + ZC_R + hc) * fn;
                const f32x4 ks = ld_h4(zp + ZC_K + hc) * fp + ld_h4(zn + ZC_K + hc) * fn;
                const f32x4 vs = ld_h4(zp + ZC_V + hc) * fp + ld_h4(zn + ZC_V + hc) * fn;
                const f32x4 r4 = rz + (rs - rz) * mu_r; k4 = kz + (ks - kz) * mu_k; const f32x4 v4 = vz + (vs - vz) * mu_v;
                const int lc = d * 64 + pc4;
                f32x4 hw = ld_h4(zr + ZC_LW_A + lc) + ld_h4(zp + ZC_LW_B + lc) * fp + ld_h4(zn + ZC_LW_B + lc) * fn;
                const f32x4 ha = ld_h4(zr + ZC_LA_A + lc) + ld_h4(zp + ZC_LA_B + lc) * fp + ld_h4(zn + ZC_LA_B + lc) * fn;
#pragma unroll
                for (int e = 0; e < 4; ++e) hw[e] = 1.0f - 2.0f * frcp(__expf(2.0f * hw[e]) + 1.0f);
                const f32x4 ku = k4 * kkw; float ssq = (ku.x * ku.x + ku.y * ku.y) + (ku.z * ku.z + ku.w * ku.w);
                ssq += __shfl_xor(ssq, 1); ssq += __shfl_xor(ssq, 2); ssq += __shfl_xor(ssq, 4); ssq += __shfl_xor(ssq, 8);
                kk4 = ku * rsqrtf(ssq + 1e-12f);
                *(LAS f32x4*)(HW + ptt * 64 + pc4) = hw; *(LAS f32x4*)(HA + ptt * 64 + pc4) = ha;
                *(LAS f32x4*)(OPS + ptt * 384 + 64 + pc4) = kk4; *(LAS f32x4*)(OPS + ptt * 384 + 256 + pc4) = r4; *(LAS f32x4*)(OPS + ptt * 384 + 320 + pc4) = v4;
            }
            __syncthreads();
            {
                f32x4 aw = {0.f, 0.f, 0.f, 0.f}, aa = {0.f, 0.f, 0.f, 0.f};
#pragma unroll 8
                for (int k = 0; k < 64; ++k) { const float hwk = HW[ptt * 64 + k], hak = HA[ptt * 64 + k];
                    aw += *(const LAS f32x4*)(WD2 + k * 64 + pc4) * hwk; aa += *(const LAS f32x4*)(WA2 + k * 64 + pc4) * hak; }
                f32x4 dec, av, kd, bb;
#pragma unroll
                for (int e = 0; e < 4; ++e) { dec[e] = __expf(-0.6065306597126334f * sigmoidf_(wd0[e] + aw[e])); av[e] = sigmoidf_(a0v[e] + aa[e]); }
                kd = k4 * ((av - 1.0f) * kaw + 1.0f); bb = kk4 * av;
                *(LAS f32x4*)(OPS + ptt * 384 + pc4) = dec; *(LAS f32x4*)(OPS + ptt * 384 + 128 + pc4) = bb; *(LAS f32x4*)(OPS + ptt * 384 + 192 + pc4) = kd;
            }
            __syncthreads();
#pragma unroll 2
            for (int s = 0; s < SC; ++s) {
                const int tt = d == 0 ? s : SC - 1 - s;
                const LAS float* op = OPS + tt * 384 + g * 8;
                const f32x4 w0 = *(const LAS f32x4*)(op), w1 = *(const LAS f32x4*)(op + 4);
                const f32x4 q0 = *(const LAS f32x4*)(op + 64), q1 = *(const LAS f32x4*)(op + 68);
                const f32x4 b0 = *(const LAS f32x4*)(op + 128), b1 = *(const LAS f32x4*)(op + 132);
                const f32x4 d0 = *(const LAS f32x4*)(op + 192), d1 = *(const LAS f32x4*)(op + 196);
                const f32x4 r0 = *(const LAS f32x4*)(op + 256), r1 = *(const LAS f32x4*)(op + 260);
                const float v = OPS[tt * 384 + 320 + i];
                float p = (S[0] * q0.x + S[1] * q0.y) + (S[2] * q0.z + S[3] * q0.w) + (S[4] * q1.x + S[5] * q1.y) + (S[6] * q1.z + S[7] * q1.w);
                p += __shfl_xor(p, 1); p += __shfl_xor(p, 2); p += __shfl_xor(p, 4);
                S[0] = S[0] * w0.x - p * b0.x + v * d0.x; S[1] = S[1] * w0.y - p * b0.y + v * d0.y; S[2] = S[2] * w0.z - p * b0.z + v * d0.z; S[3] = S[3] * w0.w - p * b0.w + v * d0.w;
                S[4] = S[4] * w1.x - p * b1.x + v * d1.x; S[5] = S[5] * w1.y - p * b1.y + v * d1.y; S[6] = S[6] * w1.z - p * b1.z + v * d1.z; S[7] = S[7] * w1.w - p * b1.w + v * d1.w;
                float y = (S[0] * r0.x + S[1] * r0.y) + (S[2] * r0.z + S[3] * r0.w) + (S[4] * r1.x + S[5] * r1.y) + (S[6] * r1.z + S[7] * r1.w);
                y += __shfl_xor(y, 1); y += __shfl_xor(y, 2); y += __shfl_xor(y, 4);
                if (g == 0) YB[tt * 64 + i] = y;
            }
            __syncthreads();
            { const f32x4 y4 = *(const LAS f32x4*)(YB + ptt * 64 + pc4); v2u w; w.x = pkbf(y4.x, y4.y); w.y = pkbf(y4.z, y4.w);
              *(v2u*)(Y + (size_t)(m0 + t0 + ptt) * D + hc) = w; }
        }
        if (!isLat) { float* so = F.out + (size_t)M * D + ((size_t)((b * 2 + d) * NH + head)) * 4096 + i * 64 + g * 8;
            *(f32x4*)so = (f32x4){S[0], S[1], S[2], S[3]}; *(f32x4*)(so + 4) = (f32x4){S[4], S[5], S[6], S[7]}; }
    }
}

constexpr int MXS = 136;
__device__ __forceinline__ void p4_mix(Frame& F) {
    const float* const* in = F.in;
    const f16* Z = (const f16*)(F.ws + WS_Z);
    const bf16* Y0 = (const bf16*)F.out; const bf16* Y1 = Y0 + (size_t)M * D;
    bf16* MIX = (bf16*)(F.ws + WS_H);
    const bf16* poolWT = (const bf16*)(F.ws + WS_POOLW); const bf16* gw2T = (const bf16*)(F.ws + WS_GW2T);
    LAS bf16* SG = (LAS bf16*)(F.lds);
    LAS f32x4* ST = (LAS f32x4*)(F.lds + 17408);
    LAS f16* ZP = (LAS f16*)(F.lds + 17408 + 16384);
    LAS bf16* MX = (LAS bf16*)(F.lds + 17408 + 16384 + 20480);
    const int tid = F.tid, lane = F.lane, wave = F.wave;
    for (int tile = F.bid; tile < M / 64; tile += F.G) {
        const int m0t = tile * 64;
        const bool isCtx = m0t < M_CTX;
        const int ms = isCtx ? (m0t / L_CTX) * L_CTX : M_CTX + ((m0t - M_CTX) / L_LAT) * L_LAT, L = isCtx ? L_CTX : L_LAT;
        const int vlo = isCtx ? ms - m0t : 0, vhi = isCtx ? ms + L_CTX - m0t : 64;
        __syncthreads();
        { const int tt = tid >> 3, c16 = (tid & 7) * 16; const int m = m0t + tt, t = m - ms;
          const f16* zr = Z + (size_t)m * NZ; const f16* zp = t > 0 ? zr - NZ : zr; const f16* zn = t < L - 1 ? zr + NZ : zr;
          const float fp = t > 0 ? 0.5f : 0.f, fn = t < L - 1 ? 0.5f : 0.f;
          unsigned o[8];
#pragma unroll
          for (int q = 0; q < 4; ++q) { const f32x4 h = ld_h4(zr + ZC_LG_A + c16 + 4 * q) + ld_h4(zp + ZC_LG_B + c16 + 4 * q) * fp + ld_h4(zn + ZC_LG_B + c16 + 4 * q) * fn;
              o[2 * q] = pkbf(sigmoidf_(h.x), sigmoidf_(h.y)); o[2 * q + 1] = pkbf(sigmoidf_(h.z), sigmoidf_(h.w)); }
          *(LAS v4u*)(SG + tt * MXS + c16) = (v4u){o[0], o[1], o[2], o[3]}; *(LAS v4u*)(SG + tt * MXS + c16 + 8) = (v4u){o[4], o[5], o[6], o[7]}; }
#pragma unroll 1
        for (int it = 0; it < 8; ++it) { const int item = it * 512 + tid, pair = item >> 2, q = item & 3, tt = pair >> 4, head = pair & 15; const int m = m0t + tt, t = m - ms, c0 = head * 64 + q * 16;
            const f16* zr = Z + (size_t)m * NZ; const f16* zp = t > 0 ? zr - NZ : zr; const f16* zn = t < L - 1 ? zr + NZ : zr;
            const float fp = t > 0 ? 0.5f : 0.f, fn = t < L - 1 ? 0.5f : 0.f;
            float y[16]; float s1 = 0.f, rk = 0.f;
#pragma unroll
            for (int e = 0; e < 4; ++e) { const f32x4 a = ld_bf4(Y0 + (size_t)m * D + c0 + 4 * e) + ld_bf4(Y1 + (size_t)m * D + c0 + 4 * e);
                y[4 * e] = a.x; y[4 * e + 1] = a.y; y[4 * e + 2] = a.z; y[4 * e + 3] = a.w; s1 += (a.x + a.y) + (a.z + a.w);
                const int c = c0 + 4 * e;
                const f32x4 rz = ld_h4(zr + ZC_R + c), kz = ld_h4(zr + ZC_K + c);
                const f32x4 rs = ld_h4(zp + ZC_R + c) * fp + ld_h4(zn + ZC_R + c) * fn, ks = ld_h4(zp + ZC_K + c) * fp + ld_h4(zn + ZC_K + c) * fn;
                const f32x4 r4 = rz + (rs - rz) * *(const f32x4*)(in[10] + c), k4 = kz + (ks - kz) * *(const f32x4*)(in[10] + D + c), w4 = *(const f32x4*)(in[22] + c);
                rk += (r4.x * k4.x * w4.x + r4.y * k4.y * w4.y) + (r4.z * k4.z * w4.z + r4.w * k4.w * w4.w); }
            s1 += __shfl_xor(s1, 1); s1 += __shfl_xor(s1, 2); rk += __shfl_xor(rk, 1); rk += __shfl_xor(rk, 2);
            const float mean = s1 * (1.0f / 64.0f); float s2 = 0.f;
#pragma unroll
            for (int e = 0; e < 16; ++e) { const float dd = y[e] - mean; s2 += dd * dd; }
            s2 += __shfl_xor(s2, 1); s2 += __shfl_xor(s2, 2);
            if (q == 0) ST[tt * 16 + head] = (f32x4){mean, rsqrtf(s2 * (1.0f / 64.0f) + 64e-5f), rk, 0.f}; }
#pragma unroll 1
        for (int g = 0; g < 4; ++g) {
            __syncthreads();
            for (int idx = tid; idx < 80 * 16; idx += NWAVES * 64) { const int rr = idx >> 4, c8 = (idx & 15) * 8, tl = rr - 8;
                v4u val = {0u, 0u, 0u, 0u};
                if (tl >= vlo && tl < vhi) val = *(const v4u*)(Z + (size_t)(m0t + tl) * NZ + ZC_POOL + g * 128 + c8);
                *(LAS v4u*)(ZP + rr * 128 + c8) = val; }
            __syncthreads();
            { const int win = 2 << g;
              for (int it = 0; it < 2; ++it) { const int item = it * 512 + tid, tt = item >> 4, c8 = (item & 15) * 8;
                  int lo = tt - win / 2, hi = tt + win - win / 2; lo = lo < vlo ? vlo : lo; hi = hi > vhi ? vhi : hi;
                  float acc8[8];
#pragma unroll
                  for (int e = 0; e < 8; ++e) acc8[e] = 0.f;
                  for (int u = lo; u < hi; ++u) { const f16x8 zv = *(const LAS f16x8*)(ZP + (u + 8) * 128 + c8);
#pragma unroll
                      for (int e = 0; e < 8; ++e) acc8[e] += (float)zv[e]; }
                  const float inv = frcp((float)(hi - lo)); const f16x8 zc = *(const LAS f16x8*)(ZP + (tt + 8) * 128 + c8);
                  unsigned o[4];
#pragma unroll
                  for (int e = 0; e < 4; ++e) o[e] = pkbf(acc8[2 * e] * inv - (float)zc[2 * e], acc8[2 * e + 1] * inv - (float)zc[2 * e + 1]);
                  *(LAS v4u*)(MX + tt * MXS + c8) = (v4u){o[0], o[1], o[2], o[3]}; } }
            __syncthreads();
            const int ch0 = wave * 32;
            bf16x8 wP[4][2], wG[4][2];
#pragma unroll
            for (int ks = 0; ks < 4; ++ks)
#pragma unroll
                for (int ct = 0; ct < 2; ++ct) { const int chl = ch0 + ct * 16 + (lane & 15);
                    wP[ks][ct] = *(const bf16x8*)(poolWT + ((size_t)g * 256 + chl) * 128 + ks * 32 + 8 * (lane >> 4));
                    wG[ks][ct] = *(const bf16x8*)(gw2T + ((size_t)g * 256 + chl) * 128 + ks * 32 + 8 * (lane >> 4)); }
#pragma unroll 1
            for (int tk = 0; tk < 4; ++tk) {
                f32x4 aP[2], aG[2];
                aP[0] = aP[1] = aG[0] = aG[1] = (f32x4){0.f, 0.f, 0.f, 0.f};
                const int tt = tk * 16 + (lane & 15), m = m0t + tt, t = m - ms;
#pragma unroll
                for (int ks = 0; ks < 4; ++ks) {
                    const bf16x8 bm = *(const LAS bf16x8*)(MX + tt * MXS + ks * 32 + 8 * (lane >> 4));
                    const bf16x8 bg = *(const LAS bf16x8*)(SG + tt * MXS + ks * 32 + 8 * (lane >> 4));
#pragma unroll
                    for (int ct = 0; ct < 2; ++ct) { aP[ct] = __builtin_amdgcn_mfma_f32_16x16x32_bf16(wP[ks][ct], bm, aP[ct], 0, 0, 0);
                                                     aG[ct] = __builtin_amdgcn_mfma_f32_16x16x32_bf16(wG[ks][ct], bg, aG[ct], 0, 0, 0); }
                }
                const f16* zr = Z + (size_t)m * NZ; const f16* zp = t > 0 ? zr - NZ : zr; const f16* zn = t < L - 1 ? zr + NZ : zr;
                const float fp = t > 0 ? 0.5f : 0.f, fn = t < L - 1 ? 0.5f : 0.f;
#pragma unroll
                for (int ct = 0; ct < 2; ++ct) { const int c = g * 256 + ch0 + ct * 16 + 4 * (lane >> 4), head = c >> 6;
                    const f32x4 lw = *(const f32x4*)(in[23] + c), lb = *(const f32x4*)(in[24] + c), muv = *(const f32x4*)(in[10] + 2 * D + c), psc = *(const f32x4*)(in[26] + c);
                    const f32x4 st = ST[tt * 16 + head];
                    const f32x4 y = ld_bf4(Y0 + (size_t)m * D + c) + ld_bf4(Y1 + (size_t)m * D + c);
                    const f32x4 vz = ld_h4(zr + ZC_V + c), vs = ld_h4(zp + ZC_V + c) * fp + ld_h4(zn + ZC_V + c) * fn; const f32x4 v4 = vz + (vs - vz) * muv;
                    const f32x4 yn = (y - st.x) * st.y * lw + lb + v4 * st.z;
                    const f32x4 bo = yn * aG[ct], ao = aP[ct] * psc;
                    const f32x4 ga = ld_h4(zr + ZC_GA + c), gb = ld_h4(zr + ZC_GB + c);
                    const f32x4 mx = ga * ao + gb * bo;
                    v2u w; w.x = pkbf(mx.x, mx.y); w.y = pkbf(mx.z, mx.w); *(v2u*)(MIX + (size_t)m * D + c) = w; }
            }
        }
    }
}

__device__ __forceinline__ void p8_final(Frame& F) {
    const int gw = F.bid * NWAVES + F.wave, NGW = F.G * NWAVES;
    const float* rss = (const float*)(F.ws + WS_RSS2); const float* gf = F.in[30];
    for (int m = gw; m < M; m += NGW) { const float rstd = rsqrtf(rss[m] * (1.0f / D) + 1e-6f); float* row = F.out + (size_t)m * D;
#pragma unroll
        for (int j = 0; j < 4; ++j) { const int c = 4 * (F.lane + 64 * j); const f32x4 x = *(const f32x4*)(row + c), g = *(const f32x4*)(gf + c); *(f32x4*)(row + c) = x * rstd * g; } }
}

__global__ void __launch_bounds__(NWAVES * 64, 2) fwd(Args args) {
    extern __shared__ __attribute__((aligned(16))) unsigned char lds_raw[];
    Frame F;
    F.lds = (LAS unsigned char*)lds_raw;
    F.tid = threadIdx.x; F.lane = F.tid & 63; F.wave = __builtin_amdgcn_readfirstlane(F.tid >> 6);
    F.G = gridDim.x; F.bid = blockIdx.x;
    F.in = args.in; F.out = args.out; F.ws = args.ws;
    volatile LAS unsigned* MISC = (volatile LAS unsigned*)(F.lds + MISC_OFF);
    if (F.tid < 32) MISC[F.tid] = 0u;
    __syncthreads();
    const int lo = args.ph_lo, hi = args.ph_hi;
    unsigned* ctl = (unsigned*)(F.ws + WS_CTL);
    XcdBarrier bar; bar.bar = ctl + CW_BAR; bar.x = 0; bar.st = nullptr;
    if (hi - lo > 1) bar = xcd_barrier_post(ctl + CW_BAR, MISC + 8);
#ifndef PH_MASK
#define PH_MASK 0x1ff
#endif
#define IN(k) (((PH_MASK >> (k)) & 1) && lo <= (k) && (k) < hi)
#define BOTH(k) (IN(k) && IN((k) + 1))
#define GRID_BAR() xcd_barrier(bar)
    bf16* H = (bf16*)(F.ws + WS_H);
    float* mod = (float*)(F.ws + WS_MOD);
    if (IN(0)) { p0_prologue(F); if (BOTH(0)) GRID_BAR(); }
    if (IN(1)) { p1_hprep(F); if (BOTH(1)) GRID_BAR(); }
    if (IN(2)) {
        pg8::Gemm g{H, (const bf16*)(F.ws + WS_WCAT), M, NZ, D}; pg8::StaticOrder S; S.init(M, NZ, F.G, F.bid);
        EpiZ E{(f16*)(F.ws + WS_Z)};
        pg8::gemm_phase<EpiZ, pg8::StaticOrder, true, true>(F.lds, g, S, E);
        if (BOTH(2)) GRID_BAR();
    }
    if (IN(3)) { p3_scan(F); if (BOTH(3)) GRID_BAR(); }
    if (IN(4)) { p4_mix(F); if (BOTH(4)) GRID_BAR(); }
    if (IN(5)) {
        pg8::Gemm g{H, (const bf16*)(F.ws + WS_WOUT), M, D, D}; pg8::StaticOrder S; S.init(M, D, F.G, F.bid);
        EpiOut1 E{args.in[0], args.in[1], F.out, (bf16*)(F.ws + WS_A2), mod, args.in[8], (float*)(F.ws + WS_RSS1)};
        pg8::gemm_phase<EpiOut1, pg8::StaticOrder, true, true>(F.lds, g, S, E);
        if (BOTH(5)) GRID_BAR();
    }
    if (IN(6)) {
        pg8::Gemm g{(const bf16*)(F.ws + WS_A2), (const bf16*)(F.ws + WS_WFF1), M, FF, D}; pg8::StaticOrder S; S.init(M, FF, F.G, F.bid);
        EpiFF1 E{(const float*)(F.ws + WS_RSS1), (const float*)(F.ws + WS_C1), (bf16*)(F.ws + WS_ACT)};
        pg8::gemm_phase<EpiFF1, pg8::StaticOrder, true, true>(F.lds, g, S, E);
        if (BOTH(6)) GRID_BAR();
    }
    if (IN(7)) {
        pg8::Gemm g{(const bf16*)(F.ws + WS_ACT), (const bf16*)(F.ws + WS_WFF2), M, D, FF}; pg8::StaticOrder S; S.init(M, D, F.G, F.bid);
        EpiOut2 E{F.out, mod, (float*)(F.ws + WS_RSS2)};
        pg8::gemm_phase<EpiOut2, pg8::StaticOrder, true, true>(F.lds, g, S, E);
        if (BOTH(7)) GRID_BAR();
    }
    if (IN(8)) { p8_final(F); }
#undef IN
#undef BOTH
#undef GRID_BAR
}

extern "C" void kernel_launch(void* const* d_in, const int* in_sizes, int n_in, void* d_out, int out_size, void* d_ws, size_t ws_size, hipStream_t stream) {
    static int grid = 0;
    if (grid == 0) {
        if (n_in != 31 || ws_size < WS_END) { fprintf(stderr, "kernel_launch: expected 31 inputs and >= %zu bytes of workspace; got %d, %zu\n", (size_t)WS_END, n_in, ws_size); grid = -1; return; }
        int dev = 0, cus = 0, per_cu = 0;
        if (hipGetDevice(&dev) != hipSuccess || hipDeviceGetAttribute(&cus, hipDeviceAttributeMultiprocessorCount, dev) != hipSuccess) { grid = -1; return; }
        if (hipFuncSetAttribute((const void*)fwd, hipFuncAttributeMaxDynamicSharedMemorySize, LDS_BYTES) != hipSuccess) { fprintf(stderr, "kernel_launch: hipFuncSetAttribute failed\n"); grid = -1; return; }
        if (hipOccupancyMaxActiveBlocksPerMultiprocessor(&per_cu, (const void*)fwd, NWAVES * 64, LDS_BYTES) != hipSuccess || per_cu < 1) { fprintf(stderr, "kernel_launch: occupancy query says %d workgroups per CU\n", per_cu); (void)hipGetLastError(); grid = -1; return; }
        grid = cus;
    }
    if (grid < 0) return;
    if (hipMemsetAsync((char*)d_ws + WS_CTL, 0, CTL_ZERO_BYTES, stream) != hipSuccess) return;
    Args a{};
    for (int i = 0; i < 31; ++i) a.in[i] = (const float*)d_in[i];
    a.out = (float*)d_out; a.ws = (unsigned char*)d_ws;
    if (MK_N_LAUNCHES == 1) {
        a.ph_lo = 0; a.ph_hi = NPHASE;
        void* kargs[] = {&a};
        hipError_t e = hipLaunchCooperativeKernel((const void*)fwd, dim3(grid), dim3(NWAVES * 64), kargs, LDS_BYTES, stream);
        if (e != hipSuccess) fprintf(stderr, "kernel_launch: cooperative launch failed: %s (grid %d)\n", hipGetErrorString(e), grid);
    } else {
        for (int p = 0; p < NPHASE; ++p) { a.ph_lo = p; a.ph_hi = p + 1; hipLaunchKernelGGL(fwd, dim3(grid), dim3(NWAVES * 64), LDS_BYTES, stream, a); }
    }
}
```

```cpp
#include <hip/hip_runtime.h>
#include <cstdio>
#include <cstdint>
namespace pg8 {
#define PG8_LAS __attribute__((address_space(3)))
typedef unsigned short bf16_t;
typedef short bf16x8 __attribute__((ext_vector_type(8)));
typedef float f32x4 __attribute__((ext_vector_type(4)));
typedef unsigned u32x4 __attribute__((ext_vector_type(4)));
constexpr int BM = 256, BK = 64, HALF = 128, HTB = HALF * BK * 2  , STAGE_BYTES = 8 * HTB, NXCD = 8, WGM = 8;

__host__ __device__ __forceinline__ int lds_byte(int r, int c) { const int st = (r >> 4) * 2 + (c >> 5), rr = r & 15, cc = c & 31, ob = rr * 64 + cc * 2; return st * 1024 + (ob ^ (((ob >> 9) & 1) << 5)); }
__host__ __device__ __forceinline__ void stage_rc(int b, int& R, int& C) { const int st = b / 1024, sb = b % 1024, swz = sb ^ (((sb >> 9) & 1) << 5); R = (st >> 1) * 16 + swz / 64; C = (st & 1) * 32 + (swz % 64) / 2; }
__host__ __device__ __forceinline__ int perm32(int rho) { const int n = rho >> 4, i = rho & 15; return 8 * (i >> 2) + 4 * n + (i & 3); }

struct Unit { int pm, pn; };
struct Gemm { const bf16_t* A; const bf16_t* Bt; int M, N, K; };

struct StaticOrder {
    int nM, nN, nwg, G, c;
    __host__ __device__ void init(int M, int N, int G_, int c_) { nM = M / BM; nN = N / BM; nwg = nM * nN; G = G_; c = c_; }
    __host__ __device__ bool next(int i, Unit& u) const {
        const long L = (long)i * G + c; if (L >= nwg) return false;
        int wgid = (int)L; { const int q = nwg / NXCD, r = nwg % NXCD, xcd = wgid % NXCD, off = wgid / NXCD; wgid = (xcd < r ? xcd * (q + 1) : r * (q + 1) + (xcd - r) * q) + off; }
        const int nig = WGM * nN, gid = wgid / nig, fm = gid * WGM, gsz = (nM - fm) < WGM ? (nM - fm) : WGM;
        u.pm = fm + ((wgid % nig) % gsz); u.pn = (wgid % nig) / gsz; return true;
    }
    __device__ __forceinline__ void a_ready(const Unit&) const {}
    __device__ __forceinline__ void done(const Unit&) const {}
};

__device__ __forceinline__ unsigned cvt_pk_bf16(float lo, float hi) { unsigned r; asm volatile("v_cvt_pk_bf16_f32 %0, %1, %2" : "=v"(r) : "v"(lo), "v"(hi)); return r; }
typedef float f32x2 __attribute__((ext_vector_type(2)));
template <class Epi, class Sched, bool ALIGN_EPI = false, bool SP2 = false>
__device__ __forceinline__ void gemm_phase(PG8_LAS unsigned char* lds, const Gemm g, const Sched& S, const Epi& E) {
    const int tid = threadIdx.x, wid = __builtin_amdgcn_readfirstlane(tid >> 6), lane = tid & 63, wr = wid >> 2, wc = wid & 3, fr = lane & 15, fq = lane >> 4;
    const int K = g.K, nt = K / BK;
    unsigned voffA[2], voffB[2];
#pragma unroll
    for (int i = 0; i < 2; ++i) { int R, C; stage_rc(tid * 16 + i * 8192, R, C); const int Rb = Epi::PERM ? ((R & ~31) + perm32(R & 31)) : R;
        voffA[i] = (unsigned)(R * K + C) * 2u; voffB[i] = (unsigned)(Rb * K + C) * 2u; }
    const size_t kstep = (size_t)(BK * 2);
    const size_t hstep = (size_t)HALF * K * 2;
    const size_t tstep = 2 * hstep;
    const unsigned ldsw = (unsigned)wid * 1024u;
    const int aoff = lds_byte(wr * 64 + fr, fq * 8), boff = lds_byte(wc * 32 + fr, fq * 8);
#define PG8_SA(b, h) (((b) * 2 + (h)) * HTB)
#define PG8_SB(b, h) ((4 + (b) * 2 + (h)) * HTB)
#define PG8_STAGE(bufoff, gbase, voff) do { _Pragma("unroll") for (int _i = 0; _i < 2; ++_i) \
        __builtin_amdgcn_global_load_lds((const unsigned*)((const char*)(gbase) + (voff)[_i]), (PG8_LAS unsigned*)(lds + (bufoff) + ldsw + _i * 8192), 16, 0, 0); } while (0)
#define PG8_LDA(dst, b, h) do { _Pragma("unroll") for (int m = 0; m < 4; ++m) _Pragma("unroll") for (int k = 0; k < 2; ++k) dst[m][k] = *(const PG8_LAS bf16x8*)(lds + PG8_SA(b, h) + aoff + m * 2048 + k * 1024); } while (0)
#define PG8_LDB(dst, b, h) do { _Pragma("unroll") for (int n = 0; n < 2; ++n) _Pragma("unroll") for (int k = 0; k < 2; ++k) dst[n][k] = *(const PG8_LAS bf16x8*)(lds + PG8_SB(b, h) + boff + n * 2048 + k * 1024); } while (0)
#define PG8_MMA(ai, bj, At, Bt) do { __builtin_amdgcn_s_setprio(1); _Pragma("unroll") for (int m = 0; m < 4; ++m) _Pragma("unroll") for (int n = 0; n < 2; ++n) _Pragma("unroll") for (int k = 0; k < 2; ++k) \
        acc[ai][bj][m][n] = __builtin_amdgcn_mfma_f32_16x16x32_bf16(Bt[n][k], At[m][k], acc[ai][bj][m][n], 0, 0, 0); __builtin_amdgcn_s_setprio(0); } while (0)
#define PG8_WAIT_V(n) asm volatile("s_waitcnt vmcnt(" #n ")" ::: "memory")
#define PG8_WAIT_L(n) asm volatile("s_waitcnt lgkmcnt(" #n ")" ::: "memory")
#define PG8_BAR __builtin_amdgcn_s_barrier()
#define PG8_SCHED __builtin_amdgcn_sched_barrier(0)
    Unit cur, nxt; int ui = 0;
    if (!S.next(0, cur)) return;
    f32x4 acc[2][2][4][2];
#pragma unroll
    for (int a = 0; a < 2; ++a)
#pragma unroll
        for (int b = 0; b < 2; ++b)
#pragma unroll
            for (int m = 0; m < 4; ++m)
#pragma unroll
                for (int n = 0; n < 2; ++n) acc[a][b][m][n] = (f32x4){0.f, 0.f, 0.f, 0.f};
    bf16x8 At[4][2], B0[2][2], B1[2][2];
    const char* cA = (const char*)g.A + (size_t)cur.pm * tstep; const char* cB = (const char*)g.Bt + (size_t)cur.pn * tstep;
    S.a_ready(cur);
    if constexpr (SP2) {
        PG8_STAGE(PG8_SB(0, 0), cB, voffB); PG8_STAGE(PG8_SB(0, 1), cB + hstep, voffB); PG8_STAGE(PG8_SA(0, 0), cA, voffA); PG8_STAGE(PG8_SA(0, 1), cA + hstep, voffA);
        if (wr == 1) PG8_BAR;
        PG8_WAIT_V(2); PG8_BAR;
        PG8_STAGE(PG8_SB(1, 0), cB + kstep, voffB); PG8_STAGE(PG8_SA(1, 0), cA + kstep, voffA); PG8_STAGE(PG8_SB(1, 1), cB + hstep + kstep, voffB);
        PG8_WAIT_V(6); PG8_BAR;
    } else {
        PG8_STAGE(PG8_SB(0, 0), cB, voffB); PG8_STAGE(PG8_SA(0, 0), cA, voffA); PG8_STAGE(PG8_SB(0, 1), cB + hstep, voffB); PG8_STAGE(PG8_SA(0, 1), cA + hstep, voffA);
        if (wr == 1) PG8_BAR;
        PG8_WAIT_V(4); PG8_BAR;
        PG8_STAGE(PG8_SB(1, 0), cB + kstep, voffB); PG8_STAGE(PG8_SA(1, 0), cA + kstep, voffA); PG8_STAGE(PG8_SB(1, 1), cB + hstep + kstep, voffB);
        PG8_WAIT_V(6); PG8_BAR;
    }
    for (;;) {
        const bool has_next = S.next(ui + 1, nxt);
        const char* nA = has_next ? (const char*)g.A + (size_t)nxt.pm * tstep : cA; const char* nB = has_next ? (const char*)g.Bt + (size_t)nxt.pn * tstep : cB;
        for (int t = 0; t < nt; t += 2) {
            const bool last = (t == nt - 2);
            const char* a1 = cA + (size_t)(t + 1) * kstep;
            const char* a2 = last ? nA : cA + (size_t)(t + 2) * kstep; const char* b2 = last ? nB : cB + (size_t)(t + 2) * kstep;
            const char* a3 = a2 + kstep; const char* b3 = b2 + kstep;
            if (last && has_next) S.a_ready(nxt);
            if constexpr (SP2) {
            PG8_LDB(B0, 0, 0); PG8_LDB(B1, 0, 1); PG8_SCHED; PG8_LDA(At, 0, 0); PG8_STAGE(PG8_SA(1, 1), a1 + hstep, voffA);
            PG8_WAIT_V(8); PG8_WAIT_L(0); PG8_BAR; PG8_MMA(0, 0, At, B0); PG8_MMA(0, 1, At, B1); PG8_BAR; PG8_SCHED;
            PG8_LDA(At, 0, 1); PG8_STAGE(PG8_SB(0, 0), b2, voffB); PG8_STAGE(PG8_SB(0, 1), b2 + hstep, voffB); PG8_STAGE(PG8_SA(0, 0), a2, voffA);
            PG8_WAIT_V(8); PG8_WAIT_L(0); PG8_BAR; PG8_MMA(1, 0, At, B0); PG8_MMA(1, 1, At, B1); PG8_BAR; PG8_SCHED;
            PG8_LDB(B0, 1, 0); PG8_LDB(B1, 1, 1); PG8_SCHED; PG8_LDA(At, 1, 0); PG8_STAGE(PG8_SA(0, 1), a2 + hstep, voffA);
            PG8_WAIT_V(8); PG8_WAIT_L(0); PG8_BAR; PG8_MMA(0, 0, At, B0); PG8_MMA(0, 1, At, B1); PG8_BAR; PG8_SCHED;
            PG8_LDA(At, 1, 1); PG8_STAGE(PG8_SB(1, 0), b3, voffB); PG8_STAGE(PG8_SB(1, 1), b3 + hstep, voffB); PG8_STAGE(PG8_SA(1, 0), a3, voffA);
            PG8_WAIT_V(8); PG8_WAIT_L(0); PG8_BAR; PG8_MMA(1, 0, At, B0); PG8_MMA(1, 1, At, B1); PG8_BAR; PG8_SCHED;
            } else {
            PG8_LDB(B0, 0, 0); PG8_SCHED; PG8_LDA(At, 0, 0); PG8_STAGE(PG8_SA(1, 1), a1 + hstep, voffA);
            PG8_WAIT_L(8); PG8_BAR; PG8_WAIT_L(0); PG8_MMA(0, 0, At, B0); PG8_BAR; PG8_SCHED;
            PG8_LDB(B1, 0, 1); PG8_STAGE(PG8_SB(0, 0), b2, voffB);
            PG8_BAR; PG8_WAIT_L(0); PG8_MMA(0, 1, At, B1); PG8_BAR;
            PG8_LDA(At, 0, 1); PG8_STAGE(PG8_SA(0, 0), a2, voffA);
            PG8_BAR; PG8_WAIT_L(0); PG8_MMA(1, 0, At, B0); PG8_BAR; PG8_SCHED;
            PG8_STAGE(PG8_SB(0, 1), b2 + hstep, voffB);
            PG8_WAIT_V(6); PG8_BAR; PG8_MMA(1, 1, At, B1); PG8_BAR;
            PG8_LDB(B0, 1, 0); PG8_SCHED; PG8_LDA(At, 1, 0); PG8_STAGE(PG8_SA(0, 1), a2 + hstep, voffA);
            PG8_WAIT_L(8); PG8_BAR; PG8_WAIT_L(0); PG8_MMA(0, 0, At, B0); PG8_BAR; PG8_SCHED;
            PG8_LDB(B1, 1, 1); PG8_STAGE(PG8_SB(1, 0), b3, voffB);
            PG8_BAR; PG8_WAIT_L(0); PG8_MMA(0, 1, At, B1); PG8_BAR;
            PG8_LDA(At, 1, 1); PG8_STAGE(PG8_SA(1, 0), a3, voffA);
            PG8_BAR; PG8_WAIT_L(0); PG8_MMA(1, 0, At, B0); PG8_BAR; PG8_SCHED;
            PG8_STAGE(PG8_SB(1, 1), b3 + hstep, voffB);
            PG8_WAIT_V(6); PG8_BAR; PG8_MMA(1, 1, At, B1); PG8_BAR;
            }
        }
        if constexpr (ALIGN_EPI) { if (wr == 0) PG8_BAR; }
        if constexpr (!Epi::AFTER_DRAIN) { E(acc, cur, wr, wc, fr, fq); S.done(cur); }
        if (!has_next) break;
#pragma unroll
        for (int a = 0; a < 2; ++a)
#pragma unroll
            for (int b = 0; b < 2; ++b)
#pragma unroll
                for (int m = 0; m < 4; ++m)
#pragma unroll
                    for (int n = 0; n < 2; ++n) acc[a][b][m][n] = (f32x4){0.f, 0.f, 0.f, 0.f};
        cur = nxt; cA = nA; cB = nB; ++ui;
        if constexpr (ALIGN_EPI) { if (wr == 1) PG8_BAR; }
    }
    PG8_WAIT_V(0);
    if constexpr (!ALIGN_EPI) { if (wr == 0) PG8_BAR; }
    PG8_BAR;
    if constexpr (Epi::AFTER_DRAIN) { E.fused(acc, cur, wr, wc, fr, fq, lds, wid, lane); S.done(cur); }
#undef PG8_SA
#undef PG8_SB
#undef PG8_STAGE
#undef PG8_LDA
#undef PG8_LDB
#undef PG8_MMA
#undef PG8_WAIT_V
#undef PG8_WAIT_L
#undef PG8_BAR
#undef PG8_SCHED
}
}

#ifndef MK_N_LAUNCHES
#define MK_N_LAUNCHES 1
#endif
constexpr int NWAVES = 8;
constexpr int D = 1024, NH = 16, HD = 64, FF = 4096;
constexpr int M_CTX = 16 * 256, M_LAT = 4 * 2048, M = M_CTX + M_LAT;
constexpr int L_CTX = 256, L_LAT = 2048;
constexpr int NMOD = 6 * D;
constexpr int ZC_POOL = 0, ZC_R = 512, ZC_K = 1536, ZC_V = 2560, ZC_GA = 3584, ZC_GB = 4608;
constexpr int ZC_LW_A = 5632, ZC_LW_B = 5760, ZC_LA_A = 5888, ZC_LA_B = 6016, ZC_LG_A = 6144, ZC_LG_B = 6272, NZ = 6400;
constexpr int NPHASE = 9;

constexpr size_t MiB = 1u << 20;
constexpr size_t WS_CTL = 0, CTL_ZERO_BYTES = 1 * MiB;
constexpr int CW_BAR = 4096;
constexpr size_t WS_RSS1 = 256 * 1024, WS_RSS2 = 320 * 1024;
constexpr size_t WS_MOD = 1 * MiB, WS_C1 = 1 * MiB + 128 * 1024;
constexpr size_t WS_WCAT = 2 * MiB, WS_WOUT = 15 * MiB, WS_WFF1 = 17 * MiB, WS_WFF2 = 25 * MiB;
constexpr size_t WS_POOLW = 33 * MiB, WS_GW2T = 33 * MiB + 256 * 1024;
constexpr size_t WS_H = 34 * MiB;
constexpr size_t WS_Z = 58 * MiB;
constexpr size_t WS_ACT = 58 * MiB;
constexpr size_t WS_A2 = 154 * MiB;
constexpr size_t WS_END = 208 * MiB;
static_assert(WS_WCAT + (size_t)NZ * D * 2 <= WS_WOUT && WS_Z + (size_t)M * NZ * 2 <= WS_END && WS_ACT + (size_t)M * FF * 2 <= WS_A2 && WS_A2 + (size_t)M * D * 2 <= WS_END, "ws map");

constexpr int LDS_BYTES = 147456;
constexpr int RING_BYTES = 131072, MISC_OFF = 147200;

#define GAS __attribute__((address_space(1)))
#define LAS __attribute__((address_space(3)))
typedef unsigned short bf16;
typedef _Float16 f16;
typedef unsigned v4u __attribute__((ext_vector_type(4)));
typedef unsigned v2u __attribute__((ext_vector_type(2)));
typedef float f32x4 __attribute__((ext_vector_type(4)));
typedef float f32x2 __attribute__((ext_vector_type(2)));
typedef short bf16x8 __attribute__((ext_vector_type(8)));
typedef _Float16 f16x4 __attribute__((ext_vector_type(4)));
typedef _Float16 f16x8 __attribute__((ext_vector_type(8)));
typedef _Float16 f16x2 __attribute__((ext_vector_type(2)));
typedef GAS unsigned gu32;
#define RLX_AGENT __ATOMIC_RELAXED, __HIP_MEMORY_SCOPE_AGENT
#define LDS_WAIT() asm volatile("s_waitcnt lgkmcnt(0)" ::: "memory")
#define VM_WAIT() asm volatile("s_waitcnt vmcnt(0)" ::: "memory")

typedef __bf16 bf16x2_t __attribute__((ext_vector_type(2)));
__device__ __forceinline__ unsigned pkbf(float lo, float hi) { f32x2 v = {lo, hi}; bf16x2_t b = __builtin_convertvector(v, bf16x2_t); return __builtin_bit_cast(unsigned, b); }
__device__ __forceinline__ unsigned pkh(float lo, float hi) { f16x2 v = {(f16)lo, (f16)hi}; return __builtin_bit_cast(unsigned, v); }
__device__ __forceinline__ float bf2f(unsigned short b) { return __builtin_bit_cast(float, (unsigned)b << 16); }
__device__ __forceinline__ f32x4 ld_h4(const f16* p) { const f16x4 v = *(const f16x4*)p; return __builtin_convertvector(v, f32x4); }
__device__ __forceinline__ f32x4 ld_bf4(const bf16* p) { const v2u v = *(const v2u*)p; f32x4 r; r.x = __builtin_bit_cast(float, v.x << 16); r.y = __builtin_bit_cast(float, v.x & 0xffff0000u);
    r.z = __builtin_bit_cast(float, v.y << 16); r.w = __builtin_bit_cast(float, v.y & 0xffff0000u); return r; }
__device__ __forceinline__ float frcp(float x) { return __builtin_amdgcn_rcpf(x); }
__device__ __forceinline__ float sigmoidf_(float x) { return frcp(1.0f + __expf(-x)); }
__device__ __forceinline__ float wave_sum(float v) {
#pragma unroll
    for (int o = 1; o < 64; o <<= 1) v += __shfl_xor(v, o);
    return v;
}
__device__ __forceinline__ int cvec_of_row(int m) { return m < M_CTX ? 0 : 1 + (m - M_CTX) / L_LAT; }

#define XB_TMO      128
#define XB_XCNT(j)  (256  + 64 * (j))
#define XB_XSUB(j)  (1280 + 64 * (j))
#define XB_XGEN(j)  (2304 + 64 * (j))
#define XB_TOP      3328
#define XB_TOPGEN   3392
#define XCD_BAR_WORDS 3456
#define XB_SPIN_CAP (1u << 18)
__device__ __forceinline__ unsigned xb_ld(unsigned* p)              { return __hip_atomic_load(p, __ATOMIC_RELAXED, __HIP_MEMORY_SCOPE_AGENT); }
__device__ __forceinline__ unsigned xb_add(unsigned* p, unsigned v) { return __hip_atomic_fetch_add(p, v, __ATOMIC_RELAXED, __HIP_MEMORY_SCOPE_AGENT); }
__device__ __forceinline__ unsigned xb_xcc_id() { return (unsigned)__builtin_amdgcn_s_getreg((3 << 11) | 20) & 0xFu; }
#define XB_SPIN(cond, bar) do { unsigned _sp = 0; while (cond) { __builtin_amdgcn_s_sleep(1); \
    if ((++_sp & 255u) == 0u) { if (xb_ld(&(bar)[XB_TMO])) break; if (_sp > XB_SPIN_CAP) { atomicAdd(&(bar)[XB_TMO], 1u); break; } } } } while (0)
struct XcdBarrier { unsigned* bar; unsigned x; volatile LAS unsigned* st; };
__device__ __forceinline__ XcdBarrier xcd_barrier_post(unsigned* bar, volatile LAS unsigned* st) {
    XcdBarrier b; b.bar = bar; b.x = xb_xcc_id(); b.st = st;
    if (threadIdx.x == 0) (void)xb_add(&bar[XB_XCNT(b.x)], 1u);
    return b;
}
__device__ __forceinline__ void xcd_barrier_complete(unsigned* bar, unsigned x, unsigned& nloc, unsigned& nx) {
    const unsigned G = gridDim.x * gridDim.y * gridDim.z;
    unsigned sum, cnt, mine, sp = 0u;
    for (;;) {
        sum = 0u; cnt = 0u; mine = 0u;
#pragma unroll
        for (unsigned j = 0; j < 16; ++j) { const unsigned c = xb_ld(&bar[XB_XCNT(j)]); sum += c; cnt += (c > 0u) ? 1u : 0u; mine = (j == x) ? c : mine; }
        if (sum == G) break;
        __builtin_amdgcn_s_sleep(1);
        if ((++sp & 255u) == 0u) { if (xb_ld(&bar[XB_TMO])) break; if (sp > XB_SPIN_CAP) { atomicAdd(&bar[XB_TMO], 1u); break; } }
    }
    nloc = mine > 0u ? mine : 1u; nx = cnt > 0u ? cnt : 1u;
}
__device__ __forceinline__ void xcd_barrier(const XcdBarrier& b) {
    asm volatile("s_waitcnt vmcnt(0)" ::: "memory");
    __syncthreads();
    if (threadIdx.x == 0) {
        unsigned* bar = b.bar;
        __builtin_amdgcn_s_waitcnt(0);
        unsigned nloc = b.st[0], nx = b.st[1];
        if (nloc == 0u) { xcd_barrier_complete(bar, b.x, nloc, nx); b.st[0] = nloc; b.st[1] = nx; }
        const unsigned old = xb_add(&bar[XB_XSUB(b.x)], 1u);
        const unsigned gen = old / nloc;
        if (old + 1u == (gen + 1u) * nloc) {
            __builtin_amdgcn_fence(__ATOMIC_RELEASE, "agent");
            asm volatile("s_waitcnt vmcnt(0)" ::: "memory");
            const unsigned og = xb_add(&bar[XB_TOP], 1u);
            const unsigned tg = og / nx;
            if (og + 1u == (tg + 1u) * nx) xb_add(&bar[XB_TOPGEN], 1u);
            else XB_SPIN(xb_ld(&bar[XB_TOPGEN]) == tg, bar);
            __builtin_amdgcn_fence(__ATOMIC_ACQUIRE, "agent");
            xb_add(&bar[XB_XGEN(b.x)], 1u);
            asm volatile("s_waitcnt vmcnt(0)" ::: "memory");
        } else {
            XB_SPIN(xb_ld(&bar[XB_XGEN(b.x)]) == gen, bar);
            __builtin_amdgcn_fence(__ATOMIC_ACQUIRE, "agent");
            asm volatile("s_waitcnt vmcnt(0)" ::: "memory");
        }
    }
    __syncthreads();
}

struct EpiZ {
    static constexpr bool PERM = true, AFTER_DRAIN = false;
    f16* Z;
    __device__ __forceinline__ void operator()(const f32x4 (&acc)[2][2][4][2], const pg8::Unit& u, int wr, int wc, int fr, int fq) const {
        const int row0 = u.pm * 256 + wr * 64 + fr, col0 = u.pn * 256 + wc * 32 + 8 * fq;
        const bool sig = (u.pn >= ZC_GA / 256) && (u.pn < ZC_LW_A / 256);
#pragma unroll
        for (int ai = 0; ai < 2; ++ai)
#pragma unroll
            for (int m = 0; m < 4; ++m) { f16* rowp = Z + (size_t)(row0 + ai * 128 + m * 16) * NZ + col0;
#pragma unroll
                for (int bj = 0; bj < 2; ++bj) { f32x4 v0 = acc[ai][bj][m][0], v1 = acc[ai][bj][m][1];
                    if (sig) {
#pragma unroll
                        for (int e = 0; e < 4; ++e) { v0[e] = sigmoidf_(v0[e]); v1[e] = sigmoidf_(v1[e]); } }
                    v4u w; w.x = pkh(v0[0], v0[1]); w.y = pkh(v0[2], v0[3]); w.z = pkh(v1[0], v1[1]); w.w = pkh(v1[2], v1[3]);
                    *(v4u*)(rowp + bj * 128) = w; } }
    }
};
struct EpiOut1 {
    static constexpr bool PERM = false, AFTER_DRAIN = false;
    const float* xp; const float* xs; float* X1; bf16* A2; const float* mod; const float* g2; float* rowss;
    __device__ __forceinline__ void operator()(const f32x4 (&acc)[2][2][4][2], const pg8::Unit& u, int wr, int wc, int fr, int fq) const {
        const int ci = cvec_of_row(u.pm * 256);
        const float* xb = (u.pm < M_CTX / 256) ? xp + (size_t)u.pm * 256 * D : xs + (size_t)(u.pm - M_CTX / 256) * 256 * D;
        const int col0 = u.pn * 256 + wc * 32 + 4 * fq;
        f32x4 ga[2][2], gm[2][2];
#pragma unroll
        for (int bj = 0; bj < 2; ++bj)
#pragma unroll
            for (int n = 0; n < 2; ++n) { const int c = col0 + bj * 128 + n * 16;
                ga[bj][n] = *(const f32x4*)(mod + ci * NMOD + 2 * D + c);
                const f32x4 sc = *(const f32x4*)(mod + ci * NMOD + 4 * D + c), g = *(const f32x4*)(g2 + c); gm[bj][n] = g * (sc + 1.0f); }
#pragma unroll
        for (int ai = 0; ai < 2; ++ai)
#pragma unroll
            for (int m = 0; m < 4; ++m) { const int rl = ai * 128 + wr * 64 + m * 16 + fr; const size_t r = (size_t)u.pm * 256 + rl; float ss = 0.f;
#pragma unroll
                for (int bj = 0; bj < 2; ++bj)
#pragma unroll
                    for (int n = 0; n < 2; ++n) { const int c = col0 + bj * 128 + n * 16;
                        const f32x4 x = *(const f32x4*)(xb + (size_t)rl * D + c); const f32x4 x1 = x + ga[bj][n] * acc[ai][bj][m][n];
                        *(f32x4*)(X1 + r * D + c) = x1; ss += (x1[0] * x1[0] + x1[1] * x1[1]) + (x1[2] * x1[2] + x1[3] * x1[3]);
                        const f32x4 a = x1 * gm[bj][n]; v2u w; w.x = pkbf(a[0], a[1]); w.y = pkbf(a[2], a[3]); *(v2u*)(A2 + r * D + c) = w; }
                ss += __shfl_xor(ss, 16); ss += __shfl_xor(ss, 32);
                if (fq == 0) atomicAdd(rowss + r, ss); }
    }
};
struct EpiFF1 {
    static constexpr bool PERM = true, AFTER_DRAIN = false;
    const float* rowss; const float* c1; bf16* ACT;
    __device__ __forceinline__ void operator()(const f32x4 (&acc)[2][2][4][2], const pg8::Unit& u, int wr, int wc, int fr, int fq) const {
        const int ci = cvec_of_row(u.pm * 256);
        const int row0 = u.pm * 256 + wr * 64 + fr, col0 = u.pn * 256 + wc * 32 + 8 * fq;
        f32x4 cb[2][2];
#pragma unroll
        for (int bj = 0; bj < 2; ++bj)
#pragma unroll
            for (int n = 0; n < 2; ++n) cb[bj][n] = *(const f32x4*)(c1 + ci * FF + col0 + bj * 128 + 4 * n);
#pragma unroll
        for (int ai = 0; ai < 2; ++ai)
#pragma unroll
            for (int m = 0; m < 4; ++m) { const int r = row0 + ai * 128 + m * 16; const float rstd = rsqrtf(rowss[r] * (1.0f / D) + 1e-6f);
                bf16* rowp = ACT + (size_t)r * FF + col0;
#pragma unroll
                for (int bj = 0; bj < 2; ++bj) { f32x4 v0 = acc[ai][bj][m][0] * rstd + cb[bj][0], v1 = acc[ai][bj][m][1] * rstd + cb[bj][1];
#pragma unroll
                    for (int e = 0; e < 4; ++e) { const float a = fmaxf(v0[e], 0.f), b = fmaxf(v1[e], 0.f); v0[e] = a * a; v1[e] = b * b; }
                    v4u w; w.x = pkbf(v0[0], v0[1]); w.y = pkbf(v0[2], v0[3]); w.z = pkbf(v1[0], v1[1]); w.w = pkbf(v1[2], v1[3]);
                    *(v4u*)(rowp + bj * 128) = w; } }
    }
};
struct EpiOut2 {
    static constexpr bool PERM = false, AFTER_DRAIN = false;
    float* X; const float* mod; float* rowss;
    __device__ __forceinline__ void operator()(const f32x4 (&acc)[2][2][4][2], const pg8::Unit& u, int wr, int wc, int fr, int fq) const {
        const int ci = cvec_of_row(u.pm * 256);
        const int col0 = u.pn * 256 + wc * 32 + 4 * fq;
        f32x4 ga[2][2];
#pragma unroll
        for (int bj = 0; bj < 2; ++bj)
#pragma unroll
            for (int n = 0; n < 2; ++n) ga[bj][n] = *(const f32x4*)(mod + ci * NMOD + 5 * D + col0 + bj * 128 + n * 16);
#pragma unroll
        for (int ai = 0; ai < 2; ++ai)
#pragma unroll
            for (int m = 0; m < 4; ++m) { const size_t r = (size_t)u.pm * 256 + ai * 128 + wr * 64 + m * 16 + fr; float ss = 0.f;
#pragma unroll
                for (int bj = 0; bj < 2; ++bj)
#pragma unroll
                    for (int n = 0; n < 2; ++n) { const int c = col0 + bj * 128 + n * 16;
                        const f32x4 x = *(const f32x4*)(X + r * D + c); const f32x4 x2 = x + ga[bj][n] * acc[ai][bj][m][n];
                        *(f32x4*)(X + r * D + c) = x2; ss += (x2[0] * x2[0] + x2[1] * x2[1]) + (x2[2] * x2[2] + x2[3] * x2[3]); }
                ss += __shfl_xor(ss, 16); ss += __shfl_xor(ss, 32);
                if (fq == 0) atomicAdd(rowss + r, ss); }
    }
};

struct Args { const float* in[31]; float* out; unsigned char* ws; int ph_lo, ph_hi; };
struct Frame {
    LAS unsigned char* lds;
    int tid, lane, wave, G, bid;
    const float* const* in;
    float* out; unsigned char* ws;
};

__device__ __forceinline__ void tr_item(const float* W, int ldw, const float* mu, int mode, bf16* WT, int ldk, LAS float* scr, int kb, int nb, int lane) {
    const int k0 = 64 * kb, n0 = 32 * nb;
#pragma unroll 8
    for (int i = 0; i < 32; ++i) { const int kk = 2 * i + (lane >> 5); float v = W[(size_t)(k0 + kk) * ldw + n0 + (lane & 31)];
        if (mode) { const float mm = mu[k0 + kk]; v *= (mode == 1) ? (1.0f - mm) : mm; }
        scr[kk * 33 + (lane & 31)] = v; }
    LDS_WAIT(); asm volatile("" ::: "memory");
    const int c = lane & 7;
#pragma unroll
    for (int j = 0; j < 4; ++j) { const int n = (lane >> 3) + 8 * j; const LAS float* s = scr + (8 * c) * 33 + n;
        v4u o; o.x = pkbf(s[0 * 33], s[1 * 33]); o.y = pkbf(s[2 * 33], s[3 * 33]); o.z = pkbf(s[4 * 33], s[5 * 33]); o.w = pkbf(s[6 * 33], s[7 * 33]);
        *(GAS v4u*)(WT + (size_t)(n0 + n) * ldk + k0 + 8 * c) = o; }
    LDS_WAIT(); asm volatile("" ::: "memory");
}
__device__ __forceinline__ void p0_prologue(Frame& F) {
    const float* const* in = F.in;
    {
        LAS float* sl = (LAS float*)(F.lds + 98304);
        LAS float* red = (LAS float*)(F.lds + 98304 + 20480);
        if (F.bid < 192 || F.G < 192) {
            for (int i = F.tid; i < 5 * D; i += NWAVES * 64) { const int ci = i >> 10, k = i & 1023; const float x = ci == 0 ? in[4][k] : in[3][(ci - 1) * D + k]; sl[i] = x * frcp(1.0f + __expf(-x)); }
            __syncthreads();
            float* mod = (float*)(F.ws + WS_MOD);
            for (int item = F.bid; item < 192; item += F.G) {
                const int col = F.tid & 31, ks = F.tid >> 5, n = item * 32 + col;
                float a0 = 0.f, a1 = 0.f, a2 = 0.f, a3 = 0.f, a4 = 0.f;
                const float* wp = in[5] + (size_t)(ks * 64) * NMOD + n;
#pragma unroll 8
                for (int k = 0; k < 64; ++k) { const float w = wp[(size_t)k * NMOD]; const int kk = ks * 64 + k;
                    a0 += sl[kk] * w; a1 += sl[1024 + kk] * w; a2 += sl[2048 + kk] * w; a3 += sl[3072 + kk] * w; a4 += sl[4096 + kk] * w; }
                LAS float* rp = red + (ks * 32 + col) * 5; rp[0] = a0; rp[1] = a1; rp[2] = a2; rp[3] = a3; rp[4] = a4;
                __syncthreads();
                if (F.tid < 160) { const int ci = F.tid >> 5, cc = F.tid & 31; float s = in[6][item * 32 + cc];
#pragma unroll
                    for (int q = 0; q < 16; ++q) s += red[(q * 32 + cc) * 5 + ci];
                    mod[ci * NMOD + item * 32 + cc] = s; }
                __syncthreads();
            }
        }
    }
    LAS float* scr = (LAS float*)(F.lds + F.wave * 12288);
    const int gw = F.bid * NWAVES + F.wave, NGW = F.G * NWAVES;
    bf16* WcatT = (bf16*)(F.ws + WS_WCAT); bf16* WoutT = (bf16*)(F.ws + WS_WOUT); bf16* Wff1T = (bf16*)(F.ws + WS_WFF1); bf16* Wff2T = (bf16*)(F.ws + WS_WFF2);
    bf16* poolWT = (bf16*)(F.ws + WS_POOLW); bf16* gw2T = (bf16*)(F.ws + WS_GW2T);
    constexpr int I_IN = 16 * 176, I_LORA = 6 * 64, I_OUT = 16 * 32, I_F1 = 16 * 128, I_F2 = 64 * 32, I_POOL = 4 * 16, I_G2 = 2 * 32;
    constexpr int NITEMS = I_IN + I_LORA + I_OUT + I_F1 + I_F2 + I_POOL + I_G2;
    for (int it = gw; it < NITEMS; it += NGW) {
        int r = it;
        if (r < I_IN) { tr_item(in[9], 5632, nullptr, 0, WcatT, D, scr, r / 176, r % 176, F.lane); continue; } r -= I_IN;
        if (r < I_LORA) { const int qs = r / 64, q = qs >> 1, s = qs & 1, rr = r % 64, kb = rr / 4, nb = rr % 4;
            const float* W; int ldw;
            if (q < 2) { W = (q == 0 ? in[13] : in[16]) + (size_t)(nb >> 1) * D * 64 + (nb & 1) * 32; ldw = 64; } else { W = in[18] + nb * 32; ldw = 128; }
            tr_item(W, ldw, in[11] + q * D, s + 1, WcatT + (size_t)(ZC_LW_A + q * 256 + s * 128 + nb * 32) * D, D, scr, kb, 0, F.lane); continue; } r -= I_LORA;
        if (r < I_OUT) { tr_item(in[27], D, nullptr, 0, WoutT, D, scr, r / 32, r % 32, F.lane); continue; } r -= I_OUT;
        if (r < I_F1) { tr_item(in[28], FF, nullptr, 0, Wff1T, D, scr, r / 128, r % 128, F.lane); continue; } r -= I_F1;
        if (r < I_F2) { tr_item(in[29], D, nullptr, 0, Wff2T, FF, scr, r / 32, r % 32, F.lane); continue; } r -= I_F2;
        if (r < I_POOL) { const int g = r / 16, rr = r % 16; tr_item(in[25] + (size_t)g * 128 * 256, 256, nullptr, 0, poolWT + (size_t)g * 256 * 128, 128, scr, rr / 8, rr % 8, F.lane); continue; } r -= I_POOL;
        tr_item(in[19], D, nullptr, 0, gw2T, 128, scr, r / 32, r % 32, F.lane);
    }
}

__device__ __forceinline__ void p1_hprep(Frame& F) {
    const float* const* in = F.in;
    const int gw = F.bid * NWAVES + F.wave, NGW = F.G * NWAVES;
    const float* mod = (const float*)(F.ws + WS_MOD);
    bf16* H = (bf16*)(F.ws + WS_H);
    for (int m = gw; m < M; m += NGW) {
        const float* xrow = m < M_CTX ? in[0] + (size_t)m * D : in[1] + (size_t)(m - M_CTX) * D;
        const int ci = cvec_of_row(m);
        f32x4 v[4]; float s = 0.f;
#pragma unroll
        for (int j = 0; j < 4; ++j) { v[j] = *(const f32x4*)(xrow + 4 * (F.lane + 64 * j)); s += (v[j].x * v[j].x + v[j].y * v[j].y) + (v[j].z * v[j].z + v[j].w * v[j].w); }
        const float rstd = rsqrtf(wave_sum(s) * (1.0f / D) + 1e-6f);
#pragma unroll
        for (int j = 0; j < 4; ++j) { const int c = 4 * (F.lane + 64 * j);
            const f32x4 g = *(const f32x4*)(in[7] + c), sh = *(const f32x4*)(mod + ci * NMOD + c), sc = *(const f32x4*)(mod + ci * NMOD + D + c);
            const f32x4 y = (v[j] * rstd) * g * (sc + 1.0f) + sh;
            v2u w; w.x = pkbf(y.x, y.y); w.y = pkbf(y.z, y.w); *(v2u*)(H + (size_t)m * D + c) = w; }
    }
    const bf16* Wff1T = (const bf16*)(F.ws + WS_WFF1); float* c1 = (float*)(F.ws + WS_C1);
    for (int n = gw; n < FF; n += NGW) {
        const bf16* wr = Wff1T + (size_t)n * D + F.lane * 16;
        const v4u w0 = *(const v4u*)wr, w1 = *(const v4u*)(wr + 8);
        float w[16];
#pragma unroll
        for (int e = 0; e < 4; ++e) { w[2 * e] = __builtin_bit_cast(float, w0[e] << 16); w[2 * e + 1] = __builtin_bit_cast(float, w0[e] & 0xffff0000u);
            w[8 + 2 * e] = __builtin_bit_cast(float, w1[e] << 16); w[8 + 2 * e + 1] = __builtin_bit_cast(float, w1[e] & 0xffff0000u); }
#pragma unroll
        for (int ci = 0; ci < 5; ++ci) { const float* sh = mod + ci * NMOD + 3 * D + F.lane * 16; float s = 0.f;
#pragma unroll
            for (int q = 0; q < 4; ++q) { const f32x4 x = *(const f32x4*)(sh + 4 * q); s += x.x * w[4 * q] + x.y * w[4 * q + 1] + x.z * w[4 * q + 2] + x.w * w[4 * q + 3]; }
            s = wave_sum(s); if (F.lane == 0) c1[ci * FF + n] = s; }
    }
}

constexpr int SC = 32;
__device__ __forceinline__ void p3_scan(Frame& F) {
    const float* const* in = F.in;
    const f16* Z = (const f16*)(F.ws + WS_Z);
    LAS float* OPS = (LAS float*)(F.lds);
    LAS float* HW = (LAS float*)(F.lds + 49152);
    LAS float* HA = (LAS float*)(F.lds + 57344);
    LAS float* WD2 = (LAS float*)(F.lds + 65536);
    LAS float* WA2 = (LAS float*)(F.lds + 81920);
    LAS float* YB = (LAS float*)(F.lds + 98304);
    const int tid = F.tid, i = tid >> 3, g = tid & 7;
    const int ptt = tid >> 4, pc4 = (tid & 15) * 4;
    constexpr int NLAT = 4 * NH * 2, NCTX = 16 * NH * 2, NCH = NLAT + NCTX;
    for (int slot = 0;; ++slot) {
        int chain;
        if (F.G == 256) { if (F.bid < 128) { if (slot > 0) break; chain = F.bid; } else { if (slot > 3) break; chain = NLAT + (F.bid - 128) + 128 * slot; } }
        else { chain = F.bid + slot * F.G; if (chain >= NCH) break; }
        const bool isLat = chain < NLAT; const int cid = isLat ? chain : chain - NLAT;
        const int b = cid / 32, head = (cid >> 1) & 15, d = cid & 1;
        const int L = isLat ? L_LAT : L_CTX, m0 = isLat ? M_CTX + b * L_LAT : b * L_CTX;
        bf16* Y = (bf16*)F.out + (size_t)d * M * D;
        __syncthreads();
        for (int idx = tid; idx < 4096; idx += NWAVES * 64) { const int k = idx >> 6, c = idx & 63;
            WD2[idx] = in[14][(size_t)(d * 64 + k) * D + head * 64 + c]; WA2[idx] = in[17][(size_t)(d * 64 + k) * D + head * 64 + c]; }
        float S[8];
        if (isLat) { const float* sp = in[2] + ((size_t)((b * 2 + d) * NH + head)) * 4096 + i * 64 + g * 8; const f32x4 s0 = *(const f32x4*)sp, s1 = *(const f32x4*)(sp + 4);
            S[0] = s0.x; S[1] = s0.y; S[2] = s0.z; S[3] = s0.w; S[4] = s1.x; S[5] = s1.y; S[6] = s1.z; S[7] = s1.w; }
        else {
#pragma unroll
            for (int j = 0; j < 8; ++j) S[j] = 0.f; }
        const int hc = head * 64 + pc4;
        const f32x4 mu_r = *(const f32x4*)(in[10] + hc), mu_k = *(const f32x4*)(in[10] + D + hc), mu_v = *(const f32x4*)(in[10] + 2 * D + hc);
        const f32x4 kkw = *(const f32x4*)(in[20] + hc), kaw = *(const f32x4*)(in[21] + hc);
        const f32x4 wd0 = *(const f32x4*)(in[12] + d * D + hc), a0v = *(const f32x4*)(in[15] + d * D + hc);
        const int nch = L / SC;
        for (int ch = 0; ch < nch; ++ch) {
            const int t0 = d == 0 ? SC * ch : L - SC * (ch + 1);
            f32x4 k4, kk4;
            {
                const int t = t0 + ptt; const f16* zr = Z + (size_t)(m0 + t) * NZ;
                const float fp = t > 0 ? 0.5f : 0.f, fn = t < L - 1 ? 0.5f : 0.f;
                const f16* zp = t > 0 ? zr - NZ : zr; const f16* zn = t < L - 1 ? zr + NZ : zr;
                const f32x4 rz = ld_h4(zr + ZC_R + hc), kz = ld_h4(zr + ZC_K + hc), vz = ld_h4(zr + ZC_V + hc);
                const f32x4 rs = ld_h4(zp + ZC_R + hc) * fp + ld_h4(zn + ZC_R + hc) * fn;
                const f32x4 ks = ld_h4(zp + ZC_K + hc) * fp + ld_h4(zn + ZC_K + hc) * fn;
                const f32x4 vs = ld_h4(zp + ZC_V + hc) * fp + ld_h4(zn + ZC_V + hc) * fn;
                const f32x4 r4 = rz + (rs - rz) * mu_r; k4 = kz + (ks - kz) * mu_k; const f32x4 v4 = vz + (vs - vz) * mu_v;
                const int lc = d * 64 + pc4;
                f32x4 hw = ld_h4(zr + ZC_LW_A + lc) + ld_h4(zp + ZC_LW_B + lc) * fp + ld_h4(zn + ZC_LW_B + lc) * fn;
                const f32x4 ha = ld_h4(zr + ZC_LA_A + lc) + ld_h4(zp + ZC_LA_B + lc) * fp + ld_h4(zn + ZC_LA_B + lc) * fn;
#pragma unroll
                for (int e = 0; e < 4; ++e) hw[e] = 1.0f - 2.0f * frcp(__expf(2.0f * hw[e]) + 1.0f);
                const f32x4 ku = k4 * kkw; float ssq = (ku.x * ku.x + ku.y * ku.y) + (ku.z * ku.z + ku.w * ku.w);
                ssq += __shfl_xor(ssq, 1); ssq += __shfl_xor(ssq, 2); ssq += __shfl_xor(ssq, 4); ssq += __shfl_xor(ssq, 8);
                kk4 = ku * rsqrtf(ssq + 1e-12f);
                *(LAS f32x4*)(HW + ptt * 64 + pc4) = hw; *(LAS f32x4*)(HA + ptt * 64 + pc4) = ha;
                *(LAS f32x4*)(OPS + ptt * 384 + 64 + pc4) = kk4; *(LAS f32x4*)(OPS + ptt * 384 + 256 + pc4) = r4; *(LAS f32x4*)(OPS + ptt * 384 + 320 + pc4) = v4;
            }
            __syncthreads();
            {
                f32x4 aw = {0.f, 0.f, 0.f, 0.f}, aa = {0.f, 0.f, 0.f, 0.f};
#pragma unroll 8
                for (int k = 0; k < 64; ++k) { const float hwk = HW[ptt * 64 + k], hak = HA[ptt * 64 + k];
                    aw += *(const LAS f32x4*)(WD2 + k * 64 + pc4) * hwk; aa += *(const LAS f32x4*)(WA2 + k * 64 + pc4) * hak; }
                f32x4 dec, av, kd, bb;
#pragma unroll
                for (int e = 0; e < 4; ++e) { dec[e] = __expf(-0.6065306597126334f * sigmoidf_(wd0[e] + aw[e])); av[e] = sigmoidf_(a0v[e] + aa[e]); }
                kd = k4 * ((av - 1.0f) * kaw + 1.0f); bb = kk4 * av;
                *(LAS f32x4*)(OPS + ptt * 384 + pc4) = dec; *(LAS f32x4*)(OPS + ptt * 384 + 128 + pc4) = bb; *(LAS f32x4*)(OPS + ptt * 384 + 192 + pc4) = kd;
            }
            __syncthreads();
#pragma unroll 2
            for (int s = 0; s < SC; ++s) {
                const int tt = d == 0 ? s : SC - 1 - s;
                const LAS float* op = OPS + tt * 384 + g * 8;
                const f32x4 w0 = *(const LAS f32x4*)(op), w1 = *(const LAS f32x4*)(op + 4);
                const f32x4 q0 = *(const LAS f32x4*)(op + 64), q1 = *(const LAS f32x4*)(op + 68);
                const f32x4 b0 = *(const LAS f32x4*)(op + 128), b1 = *(const LAS f32x4*)(op + 132);
                const f32x4 d0 = *(const LAS f32x4*)(op + 192), d1 = *(const LAS f32x4*)(op + 196);
                const f32x4 r0 = *(const LAS f32x4*)(op + 256), r1 = *(const LAS f32x4*)(op + 260);
                const float v = OPS[tt * 384 + 320 + i];
                float p = (S[0] * q0.x + S[1] * q0.y) + (S[2] * q0.z + S[3] * q0.w) + (S[4] * q1.x + S[5] * q1.y) + (S[6] * q1.z + S[7] * q1.w);
                p += __shfl_xor(p, 1); p += __shfl_xor(p, 2); p += __shfl_xor(p, 4);
                S[0] = S[0] * w0.x - p * b0.x + v * d0.x; S[1] = S[1] * w0.y - p * b0.y + v * d0.y; S[2] = S[2] * w0.z - p * b0.z + v * d0.z; S[3] = S[3] * w0.w - p * b0.w + v * d0.w;
                S[4] = S[4] * w1.x - p * b1.x + v * d1.x; S[5] = S[5] * w1.y - p * b1.y + v * d1.y; S[6] = S[6] * w1.z - p * b1.z + v * d1.z; S[7] = S[7] * w1.w - p * b1.w + v * d1.w;
                float y = (S[0] * r0.x + S[1] * r0.y) + (S[2] * r0.z + S[3] * r0.w) + (S[4] * r1.x + S[5] * r1.y) + (S[6] * r1.z + S[7] * r1.w);
                y += __shfl_xor(y, 1); y += __shfl_xor(y, 2); y += __shfl_xor(y, 4);
                if (g == 0) YB[tt * 64 + i] = y;
            }
            __syncthreads();
            { const f32x4 y4 = *(const LAS f32x4*)(YB + ptt * 64 + pc4); v2u w; w.x = pkbf(y4.x, y4.y); w.y = pkbf(y4.z, y4.w);
              *(v2u*)(Y + (size_t)(m0 + t0 + ptt) * D + hc) = w; }
        }
        if (!isLat) { float* so = F.out + (size_t)M * D + ((size_t)((b * 2 + d) * NH + head)) * 4096 + i * 64 + g * 8;
            *(f32x4*)so = (f32x4){S[0], S[1], S[2], S[3]}; *(f32x4*)(so + 4) = (f32x4){S[4], S[5], S[6], S[7]}; }
    }
}

typedef short s16x4 __attribute__((ext_vector_type(4)));
__device__ __forceinline__ int sw(int row, int col) { return row * 64 + ((((col >> 3) ^ (row >> 1)) & 7) << 3) + (col & 7); }
__device__ __forceinline__ bf16x8 ldfrag(const LAS bf16* buf, int row, int col) { return *(const LAS bf16x8*)(buf + sw(row, col)); }
__device__ __forceinline__ void mm_blk(f32x4 (&acc)[2][2], const LAS bf16* X, int xr0, const LAS bf16* Yt, int yr0, int fr, int fq) {
#pragma unroll
    for (int ks = 0; ks < 2; ++ks) {
        bf16x8 a[2], b[2];
#pragma unroll
        for (int t = 0; t < 2; ++t) { a[t] = ldfrag(X, xr0 + 16 * t + fr, 32 * ks + 8 * fq); b[t] = ldfrag(Yt, yr0 + 16 * t + fr, 32 * ks + 8 * fq); }
#pragma unroll
        for (int ti = 0; ti < 2; ++ti)
#pragma unroll
            for (int tj = 0; tj < 2; ++tj) acc[ti][tj] = __builtin_amdgcn_mfma_f32_16x16x32_bf16(a[ti], b[tj], acc[ti][tj], 0, 0, 0);
    }
}
__device__ __forceinline__ void zero_blk(f32x4 (&acc)[2][2]) {
#pragma unroll
    for (int ti = 0; ti < 2; ++ti)
#pragma unroll
        for (int tj = 0; tj < 2; ++tj) acc[ti][tj] = (f32x4){0.f, 0.f, 0.f, 0.f};
}
__device__ __forceinline__ void st_blk_t(LAS bf16* dst, const f32x4 (&acc)[2][2], int xr0, int yr0, int fr, int fq) {
#pragma unroll
    for (int ti = 0; ti < 2; ++ti)
#pragma unroll
        for (int tj = 0; tj < 2; ++tj) { v2u w; w.x = pkbf(acc[ti][tj][0], acc[ti][tj][1]); w.y = pkbf(acc[ti][tj][2], acc[ti][tj][3]);
            *(LAS v2u*)(dst + sw(yr0 + 16 * tj + fr, xr0 + 16 * ti + 4 * fq)) = w; }
}
constexpr int CS = 64;
__device__ __forceinline__ void p3_scan2(Frame& F) {
    const float* const* in = F.in;
    const f16* Z = (const f16*)(F.ws + WS_Z);
    LAS bf16* const B0 = (LAS bf16*)(F.lds);
#define MB(n) (B0 + (n) * 4096)
    LAS bf16* const KKg = MB(0); LAS bf16* const Rg = MB(1); LAS bf16* const Bi = MB(2); LAS bf16* const Ki = MB(3);
    LAS bf16* const nBct = MB(4); LAS bf16* const Kct = MB(5); LAS bf16* const Vt = MB(6); LAS bf16* const Sb = MB(7);
    LAS bf16* const Aab = MB(8); LAS bf16* const Aak = MB(9); LAS bf16* const nArb = MB(10); LAS bf16* const Ark = MB(11); LAS bf16* const Minv = MB(12);
    LAS bf16* const RHSt = Bi; LAS bf16* const Ut = Ki; LAS bf16* const YB = KKg; LAS bf16* const HW = Bi; LAS bf16* const HA = Ki;
    LAS f16* const r16 = (LAS f16*)MB(8); LAS f16* const k16 = (LAS f16*)MB(9); LAS f16* const v16 = (LAS f16*)MB(10); LAS f16* const kk16 = (LAS f16*)MB(11); LAS f16* const a16 = (LAS f16*)MB(12);
    LAS bf16* const Wd2t = MB(13); LAS bf16* const Wa2t = MB(14);
    LAS float* const LW = (LAS float*)(F.lds + 15 * 8192);
    LAS float* const AD = LW;
    LAS float* const SEG = (LAS float*)(F.lds + 15 * 8192 + 16384);
    LAS float* const GC = SEG + 512;
    LAS bf16* const XT = (LAS bf16*)(GC + 64);
    const int tid = F.tid, lane = F.lane, wave = F.wave;
#define OPQ_LANE() int ln_ = lane; asm volatile("" : "+v"(ln_)); const int fr = ln_ & 15, fq = ln_ >> 4
#define OPQ_TID() int td_ = tid; asm volatile("" : "+v"(td_)); const int ptt = td_ >> 3, pc8 = (td_ & 7) * 8, cch = td_ & 63, cseg = td_ >> 6; (void)ptt; (void)pc8; (void)cch; (void)cseg
    constexpr int NLAT = 4 * NH * 2, NCTX = 16 * NH * 2, NCH = NLAT + NCTX;
    for (int slot = 0;; ++slot) {
        int chain;
        if (F.G == 256) { if (F.bid < 128) { if (slot > 0) break; chain = F.bid; } else { if (slot > 3) break; chain = NLAT + (F.bid - 128) + 128 * slot; } }
        else { chain = F.bid + slot * F.G; if (chain >= NCH) break; }
        const bool isLat = chain < NLAT; const int cid = isLat ? chain : chain - NLAT;
        const int b = cid / 32, head = (cid >> 1) & 15, d = cid & 1;
        const int L = isLat ? L_LAT : L_CTX, m0 = isLat ? M_CTX + b * L_LAT : b * L_CTX;
        bf16* Y = (bf16*)F.out + (size_t)d * M * D;
        __syncthreads();
        for (int idx = tid; idx < 4096; idx += NWAVES * 64) { const int k = idx >> 6, c = idx & 63;
            const float wv = in[14][(size_t)(d * 64 + k) * D + head * 64 + c], av = in[17][(size_t)(d * 64 + k) * D + head * 64 + c];
            Wd2t[sw(c, k)] = (bf16)(pkbf(wv, 0.f) & 0xffffu); Wa2t[sw(c, k)] = (bf16)(pkbf(av, 0.f) & 0xffffu); }
        const int v4 = wave & 3, bi = v4 >> 1, bj = v4 & 1;
        f32x4 Tacc[2][2]; zero_blk(Tacc);
        if (wave >= 4) { OPQ_LANE();
            if (isLat) { const float* sp = in[2] + ((size_t)((b * 2 + d) * NH + head)) * 4096;
#pragma unroll
                for (int ti = 0; ti < 2; ++ti)
#pragma unroll
                    for (int tj = 0; tj < 2; ++tj) Tacc[ti][tj] = *(const f32x4*)(sp + (32 * bj + 16 * tj + fr) * 64 + 32 * bi + 16 * ti + 4 * fq); }
            st_blk_t(Sb, Tacc, 32 * bi, 32 * bj, fr, fq);
        }
        const int pc8c = (tid & 7) * 8, hc8 = head * 64 + pc8c;
        float mur[8], muk[8], muv[8], kkw[8];
#pragma unroll
        for (int e = 0; e < 8; ++e) { mur[e] = in[10][hc8 + e]; muk[e] = in[10][D + hc8 + e]; muv[e] = in[10][2 * D + hc8 + e]; kkw[e] = in[20][hc8 + e]; }
        const float kac = in[21][head * 64 + (tid & 63)];
        const int nch = L / CS;
        for (int ch = 0; ch < nch; ++ch) {
            {
                OPQ_TID();
                const int tau = CS * ch + ptt, t = d == 0 ? tau : L - 1 - tau;
                const f16* zr = Z + (size_t)(m0 + t) * NZ;
                const float fp = t > 0 ? 0.5f : 0.f, fn = t < L - 1 ? 0.5f : 0.f;
                const f16* zp = t > 0 ? zr - NZ : zr; const f16* zn = t < L - 1 ? zr + NZ : zr;
                const int hc8 = head * 64 + pc8;
                const f16x8 rz = *(const f16x8*)(zr + ZC_R + hc8), rp = *(const f16x8*)(zp + ZC_R + hc8), rn = *(const f16x8*)(zn + ZC_R + hc8);
                const f16x8 kz = *(const f16x8*)(zr + ZC_K + hc8), kp = *(const f16x8*)(zp + ZC_K + hc8), kn = *(const f16x8*)(zn + ZC_K + hc8);
                const f16x8 vz = *(const f16x8*)(zr + ZC_V + hc8), vp = *(const f16x8*)(zp + ZC_V + hc8), vn = *(const f16x8*)(zn + ZC_V + hc8);
                const int lc = d * 64 + pc8;
                const f16x8 wa = *(const f16x8*)(zr + ZC_LW_A + lc), wbp = *(const f16x8*)(zp + ZC_LW_B + lc), wbn = *(const f16x8*)(zn + ZC_LW_B + lc);
                const f16x8 aa = *(const f16x8*)(zr + ZC_LA_A + lc), abp = *(const f16x8*)(zp + ZC_LA_B + lc), abn = *(const f16x8*)(zn + ZC_LA_B + lc);
                float rr[8], kk_[8], vv[8], ku[8], hw[8], ha[8]; float ssq = 0.f;
#pragma unroll
                for (int e = 0; e < 8; ++e) {
                    const float r0 = (float)rz[e], k0 = (float)kz[e], v0 = (float)vz[e];
                    rr[e] = r0 + (((float)rp[e] * fp + (float)rn[e] * fn) - r0) * mur[e];
                    kk_[e] = k0 + (((float)kp[e] * fp + (float)kn[e] * fn) - k0) * muk[e];
                    vv[e] = v0 + (((float)vp[e] * fp + (float)vn[e] * fn) - v0) * muv[e];
                    ku[e] = kk_[e] * kkw[e]; ssq += ku[e] * ku[e];
                    const float h = (float)wa[e] + (float)wbp[e] * fp + (float)wbn[e] * fn;
                    hw[e] = 1.0f - 2.0f * frcp(__expf(2.0f * h) + 1.0f);
                    ha[e] = (float)aa[e] + (float)abp[e] * fp + (float)abn[e] * fn; }
                ssq += __shfl_xor(ssq, 1); ssq += __shfl_xor(ssq, 2); ssq += __shfl_xor(ssq, 4);
                const float rn_ = rsqrtf(ssq + 1e-12f);
                v4u o;
                o.x = pkh(rr[0], rr[1]); o.y = pkh(rr[2], rr[3]); o.z = pkh(rr[4], rr[5]); o.w = pkh(rr[6], rr[7]); *(LAS v4u*)(r16 + ptt * 64 + pc8) = o;
                o.x = pkh(kk_[0], kk_[1]); o.y = pkh(kk_[2], kk_[3]); o.z = pkh(kk_[4], kk_[5]); o.w = pkh(kk_[6], kk_[7]); *(LAS v4u*)(k16 + ptt * 64 + pc8) = o;
                o.x = pkh(vv[0], vv[1]); o.y = pkh(vv[2], vv[3]); o.z = pkh(vv[4], vv[5]); o.w = pkh(vv[6], vv[7]); *(LAS v4u*)(v16 + ptt * 64 + pc8) = o;
                o.x = pkh(ku[0] * rn_, ku[1] * rn_); o.y = pkh(ku[2] * rn_, ku[3] * rn_); o.z = pkh(ku[4] * rn_, ku[5] * rn_); o.w = pkh(ku[6] * rn_, ku[7] * rn_); *(LAS v4u*)(kk16 + ptt * 64 + pc8) = o;
                o.x = pkbf(hw[0], hw[1]); o.y = pkbf(hw[2], hw[3]); o.z = pkbf(hw[4], hw[5]); o.w = pkbf(hw[6], hw[7]); *(LAS v4u*)(HW + sw(ptt, pc8)) = o;
                o.x = pkbf(ha[0], ha[1]); o.y = pkbf(ha[2], ha[3]); o.z = pkbf(ha[4], ha[5]); o.w = pkbf(ha[6], ha[7]); *(LAS v4u*)(HA + sw(ptt, pc8)) = o;
            }
            __syncthreads();
            {
                OPQ_LANE();
                f32x4 acc[2][2]; zero_blk(acc);
                mm_blk(acc, wave < 4 ? Wd2t : Wa2t, 32 * bi, wave < 4 ? HW : HA, 32 * bj, fr, fq);
#pragma unroll
                for (int ti = 0; ti < 2; ++ti) { const int c0 = 32 * bi + 16 * ti + 4 * fq;
                    const f32x4 bias = *(const f32x4*)((wave < 4 ? in[12] : in[15]) + d * D + head * 64 + c0);
#pragma unroll
                    for (int tj = 0; tj < 2; ++tj) { const int tt = 32 * bj + 16 * tj + fr; f32x4 x = acc[ti][tj] + bias;
#pragma unroll
                        for (int e = 0; e < 4; ++e) x[e] = sigmoidf_(x[e]);
                        if (wave < 4) *(LAS f32x4*)(LW + tt * 64 + c0) = x * (-0.6065306597126334f);
                        else { v2u w; w.x = pkh(x[0], x[1]); w.y = pkh(x[2], x[3]); *(LAS v2u*)(a16 + tt * 64 + c0) = w; } } }
            }
            __syncthreads();
            float lwv[8];
            { OPQ_TID(); float run = 0.f;
#pragma unroll
              for (int e = 0; e < 8; ++e) { lwv[e] = LW[(8 * cseg + e) * 64 + cch]; run += lwv[e]; }
              SEG[cseg * 64 + cch] = run; }
            __syncthreads();
            {
                OPQ_TID();
                float pre = 0.f, tot = 0.f;
#pragma unroll
                for (int s = 0; s < 8; ++s) { const float x = SEG[s * 64 + cch]; tot += x; pre += (s < cseg) ? x : 0.f; }
                const float gC = __expf(tot); float E = __expf(pre);
                if (cseg == 0) GC[cch] = gC;
                float nb[8], kc[8], vt[8];
#pragma unroll
                for (int e = 0; e < 8; ++e) { const int tt = 8 * cseg + e;
                    const float gprev = E; E *= __expf(lwv[e]); const float inv = frcp(E), e4 = gC * inv;
                    const float kkv = (float)kk16[tt * 64 + cch], rv = (float)r16[tt * 64 + cch], kv = (float)k16[tt * 64 + cch], vv = (float)v16[tt * 64 + cch], av = (float)a16[tt * 64 + cch];
                    const float kd = kv * (1.0f + (av - 1.0f) * kac), bb = kkv * av;
                    KKg[sw(tt, cch)] = (bf16)(pkbf(kkv * gprev, 0.f) & 0xffffu); Rg[sw(tt, cch)] = (bf16)(pkbf(rv * E, 0.f) & 0xffffu);
                    Bi[sw(tt, cch)] = (bf16)(pkbf(bb * inv, 0.f) & 0xffffu); Ki[sw(tt, cch)] = (bf16)(pkbf(kd * inv, 0.f) & 0xffffu);
                    nb[e] = -bb * e4; kc[e] = kd * e4; vt[e] = vv; }
                v4u o;
                o.x = pkbf(nb[0], nb[1]); o.y = pkbf(nb[2], nb[3]); o.z = pkbf(nb[4], nb[5]); o.w = pkbf(nb[6], nb[7]); *(LAS v4u*)(nBct + sw(cch, 8 * cseg)) = o;
                o.x = pkbf(kc[0], kc[1]); o.y = pkbf(kc[2], kc[3]); o.z = pkbf(kc[4], kc[5]); o.w = pkbf(kc[6], kc[7]); *(LAS v4u*)(Kct + sw(cch, 8 * cseg)) = o;
                o.x = pkbf(vt[0], vt[1]); o.y = pkbf(vt[2], vt[3]); o.z = pkbf(vt[4], vt[5]); o.w = pkbf(vt[6], vt[7]); *(LAS v4u*)(Vt + sw(cch, 8 * cseg)) = o;
            }
            __syncthreads();
            {
                OPQ_LANE();
                const int mtx = wave >> 1, sb = wave & 1;
                const LAS bf16* X = (mtx & 1) ? Ki : Bi; const LAS bf16* Yt = (mtx >> 1) ? Rg : KKg;
                LAS bf16* dst = mtx == 0 ? Aab : mtx == 1 ? Aak : mtx == 2 ? nArb : Ark;
                const bool incl = mtx >= 2; const float sgn = mtx == 2 ? -1.0f : 1.0f;
#pragma unroll
                for (int tb = 0; tb < 2; ++tb) {
                    f32x4 acc[2][2]; zero_blk(acc);
                    if (tb >= sb) mm_blk(acc, X, 32 * sb, Yt, 32 * tb, fr, fq);
#pragma unroll
                    for (int ti = 0; ti < 2; ++ti)
#pragma unroll
                        for (int tj = 0; tj < 2; ++tj) { const int t = 32 * tb + 16 * tj + fr, s0 = 32 * sb + 16 * ti + 4 * fq; f32x4 x = acc[ti][tj] * sgn;
#pragma unroll
                            for (int e = 0; e < 4; ++e) { const bool keep = incl ? (s0 + e <= t) : (s0 + e < t); x[e] = keep ? x[e] : 0.f; }
                            v2u w; w.x = pkbf(x[0], x[1]); w.y = pkbf(x[2], x[3]); *(LAS v2u*)(dst + sw(t, s0)) = w;
                            if (mtx == 0 && (32 * tb + 16 * tj) == (32 * sb + 16 * ti)) *(LAS f32x4*)(AD + ((32 * tb + 16 * tj) >> 4) * 256 + fr * 16 + 4 * fq) = x; }
                }
            }
            __syncthreads();
            f32x4 Yacc[2][2]; zero_blk(Yacc);
            if (wave == 0) {
                OPQ_LANE();
                float x[16];
#pragma unroll
                for (int r = 0; r < 16; ++r) x[r] = (r == fr) ? 1.0f : 0.0f;
#pragma unroll
                for (int r = 1; r < 16; ++r) { float s = 0.f;
#pragma unroll
                    for (int k4 = 0; k4 < (r + 3) / 4; ++k4) { const f32x4 nr = *(const LAS f32x4*)(AD + fq * 256 + r * 16 + 4 * k4);
#pragma unroll
                        for (int e = 0; e < 4; ++e) if (4 * k4 + e < r) s += nr[e] * x[4 * k4 + e]; }
                    x[r] = (r > fr) ? -s : x[r]; }
                {
#pragma unroll
                    for (int r = 0; r < 16; ++r) Minv[sw(16 * fq + r, 16 * fq + fr)] = (bf16)(pkbf(x[r], 0.f) & 0xffffu);
                    v4u o; o.x = pkbf(x[0], x[1]); o.y = pkbf(x[2], x[3]); o.z = pkbf(x[4], x[5]); o.w = pkbf(x[6], x[7]); *(LAS v4u*)(XT + fq * 256 + fr * 16) = o;
                    o.x = pkbf(x[8], x[9]); o.y = pkbf(x[10], x[11]); o.z = pkbf(x[12], x[13]); o.w = pkbf(x[14], x[15]); *(LAS v4u*)(XT + fq * 256 + fr * 16 + 8) = o;
                }
            }
            if (wave < 4) { OPQ_LANE();
                for (int r = 0; r < 16 * wave; r += 4) { const int row = r + fq; *(LAS unsigned short*)(Minv + sw(row, 16 * wave + fr)) = 0; }
            }
            if (wave >= 4) {
                OPQ_LANE();
                f32x4 R[2][2]; zero_blk(R);
                mm_blk(R, Aak, 32 * bi, Vt, 32 * bj, fr, fq);
                mm_blk(R, KKg, 32 * bi, Sb, 32 * bj, fr, fq);
                st_blk_t(RHSt, R, 32 * bi, 32 * bj, fr, fq);
#pragma unroll
                for (int ti = 0; ti < 2; ++ti) { const f32x4 g = *(const LAS f32x4*)(GC + 32 * bi + 16 * ti + 4 * fq);
#pragma unroll
                    for (int tj = 0; tj < 2; ++tj) Tacc[ti][tj] *= g; }
                mm_blk(Tacc, Kct, 32 * bi, Vt, 32 * bj, fr, fq);
                mm_blk(Yacc, Sb, 32 * bi, Rg, 32 * bj, fr, fq);
                mm_blk(Yacc, Vt, 32 * bi, Ark, 32 * bj, fr, fq);
            }
            __syncthreads();
            if (wave < 3) {
                OPQ_LANE();
                const int j = wave;
                s16x4 xb[3];
                xb[0] = *(const LAS s16x4*)(XT + j * 256 + fr * 16 + 4 * fq);
                xb[1] = xb[0]; xb[2] = xb[0];
#pragma unroll
                for (int dl = 1; dl <= 3; ++dl) { if (j + dl <= 3) { const int i = j + dl;
                    f32x4 p = {0.f, 0.f, 0.f, 0.f};
#pragma unroll
                    for (int mm = 0; mm < dl; ++mm) { const s16x4 n = *(const LAS s16x4*)(Aab + sw(16 * i + fr, 16 * (j + mm) + 4 * fq));
                        p = __builtin_amdgcn_mfma_f32_16x16x16bf16_1k(n, xb[mm], p, 0, 0, 0); }
                    v2u pw; pw.x = pkbf(p[0], p[1]); pw.y = pkbf(p[2], p[3]);
                    const s16x4 xi = *(const LAS s16x4*)(Minv + sw(16 * i + fr, 16 * i + 4 * fq));
                    f32x4 z = {0.f, 0.f, 0.f, 0.f};
                    z = __builtin_amdgcn_mfma_f32_16x16x16bf16_1k(xi, __builtin_bit_cast(s16x4, pw), z, 0, 0, 0);
                    v2u zw; zw.x = pkbf(-z[0], -z[1]); zw.y = pkbf(-z[2], -z[3]);
                    if (dl < 3) xb[dl] = __builtin_bit_cast(s16x4, zw);
                    Minv[sw(16 * i + 4 * fq + 0, 16 * j + fr)] = (bf16)(zw.x & 0xffffu); Minv[sw(16 * i + 4 * fq + 1, 16 * j + fr)] = (bf16)(zw.x >> 16);
                    Minv[sw(16 * i + 4 * fq + 2, 16 * j + fr)] = (bf16)(zw.y & 0xffffu); Minv[sw(16 * i + 4 * fq + 3, 16 * j + fr)] = (bf16)(zw.y >> 16); } }
            }
            __syncthreads();
            if (wave >= 4) {
                OPQ_LANE();
                f32x4 Uc[2][2]; zero_blk(Uc);
                mm_blk(Uc, Minv, 32 * bi, RHSt, 32 * bj, fr, fq);
                st_blk_t(Ut, Uc, 32 * bi, 32 * bj, fr, fq);
            }
            __syncthreads();
            if (wave >= 4) {
                OPQ_LANE();
                mm_blk(Tacc, nBct, 32 * bi, Ut, 32 * bj, fr, fq);
                mm_blk(Yacc, Ut, 32 * bi, nArb, 32 * bj, fr, fq);
                st_blk_t(Sb, Tacc, 32 * bi, 32 * bj, fr, fq);
                st_blk_t(YB, Yacc, 32 * bi, 32 * bj, fr, fq);
            }
            __syncthreads();
            { OPQ_TID(); const int tau = CS * ch + ptt, t = d == 0 ? tau : L - 1 - tau;
              *(v4u*)(Y + (size_t)(m0 + t) * D + head * 64 + pc8) = *(const LAS v4u*)(YB + sw(ptt, pc8)); }
        }
        if (!isLat && wave >= 4) { OPQ_LANE(); float* so = F.out + (size_t)M * D + ((size_t)((b * 2 + d) * NH + head)) * 4096;
#pragma unroll
            for (int ti = 0; ti < 2; ++ti)
#pragma unroll
                for (int tj = 0; tj < 2; ++tj) *(f32x4*)(so + (32 * bj + 16 * tj + fr) * 64 + 32 * bi + 16 * ti + 4 * fq) = Tacc[ti][tj]; }
    }
#undef MB
#undef OPQ_LANE
#undef OPQ_TID
}
constexpr int MXS = 136;
__device__ __forceinline__ void p4_mix(Frame& F) {
    const float* const* in = F.in;
    const f16* Z = (const f16*)(F.ws + WS_Z);
    const bf16* Y0 = (const bf16*)F.out; const bf16* Y1 = Y0 + (size_t)M * D;
    bf16* MIX = (bf16*)(F.ws + WS_H);
    const bf16* poolWT = (const bf16*)(F.ws + WS_POOLW); const bf16* gw2T = (const bf16*)(F.ws + WS_GW2T);
    LAS bf16* SG = (LAS bf16*)(F.lds);
    LAS f32x4* ST = (LAS f32x4*)(F.lds + 17408);
    LAS f16* ZP = (LAS f16*)(F.lds + 17408 + 16384);
    LAS bf16* MX = (LAS bf16*)(F.lds + 17408 + 16384 + 20480);
    const int tid = F.tid, lane = F.lane, wave = F.wave;
    for (int tile = F.bid; tile < M / 64; tile += F.G) {
        const int m0t = tile * 64;
        const bool isCtx = m0t < M_CTX;
        const int ms = isCtx ? (m0t / L_CTX) * L_CTX : M_CTX + ((m0t - M_CTX) / L_LAT) * L_LAT, L = isCtx ? L_CTX : L_LAT;
        const int vlo = isCtx ? ms - m0t : 0, vhi = isCtx ? ms + L_CTX - m0t : 64;
        __syncthreads();
        { const int tt = tid >> 3, c16 = (tid & 7) * 16; const int m = m0t + tt, t = m - ms;
          const f16* zr = Z + (size_t)m * NZ; const f16* zp = t > 0 ? zr - NZ : zr; const f16* zn = t < L - 1 ? zr + NZ : zr;
          const float fp = t > 0 ? 0.5f : 0.f, fn = t < L - 1 ? 0.5f : 0.f;
          unsigned o[8];
#pragma unroll
          for (int q = 0; q < 4; ++q) { const f32x4 h = ld_h4(zr + ZC_LG_A + c16 + 4 * q) + ld_h4(zp + ZC_LG_B + c16 + 4 * q) * fp + ld_h4(zn + ZC_LG_B + c16 + 4 * q) * fn;
              o[2 * q] = pkbf(sigmoidf_(h.x), sigmoidf_(h.y)); o[2 * q + 1] = pkbf(sigmoidf_(h.z), sigmoidf_(h.w)); }
          *(LAS v4u*)(SG + tt * MXS + c16) = (v4u){o[0], o[1], o[2], o[3]}; *(LAS v4u*)(SG + tt * MXS + c16 + 8) = (v4u){o[4], o[5], o[6], o[7]}; }
#pragma unroll 1
        for (int it = 0; it < 8; ++it) { const int item = it * 512 + tid, pair = item >> 2, q = item & 3, tt = pair >> 4, head = pair & 15; const int m = m0t + tt, t = m - ms, c0 = head * 64 + q * 16;
            const f16* zr = Z + (size_t)m * NZ; const f16* zp = t > 0 ? zr - NZ : zr; const f16* zn = t < L - 1 ? zr + NZ : zr;
            const float fp = t > 0 ? 0.5f : 0.f, fn = t < L - 1 ? 0.5f : 0.f;
            float y[16]; float s1 = 0.f, rk = 0.f;
#pragma unroll
            for (int e = 0; e < 4; ++e) { const f32x4 a = ld_bf4(Y0 + (size_t)m * D + c0 + 4 * e) + ld_bf4(Y1 + (size_t)m * D + c0 + 4 * e);
                y[4 * e] = a.x; y[4 * e + 1] = a.y; y[4 * e + 2] = a.z; y[4 * e + 3] = a.w; s1 += (a.x + a.y) + (a.z + a.w);
                const int c = c0 + 4 * e;
                const f32x4 rz = ld_h4(zr + ZC_R + c), kz = ld_h4(zr + ZC_K + c);
                const f32x4 rs = ld_h4(zp + ZC_R + c) * fp + ld_h4(zn + ZC_R + c) * fn, ks = ld_h4(zp + ZC_K + c) * fp + ld_h4(zn + ZC_K + c) * fn;
                const f32x4 r4 = rz + (rs - rz) * *(const f32x4*)(in[10] + c), k4 = kz + (ks - kz) * *(const f32x4*)(in[10] + D + c), w4 = *(const f32x4*)(in[22] + c);
                rk += (r4.x * k4.x * w4.x + r4.y * k4.y * w4.y) + (r4.z * k4.z * w4.z + r4.w * k4.w * w4.w); }
            s1 += __shfl_xor(s1, 1); s1 += __shfl_xor(s1, 2); rk += __shfl_xor(rk, 1); rk += __shfl_xor(rk, 2);
            const float mean = s1 * (1.0f / 64.0f); float s2 = 0.f;
#pragma unroll
            for (int e = 0; e < 16; ++e) { const float dd = y[e] - mean; s2 += dd * dd; }
            s2 += __shfl_xor(s2, 1); s2 += __shfl_xor(s2, 2);
            if (q == 0) ST[tt * 16 + head] = (f32x4){mean, rsqrtf(s2 * (1.0f / 64.0f) + 64e-5f), rk, 0.f}; }
#pragma unroll 1
        for (int g = 0; g < 4; ++g) {
            __syncthreads();
            for (int idx = tid; idx < 80 * 16; idx += NWAVES * 64) { const int rr = idx >> 4, c8 = (idx & 15) * 8, tl = rr - 8;
                v4u val = {0u, 0u, 0u, 0u};
                if (tl >= vlo && tl < vhi) val = *(const v4u*)(Z + (size_t)(m0t + tl) * NZ + ZC_POOL + g * 128 + c8);
                *(LAS v4u*)(ZP + rr * 128 + c8) = val; }
            __syncthreads();
            { const int win = 2 << g;
              for (int it = 0; it < 2; ++it) { const int item = it * 512 + tid, tt = item >> 4, c8 = (item & 15) * 8;
                  int lo = tt - win / 2, hi = tt + win - win / 2; lo = lo < vlo ? vlo : lo; hi = hi > vhi ? vhi : hi;
                  float acc8[8];
#pragma unroll
                  for (int e = 0; e < 8; ++e) acc8[e] = 0.f;
                  for (int u = lo; u < hi; ++u) { const f16x8 zv = *(const LAS f16x8*)(ZP + (u + 8) * 128 + c8);
#pragma unroll
                      for (int e = 0; e < 8; ++e) acc8[e] += (float)zv[e]; }
                  const float inv = frcp((float)(hi - lo)); const f16x8 zc = *(const LAS f16x8*)(ZP + (tt + 8) * 128 + c8);
                  unsigned o[4];
#pragma unroll
                  for (int e = 0; e < 4; ++e) o[e] = pkbf(acc8[2 * e] * inv - (float)zc[2 * e], acc8[2 * e + 1] * inv - (float)zc[2 * e + 1]);
                  *(LAS v4u*)(MX + tt * MXS + c8) = (v4u){o[0], o[1], o[2], o[3]}; } }
            __syncthreads();
            const int ch0 = wave * 32;
            bf16x8 wP[4][2], wG[4][2];
#pragma unroll
            for (int ks = 0; ks < 4; ++ks)
#pragma unroll
                for (int ct = 0; ct < 2; ++ct) { const int chl = ch0 + ct * 16 + (lane & 15);
                    wP[ks][ct] = *(const bf16x8*)(poolWT + ((size_t)g * 256 + chl) * 128 + ks * 32 + 8 * (lane >> 4));
                    wG[ks][ct] = *(const bf16x8*)(gw2T + ((size_t)g * 256 + chl) * 128 + ks * 32 + 8 * (lane >> 4)); }
#pragma unroll 1
            for (int tk = 0; tk < 4; ++tk) {
                f32x4 aP[2], aG[2];
                aP[0] = aP[1] = aG[0] = aG[1] = (f32x4){0.f, 0.f, 0.f, 0.f};
                const int tt = tk * 16 + (lane & 15), m = m0t + tt, t = m - ms;
#pragma unroll
                for (int ks = 0; ks < 4; ++ks) {
                    const bf16x8 bm = *(const LAS bf16x8*)(MX + tt * MXS + ks * 32 + 8 * (lane >> 4));
                    const bf16x8 bg = *(const LAS bf16x8*)(SG + tt * MXS + ks * 32 + 8 * (lane >> 4));
#pragma unroll
                    for (int ct = 0; ct < 2; ++ct) { aP[ct] = __builtin_amdgcn_mfma_f32_16x16x32_bf16(wP[ks][ct], bm, aP[ct], 0, 0, 0);
                                                     aG[ct] = __builtin_amdgcn_mfma_f32_16x16x32_bf16(wG[ks][ct], bg, aG[ct], 0, 0, 0); }
                }
                const f16* zr = Z + (size_t)m * NZ; const f16* zp = t > 0 ? zr - NZ : zr; const f16* zn = t < L - 1 ? zr + NZ : zr;
                const float fp = t > 0 ? 0.5f : 0.f, fn = t < L - 1 ? 0.5f : 0.f;
#pragma unroll
                for (int ct = 0; ct < 2; ++ct) { const int c = g * 256 + ch0 + ct * 16 + 4 * (lane >> 4), head = c >> 6;
                    const f32x4 lw = *(const f32x4*)(in[23] + c), lb = *(const f32x4*)(in[24] + c), muv = *(const f32x4*)(in[10] + 2 * D + c), psc = *(const f32x4*)(in[26] + c);
                    const f32x4 st = ST[tt * 16 + head];
                    const f32x4 y = ld_bf4(Y0 + (size_t)m * D + c) + ld_bf4(Y1 + (size_t)m * D + c);
                    const f32x4 vz = ld_h4(zr + ZC_V + c), vs = ld_h4(zp + ZC_V + c) * fp + ld_h4(zn + ZC_V + c) * fn; const f32x4 v4 = vz + (vs - vz) * muv;
                    const f32x4 yn = (y - st.x) * st.y * lw + lb + v4 * st.z;
                    const f32x4 bo = yn * aG[ct], ao = aP[ct] * psc;
                    const f32x4 ga = ld_h4(zr + ZC_GA + c), gb = ld_h4(zr + ZC_GB + c);
                    const f32x4 mx = ga * ao + gb * bo;
                    v2u w; w.x = pkbf(mx.x, mx.y); w.y = pkbf(mx.z, mx.w); *(v2u*)(MIX + (size_t)m * D + c) = w; }
            }
        }
    }
}

__device__ __forceinline__ void p8_final(Frame& F) {
    const int gw = F.bid * NWAVES + F.wave, NGW = F.G * NWAVES;
    const float* rss = (const float*)(F.ws + WS_RSS2); const float* gf = F.in[30];
    for (int m = gw; m < M; m += NGW) { const float rstd = rsqrtf(rss[m] * (1.0f / D) + 1e-6f); float* row = F.out + (size_t)m * D;
#pragma unroll
        for (int j = 0; j < 4; ++j) { const int c = 4 * (F.lane + 64 * j); const f32x4 x = *(const f32x4*)(row + c), g = *(const f32x4*)(gf + c); *(f32x4*)(row + c) = x * rstd * g; } }
}

__global__ void __launch_bounds__(NWAVES * 64, 2) fwd(Args args) {
    extern __shared__ __attribute__((aligned(16))) unsigned char lds_raw[];
    Frame F;
    F.lds = (LAS unsigned char*)lds_raw;
    F.tid = threadIdx.x; F.lane = F.tid & 63; F.wave = __builtin_amdgcn_readfirstlane(F.tid >> 6);
    F.G = gridDim.x; F.bid = blockIdx.x;
    F.in = args.in; F.out = args.out; F.ws = args.ws;
    volatile LAS unsigned* MISC = (volatile LAS unsigned*)(F.lds + MISC_OFF);
    if (F.tid < 32) MISC[F.tid] = 0u;
    __syncthreads();
    const int lo = args.ph_lo, hi = args.ph_hi;
    unsigned* ctl = (unsigned*)(F.ws + WS_CTL);
    XcdBarrier bar; bar.bar = ctl + CW_BAR; bar.x = 0; bar.st = nullptr;
    if (hi - lo > 1) bar = xcd_barrier_post(ctl + CW_BAR, MISC + 8);
#ifndef PH_MASK
#define PH_MASK 0x1ff
#endif
#ifndef REPEAT_MASK
#define REPEAT_MASK 0
#endif
#define REP(k) (((REPEAT_MASK >> (k)) & 1) ? 2 : 1)
#define IN(k) (((PH_MASK >> (k)) & 1) && lo <= (k) && (k) < hi)
#define BOTH(k) (IN(k) && IN((k) + 1))
#define GRID_BAR() xcd_barrier(bar)
    bf16* H = (bf16*)(F.ws + WS_H);
    float* mod = (float*)(F.ws + WS_MOD);
    if (IN(0)) { for (int rep = 0; rep < REP(0); ++rep) p0_prologue(F); if (BOTH(0)) GRID_BAR(); }
    if (IN(1)) { for (int rep = 0; rep < REP(1); ++rep) p1_hprep(F); if (BOTH(1)) GRID_BAR(); }
    if (IN(2)) {
        pg8::Gemm g{H, (const bf16*)(F.ws + WS_WCAT), M, NZ, D}; pg8::StaticOrder S; S.init(M, NZ, F.G, F.bid);
        EpiZ E{(f16*)(F.ws + WS_Z)};
        for (int rep = 0; rep < REP(2); ++rep) pg8::gemm_phase<EpiZ, pg8::StaticOrder, true, true>(F.lds, g, S, E);
        if (BOTH(2)) GRID_BAR();
    }
    if (IN(3)) { for (int rep = 0; rep < REP(3); ++rep) p3_scan2(F); if (BOTH(3)) GRID_BAR(); }
    if (IN(4)) { for (int rep = 0; rep < REP(4); ++rep) p4_mix(F); if (BOTH(4)) GRID_BAR(); }
    if (IN(5)) {
        pg8::Gemm g{H, (const bf16*)(F.ws + WS_WOUT), M, D, D}; pg8::StaticOrder S; S.init(M, D, F.G, F.bid);
        EpiOut1 E{args.in[0], args.in[1], F.out, (bf16*)(F.ws + WS_A2), mod, args.in[8], (float*)(F.ws + WS_RSS1)};
        pg8::gemm_phase<EpiOut1, pg8::StaticOrder, true, true>(F.lds, g, S, E);
        if (BOTH(5)) GRID_BAR();
    }
    if (IN(6)) {
        pg8::Gemm g{(const bf16*)(F.ws + WS_A2), (const bf16*)(F.ws + WS_WFF1), M, FF, D}; pg8::StaticOrder S; S.init(M, FF, F.G, F.bid);
        EpiFF1 E{(const float*)(F.ws + WS_RSS1), (const float*)(F.ws + WS_C1), (bf16*)(F.ws + WS_ACT)};
        for (int rep = 0; rep < REP(6); ++rep) pg8::gemm_phase<EpiFF1, pg8::StaticOrder, true, true>(F.lds, g, S, E);
        if (BOTH(6)) GRID_BAR();
    }
    if (IN(7)) {
        pg8::Gemm g{(const bf16*)(F.ws + WS_ACT), (const bf16*)(F.ws + WS_WFF2), M, D, FF}; pg8::StaticOrder S; S.init(M, D, F.G, F.bid);
        EpiOut2 E{F.out, mod, (float*)(F.ws + WS_RSS2)};
        pg8::gemm_phase<EpiOut2, pg8::StaticOrder, true, true>(F.lds, g, S, E);
        if (BOTH(7)) GRID_BAR();
    }
    if (IN(8)) { p8_final(F); }
#undef IN
#undef BOTH
#undef GRID_BAR
}

extern "C" void kernel_launch(void* const* d_in, const int* in_sizes, int n_in, void* d_out, int out_size, void* d_ws, size_t ws_size, hipStream_t stream) {
    static int grid = 0;
    if (grid == 0) {
        if (n_in != 31 || ws_size < WS_END) { fprintf(stderr, "kernel_launch: expected 31 inputs and >= %zu bytes of workspace; got %d, %zu\n", (size_t)WS_END, n_in, ws_size); grid = -1; return; }
        int dev = 0, cus = 0, per_cu = 0;
        if (hipGetDevice(&dev) != hipSuccess || hipDeviceGetAttribute(&cus, hipDeviceAttributeMultiprocessorCount, dev) != hipSuccess) { grid = -1; return; }
        if (hipFuncSetAttribute((const void*)fwd, hipFuncAttributeMaxDynamicSharedMemorySize, LDS_BYTES) != hipSuccess) { fprintf(stderr, "kernel_launch: hipFuncSetAttribute failed\n"); grid = -1; return; }
        if (hipOccupancyMaxActiveBlocksPerMultiprocessor(&per_cu, (const void*)fwd, NWAVES * 64, LDS_BYTES) != hipSuccess || per_cu < 1) { fprintf(stderr, "kernel_launch: occupancy query says %d workgroups per CU\n", per_cu); (void)hipGetLastError(); grid = -1; return; }
        grid = cus;
    }
    if (grid < 0) return;
    if (hipMemsetAsync((char*)d_ws + WS_CTL, 0, CTL_ZERO_BYTES, stream) != hipSuccess) return;
    Args a{};
    for (int i = 0; i < 31; ++i) a.in[i] = (const float*)d_in[i];
    a.out = (float*)d_out; a.ws = (unsigned char*)d_ws;
    if (MK_N_LAUNCHES == 1) {
        a.ph_lo = 0; a.ph_hi = NPHASE;
        void* kargs[] = {&a};
        hipError_t e = hipLaunchCooperativeKernel((const void*)fwd, dim3(grid), dim3(NWAVES * 64), kargs, LDS_BYTES, stream);
        if (e != hipSuccess) fprintf(stderr, "kernel_launch: cooperative launch failed: %s (grid %d)\n", hipGetErrorString(e), grid);
    } else {
        for (int p = 0; p < NPHASE; ++p) { a.ph_lo = p; a.ph_hi = p + 1; hipLaunchKernelGGL(fwd, dim3(grid), dim3(NWAVES * 64), LDS_BYTES, stream, a); }
    }
}
```

```cpp
#include <hip/hip_runtime.h>
#include <cstdio>
#include <cstdint>
namespace pg8 {
#define PG8_LAS __attribute__((address_space(3)))
typedef unsigned short bf16_t;
typedef short bf16x8 __attribute__((ext_vector_type(8)));
typedef float f32x4 __attribute__((ext_vector_type(4)));
typedef unsigned u32x4 __attribute__((ext_vector_type(4)));
constexpr int BM = 256, BK = 64, HALF = 128, HTB = HALF * BK * 2  , STAGE_BYTES = 8 * HTB, NXCD = 8, WGM = 8;

__host__ __device__ __forceinline__ int lds_byte(int r, int c) { const int st = (r >> 4) * 2 + (c >> 5), rr = r & 15, cc = c & 31, ob = rr * 64 + cc * 2; return st * 1024 + (ob ^ (((ob >> 9) & 1) << 5)); }
__host__ __device__ __forceinline__ void stage_rc(int b, int& R, int& C) { const int st = b / 1024, sb = b % 1024, swz = sb ^ (((sb >> 9) & 1) << 5); R = (st >> 1) * 16 + swz / 64; C = (st & 1) * 32 + (swz % 64) / 2; }
__host__ __device__ __forceinline__ int perm32(int rho) { const int n = rho >> 4, i = rho & 15; return 8 * (i >> 2) + 4 * n + (i & 3); }

struct Unit { int pm, pn; };
struct Gemm { const bf16_t* A; const bf16_t* Bt; int M, N, K; };

struct StaticOrder {
    int nM, nN, nwg, G, c;
    __host__ __device__ void init(int M, int N, int G_, int c_) { nM = M / BM; nN = N / BM; nwg = nM * nN; G = G_; c = c_; }
    __host__ __device__ bool next(int i, Unit& u) const {
        const long L = (long)i * G + c; if (L >= nwg) return false;
        int wgid = (int)L; { const int q = nwg / NXCD, r = nwg % NXCD, xcd = wgid % NXCD, off = wgid / NXCD; wgid = (xcd < r ? xcd * (q + 1) : r * (q + 1) + (xcd - r) * q) + off; }
        const int nig = WGM * nN, gid = wgid / nig, fm = gid * WGM, gsz = (nM - fm) < WGM ? (nM - fm) : WGM;
        u.pm = fm + ((wgid % nig) % gsz); u.pn = (wgid % nig) / gsz; return true;
    }
    __device__ __forceinline__ void a_ready(const Unit&) const {}
    __device__ __forceinline__ void done(const Unit&) const {}
};

__device__ __forceinline__ unsigned cvt_pk_bf16(float lo, float hi) { unsigned r; asm volatile("v_cvt_pk_bf16_f32 %0, %1, %2" : "=v"(r) : "v"(lo), "v"(hi)); return r; }
typedef float f32x2 __attribute__((ext_vector_type(2)));
template <class Epi, class Sched, bool ALIGN_EPI = false, bool SP2 = false>
__device__ __forceinline__ void gemm_phase(PG8_LAS unsigned char* lds, const Gemm g, const Sched& S, const Epi& E) {
    const int tid = threadIdx.x, wid = __builtin_amdgcn_readfirstlane(tid >> 6), lane = tid & 63, wr = wid >> 2, wc = wid & 3, fr = lane & 15, fq = lane >> 4;
    const int K = g.K, nt = K / BK;
    unsigned voffA[2], voffB[2];
#pragma unroll
    for (int i = 0; i < 2; ++i) { int R, C; stage_rc(tid * 16 + i * 8192, R, C); const int Rb = Epi::PERM ? ((R & ~31) + perm32(R & 31)) : R;
        voffA[i] = (unsigned)(R * K + C) * 2u; voffB[i] = (unsigned)(Rb * K + C) * 2u; }
    const size_t kstep = (size_t)(BK * 2);
    const size_t hstep = (size_t)HALF * K * 2;
    const size_t tstep = 2 * hstep;
    const unsigned ldsw = (unsigned)wid * 1024u;
    const int aoff = lds_byte(wr * 64 + fr, fq * 8), boff = lds_byte(wc * 32 + fr, fq * 8);
#define PG8_SA(b, h) (((b) * 2 + (h)) * HTB)
#define PG8_SB(b, h) ((4 + (b) * 2 + (h)) * HTB)
#define PG8_STAGE(bufoff, gbase, voff) do { _Pragma("unroll") for (int _i = 0; _i < 2; ++_i) \
        __builtin_amdgcn_global_load_lds((const unsigned*)((const char*)(gbase) + (voff)[_i]), (PG8_LAS unsigned*)(lds + (bufoff) + ldsw + _i * 8192), 16, 0, 0); } while (0)
#define PG8_LDA(dst, b, h) do { _Pragma("unroll") for (int m = 0; m < 4; ++m) _Pragma("unroll") for (int k = 0; k < 2; ++k) dst[m][k] = *(const PG8_LAS bf16x8*)(lds + PG8_SA(b, h) + aoff + m * 2048 + k * 1024); } while (0)
#define PG8_LDB(dst, b, h) do { _Pragma("unroll") for (int n = 0; n < 2; ++n) _Pragma("unroll") for (int k = 0; k < 2; ++k) dst[n][k] = *(const PG8_LAS bf16x8*)(lds + PG8_SB(b, h) + boff + n * 2048 + k * 1024); } while (0)
#define PG8_MMA(ai, bj, At, Bt) do { __builtin_amdgcn_s_setprio(1); _Pragma("unroll") for (int m = 0; m < 4; ++m) _Pragma("unroll") for (int n = 0; n < 2; ++n) _Pragma("unroll") for (int k = 0; k < 2; ++k) \
        acc[ai][bj][m][n] = __builtin_amdgcn_mfma_f32_16x16x32_bf16(Bt[n][k], At[m][k], acc[ai][bj][m][n], 0, 0, 0); __builtin_amdgcn_s_setprio(0); } while (0)
#define PG8_WAIT_V(n) asm volatile("s_waitcnt vmcnt(" #n ")" ::: "memory")
#define PG8_WAIT_L(n) asm volatile("s_waitcnt lgkmcnt(" #n ")" ::: "memory")
#define PG8_BAR __builtin_amdgcn_s_barrier()
#define PG8_SCHED __builtin_amdgcn_sched_barrier(0)
    Unit cur, nxt; int ui = 0;
    if (!S.next(0, cur)) return;
    f32x4 acc[2][2][4][2];
#pragma unroll
    for (int a = 0; a < 2; ++a)
#pragma unroll
        for (int b = 0; b < 2; ++b)
#pragma unroll
            for (int m = 0; m < 4; ++m)
#pragma unroll
                for (int n = 0; n < 2; ++n) acc[a][b][m][n] = (f32x4){0.f, 0.f, 0.f, 0.f};
    bf16x8 At[4][2], B0[2][2], B1[2][2];
    const char* cA = (const char*)g.A + (size_t)cur.pm * tstep; const char* cB = (const char*)g.Bt + (size_t)cur.pn * tstep;
    S.a_ready(cur);
    if constexpr (SP2) {
        PG8_STAGE(PG8_SB(0, 0), cB, voffB); PG8_STAGE(PG8_SB(0, 1), cB + hstep, voffB); PG8_STAGE(PG8_SA(0, 0), cA, voffA); PG8_STAGE(PG8_SA(0, 1), cA + hstep, voffA);
        if (wr == 1) PG8_BAR;
        PG8_WAIT_V(2); PG8_BAR;
        PG8_STAGE(PG8_SB(1, 0), cB + kstep, voffB); PG8_STAGE(PG8_SA(1, 0), cA + kstep, voffA); PG8_STAGE(PG8_SB(1, 1), cB + hstep + kstep, voffB);
        PG8_WAIT_V(6); PG8_BAR;
    } else {
        PG8_STAGE(PG8_SB(0, 0), cB, voffB); PG8_STAGE(PG8_SA(0, 0), cA, voffA); PG8_STAGE(PG8_SB(0, 1), cB + hstep, voffB); PG8_STAGE(PG8_SA(0, 1), cA + hstep, voffA);
        if (wr == 1) PG8_BAR;
        PG8_WAIT_V(4); PG8_BAR;
        PG8_STAGE(PG8_SB(1, 0), cB + kstep, voffB); PG8_STAGE(PG8_SA(1, 0), cA + kstep, voffA); PG8_STAGE(PG8_SB(1, 1), cB + hstep + kstep, voffB);
        PG8_WAIT_V(6); PG8_BAR;
    }
    for (;;) {
        const bool has_next = S.next(ui + 1, nxt);
        const char* nA = has_next ? (const char*)g.A + (size_t)nxt.pm * tstep : cA; const char* nB = has_next ? (const char*)g.Bt + (size_t)nxt.pn * tstep : cB;
        for (int t = 0; t < nt; t += 2) {
            const bool last = (t == nt - 2);
            const char* a1 = cA + (size_t)(t + 1) * kstep;
            const char* a2 = last ? nA : cA + (size_t)(t + 2) * kstep; const char* b2 = last ? nB : cB + (size_t)(t + 2) * kstep;
            const char* a3 = a2 + kstep; const char* b3 = b2 + kstep;
            if (last && has_next) S.a_ready(nxt);
            if constexpr (SP2) {
            PG8_LDB(B0, 0, 0); PG8_LDB(B1, 0, 1); PG8_SCHED; PG8_LDA(At, 0, 0); PG8_STAGE(PG8_SA(1, 1), a1 + hstep, voffA);
            PG8_WAIT_V(8); PG8_WAIT_L(0); PG8_BAR; PG8_MMA(0, 0, At, B0); PG8_MMA(0, 1, At, B1); PG8_BAR; PG8_SCHED;
            PG8_LDA(At, 0, 1); PG8_STAGE(PG8_SB(0, 0), b2, voffB); PG8_STAGE(PG8_SB(0, 1), b2 + hstep, voffB); PG8_STAGE(PG8_SA(0, 0), a2, voffA);
            PG8_WAIT_V(8); PG8_WAIT_L(0); PG8_BAR; PG8_MMA(1, 0, At, B0); PG8_MMA(1, 1, At, B1); PG8_BAR; PG8_SCHED;
            PG8_LDB(B0, 1, 0); PG8_LDB(B1, 1, 1); PG8_SCHED; PG8_LDA(At, 1, 0); PG8_STAGE(PG8_SA(0, 1), a2 + hstep, voffA);
            PG8_WAIT_V(8); PG8_WAIT_L(0); PG8_BAR; PG8_MMA(0, 0, At, B0); PG8_MMA(0, 1, At, B1); PG8_BAR; PG8_SCHED;
            PG8_LDA(At, 1, 1); PG8_STAGE(PG8_SB(1, 0), b3, voffB); PG8_STAGE(PG8_SB(1, 1), b3 + hstep, voffB); PG8_STAGE(PG8_SA(1, 0), a3, voffA);
            PG8_WAIT_V(8); PG8_WAIT_L(0); PG8_BAR; PG8_MMA(1, 0, At, B0); PG8_MMA(1, 1, At, B1); PG8_BAR; PG8_SCHED;
            } else {
            PG8_LDB(B0, 0, 0); PG8_SCHED; PG8_LDA(At, 0, 0); PG8_STAGE(PG8_SA(1, 1), a1 + hstep, voffA);
            PG8_WAIT_L(8); PG8_BAR; PG8_WAIT_L(0); PG8_MMA(0, 0, At, B0); PG8_BAR; PG8_SCHED;
            PG8_LDB(B1, 0, 1); PG8_STAGE(PG8_SB(0, 0), b2, voffB);
            PG8_BAR; PG8_WAIT_L(0); PG8_MMA(0, 1, At, B1); PG8_BAR;
            PG8_LDA(At, 0, 1); PG8_STAGE(PG8_SA(0, 0), a2, voffA);
            PG8_BAR; PG8_WAIT_L(0); PG8_MMA(1, 0, At, B0); PG8_BAR; PG8_SCHED;
            PG8_STAGE(PG8_SB(0, 1), b2 + hstep, voffB);
            PG8_WAIT_V(6); PG8_BAR; PG8_MMA(1, 1, At, B1); PG8_BAR;
            PG8_LDB(B0, 1, 0); PG8_SCHED; PG8_LDA(At, 1, 0); PG8_STAGE(PG8_SA(0, 1), a2 + hstep, voffA);
            PG8_WAIT_L(8); PG8_BAR; PG8_WAIT_L(0); PG8_MMA(0, 0, At, B0); PG8_BAR; PG8_SCHED;
            PG8_LDB(B1, 1, 1); PG8_STAGE(PG8_SB(1, 0), b3, voffB);
            PG8_BAR; PG8_WAIT_L(0); PG8_MMA(0, 1, At, B1); PG8_BAR;
            PG8_LDA(At, 1, 1); PG8_STAGE(PG8_SA(1, 0), a3, voffA);
            PG8_BAR; PG8_WAIT_L(0); PG8_MMA(1, 0, At, B0); PG8_BAR; PG8_SCHED;
            PG8_STAGE(PG8_SB(1, 1), b3 + hstep, voffB);
            PG8_WAIT_V(6); PG8_BAR; PG8_MMA(1, 1, At, B1); PG8_BAR;
            }
        }
        if constexpr (ALIGN_EPI) { if (wr == 0) PG8_BAR; }
        if constexpr (!Epi::AFTER_DRAIN) { E(acc, cur, wr, wc, fr, fq); S.done(cur); }
        if (!has_next) break;
#pragma unroll
        for (int a = 0; a < 2; ++a)
#pragma unroll
            for (int b = 0; b < 2; ++b)
#pragma unroll
                for (int m = 0; m < 4; ++m)
#pragma unroll
                    for (int n = 0; n < 2; ++n) acc[a][b][m][n] = (f32x4){0.f, 0.f, 0.f, 0.f};
        cur = nxt; cA = nA; cB = nB; ++ui;
        if constexpr (ALIGN_EPI) { if (wr == 1) PG8_BAR; }
    }
    PG8_WAIT_V(0);
    if constexpr (!ALIGN_EPI) { if (wr == 0) PG8_BAR; }
    PG8_BAR;
    if constexpr (Epi::AFTER_DRAIN) { E.fused(acc, cur, wr, wc, fr, fq, lds, wid, lane); S.done(cur); }
#undef PG8_SA
#undef PG8_SB
#undef PG8_STAGE
#undef PG8_LDA
#undef PG8_LDB
#undef PG8_MMA
#undef PG8_WAIT_V
#undef PG8_WAIT_L
#undef PG8_BAR
#undef PG8_SCHED
}
}

#ifndef MK_N_LAUNCHES
#define MK_N_LAUNCHES 1
#endif
constexpr int NWAVES = 8;
constexpr int D = 1024, NH = 16, HD = 64, FF = 4096;
constexpr int M_CTX = 16 * 256, M_LAT = 4 * 2048, M = M_CTX + M_LAT;
constexpr int L_CTX = 256, L_LAT = 2048;
constexpr int NMOD = 6 * D;
constexpr int ZC_POOL = 0, ZC_R = 512, ZC_K = 1536, ZC_V = 2560, ZC_GA = 3584, ZC_GB = 4608;
constexpr int ZC_LW_A = 5632, ZC_LW_B = 5760, ZC_LA_A = 5888, ZC_LA_B = 6016, ZC_LG_A = 6144, ZC_LG_B = 6272, NZ = 6400;
constexpr int NPHASE = 9;

constexpr size_t MiB = 1u << 20;
constexpr size_t WS_CTL = 0, CTL_ZERO_BYTES = 1 * MiB;
constexpr int CW_BAR = 4096;
constexpr size_t WS_RSS1 = 256 * 1024, WS_RSS2 = 320 * 1024;
constexpr size_t WS_MOD = 1 * MiB, WS_C1 = 1 * MiB + 128 * 1024;
constexpr size_t WS_WCAT = 2 * MiB, WS_WOUT = 15 * MiB, WS_WFF1 = 17 * MiB, WS_WFF2 = 25 * MiB;
constexpr size_t WS_POOLW = 33 * MiB, WS_GW2T = 33 * MiB + 256 * 1024;
constexpr size_t WS_H = 34 * MiB;
constexpr size_t WS_Z = 58 * MiB;
constexpr size_t WS_ACT = 58 * MiB;
constexpr size_t WS_A2 = 154 * MiB;
constexpr size_t WS_END = 208 * MiB;
static_assert(WS_WCAT + (size_t)NZ * D * 2 <= WS_WOUT && WS_Z + (size_t)M * NZ * 2 <= WS_END && WS_ACT + (size_t)M * FF * 2 <= WS_A2 && WS_A2 + (size_t)M * D * 2 <= WS_END, "ws map");

constexpr int LDS_BYTES = 147456;
constexpr int RING_BYTES = 131072, MISC_OFF = 147200;

#define GAS __attribute__((address_space(1)))
#define LAS __attribute__((address_space(3)))
typedef unsigned short bf16;
typedef _Float16 f16;
typedef unsigned v4u __attribute__((ext_vector_type(4)));
typedef unsigned v2u __attribute__((ext_vector_type(2)));
typedef float f32x4 __attribute__((ext_vector_type(4)));
typedef float f32x2 __attribute__((ext_vector_type(2)));
typedef short bf16x8 __attribute__((ext_vector_type(8)));
typedef _Float16 f16x4 __attribute__((ext_vector_type(4)));
typedef _Float16 f16x8 __attribute__((ext_vector_type(8)));
typedef _Float16 f16x2 __attribute__((ext_vector_type(2)));
typedef GAS unsigned gu32;
#define RLX_AGENT __ATOMIC_RELAXED, __HIP_MEMORY_SCOPE_AGENT
#define LDS_WAIT() asm volatile("s_waitcnt lgkmcnt(0)" ::: "memory")
#define VM_WAIT() asm volatile("s_waitcnt vmcnt(0)" ::: "memory")

typedef __bf16 bf16x2_t __attribute__((ext_vector_type(2)));
__device__ __forceinline__ unsigned pkbf(float lo, float hi) { f32x2 v = {lo, hi}; bf16x2_t b = __builtin_convertvector(v, bf16x2_t); return __builtin_bit_cast(unsigned, b); }
__device__ __forceinline__ unsigned pkh(float lo, float hi) { f16x2 v = {(f16)lo, (f16)hi}; return __builtin_bit_cast(unsigned, v); }
__device__ __forceinline__ float bf2f(unsigned short b) { return __builtin_bit_cast(float, (unsigned)b << 16); }
__device__ __forceinline__ f32x4 ld_h4(const f16* p) { const f16x4 v = *(const f16x4*)p; return __builtin_convertvector(v, f32x4); }
__device__ __forceinline__ f32x4 ld_bf4(const bf16* p) { const v2u v = *(const v2u*)p; f32x4 r; r.x = __builtin_bit_cast(float, v.x << 16); r.y = __builtin_bit_cast(float, v.x & 0xffff0000u);
    r.z = __builtin_bit_cast(float, v.y << 16); r.w = __builtin_bit_cast(float, v.y & 0xffff0000u); return r; }
__device__ __forceinline__ float frcp(float x) { return __builtin_amdgcn_rcpf(x); }
__device__ __forceinline__ float sigmoidf_(float x) { return frcp(1.0f + __expf(-x)); }
__device__ __forceinline__ float wave_sum(float v) {
#pragma unroll
    for (int o = 1; o < 64; o <<= 1) v += __shfl_xor(v, o);
    return v;
}
__device__ __forceinline__ int cvec_of_row(int m) { return m < M_CTX ? 0 : 1 + (m - M_CTX) / L_LAT; }

#define XB_TMO      128
#define XB_XCNT(j)  (256  + 64 * (j))
#define XB_XSUB(j)  (1280 + 64 * (j))
#define XB_XGEN(j)  (2304 + 64 * (j))
#define XB_TOP      3328
#define XB_TOPGEN   3392
#define XCD_BAR_WORDS 3456
#define XB_SPIN_CAP (1u << 18)
__device__ __forceinline__ unsigned xb_ld(unsigned* p)              { return __hip_atomic_load(p, __ATOMIC_RELAXED, __HIP_MEMORY_SCOPE_AGENT); }
__device__ __forceinline__ unsigned xb_add(unsigned* p, unsigned v) { return __hip_atomic_fetch_add(p, v, __ATOMIC_RELAXED, __HIP_MEMORY_SCOPE_AGENT); }
__device__ __forceinline__ unsigned xb_xcc_id() { return (unsigned)__builtin_amdgcn_s_getreg((3 << 11) | 20) & 0xFu; }
#define XB_SPIN(cond, bar) do { unsigned _sp = 0; while (cond) { __builtin_amdgcn_s_sleep(1); \
    if ((++_sp & 255u) == 0u) { if (xb_ld(&(bar)[XB_TMO])) break; if (_sp > XB_SPIN_CAP) { atomicAdd(&(bar)[XB_TMO], 1u); break; } } } } while (0)
struct XcdBarrier { unsigned* bar; unsigned x; volatile LAS unsigned* st; };
__device__ __forceinline__ XcdBarrier xcd_barrier_post(unsigned* bar, volatile LAS unsigned* st) {
    XcdBarrier b; b.bar = bar; b.x = xb_xcc_id(); b.st = st;
    if (threadIdx.x == 0) (void)xb_add(&bar[XB_XCNT(b.x)], 1u);
    return b;
}
__device__ __forceinline__ void xcd_barrier_complete(unsigned* bar, unsigned x, unsigned& nloc, unsigned& nx) {
    const unsigned G = gridDim.x * gridDim.y * gridDim.z;
    unsigned sum, cnt, mine, sp = 0u;
    for (;;) {
        sum = 0u; cnt = 0u; mine = 0u;
#pragma unroll
        for (unsigned j = 0; j < 16; ++j) { const unsigned c = xb_ld(&bar[XB_XCNT(j)]); sum += c; cnt += (c > 0u) ? 1u : 0u; mine = (j == x) ? c : mine; }
        if (sum == G) break;
        __builtin_amdgcn_s_sleep(1);
        if ((++sp & 255u) == 0u) { if (xb_ld(&bar[XB_TMO])) break; if (sp > XB_SPIN_CAP) { atomicAdd(&bar[XB_TMO], 1u); break; } }
    }
    nloc = mine > 0u ? mine : 1u; nx = cnt > 0u ? cnt : 1u;
}
__device__ __forceinline__ void xcd_barrier(const XcdBarrier& b) {
    asm volatile("s_waitcnt vmcnt(0)" ::: "memory");
    __syncthreads();
    if (threadIdx.x == 0) {
        unsigned* bar = b.bar;
        __builtin_amdgcn_s_waitcnt(0);
        unsigned nloc = b.st[0], nx = b.st[1];
        if (nloc == 0u) { xcd_barrier_complete(bar, b.x, nloc, nx); b.st[0] = nloc; b.st[1] = nx; }
        const unsigned old = xb_add(&bar[XB_XSUB(b.x)], 1u);
        const unsigned gen = old / nloc;
        if (old + 1u == (gen + 1u) * nloc) {
            __builtin_amdgcn_fence(__ATOMIC_RELEASE, "agent");
            asm volatile("s_waitcnt vmcnt(0)" ::: "memory");
            const unsigned og = xb_add(&bar[XB_TOP], 1u);
            const unsigned tg = og / nx;
            if (og + 1u == (tg + 1u) * nx) xb_add(&bar[XB_TOPGEN], 1u);
            else XB_SPIN(xb_ld(&bar[XB_TOPGEN]) == tg, bar);
            __builtin_amdgcn_fence(__ATOMIC_ACQUIRE, "agent");
            xb_add(&bar[XB_XGEN(b.x)], 1u);
            asm volatile("s_waitcnt vmcnt(0)" ::: "memory");
        } else {
            XB_SPIN(xb_ld(&bar[XB_XGEN(b.x)]) == gen, bar);
            __builtin_amdgcn_fence(__ATOMIC_ACQUIRE, "agent");
            asm volatile("s_waitcnt vmcnt(0)" ::: "memory");
        }
    }
    __syncthreads();
}

struct EpiZ {
    static constexpr bool PERM = true, AFTER_DRAIN = false;
    f16* Z;
    __device__ __forceinline__ void operator()(const f32x4 (&acc)[2][2][4][2], const pg8::Unit& u, int wr, int wc, int fr, int fq) const {
        const int row0 = u.pm * 256 + wr * 64 + fr, col0 = u.pn * 256 + wc * 32 + 8 * fq;
        const bool sig = (u.pn >= ZC_GA / 256) && (u.pn < ZC_LW_A / 256);
#pragma unroll
        for (int ai = 0; ai < 2; ++ai)
#pragma unroll
            for (int m = 0; m < 4; ++m) { f16* rowp = Z + (size_t)(row0 + ai * 128 + m * 16) * NZ + col0;
#pragma unroll
                for (int bj = 0; bj < 2; ++bj) { f32x4 v0 = acc[ai][bj][m][0], v1 = acc[ai][bj][m][1];
                    if (sig) {
#pragma unroll
                        for (int e = 0; e < 4; ++e) { v0[e] = sigmoidf_(v0[e]); v1[e] = sigmoidf_(v1[e]); } }
                    v4u w; w.x = pkh(v0[0], v0[1]); w.y = pkh(v0[2], v0[3]); w.z = pkh(v1[0], v1[1]); w.w = pkh(v1[2], v1[3]);
                    *(v4u*)(rowp + bj * 128) = w; } }
    }
};
struct EpiOut1 {
    static constexpr bool PERM = false, AFTER_DRAIN = false;
    const float* xp; const float* xs; float* X1; bf16* A2; const float* mod; const float* g2; float* rowss;
    __device__ __forceinline__ void operator()(const f32x4 (&acc)[2][2][4][2], const pg8::Unit& u, int wr, int wc, int fr, int fq) const {
        const int ci = cvec_of_row(u.pm * 256);
        const float* xb = (u.pm < M_CTX / 256) ? xp + (size_t)u.pm * 256 * D : xs + (size_t)(u.pm - M_CTX / 256) * 256 * D;
        const int col0 = u.pn * 256 + wc * 32 + 4 * fq;
        f32x4 ga[2][2], gm[2][2];
#pragma unroll
        for (int bj = 0; bj < 2; ++bj)
#pragma unroll
            for (int n = 0; n < 2; ++n) { const int c = col0 + bj * 128 + n * 16;
                ga[bj][n] = *(const f32x4*)(mod + ci * NMOD + 2 * D + c);
                const f32x4 sc = *(const f32x4*)(mod + ci * NMOD + 4 * D + c), g = *(const f32x4*)(g2 + c); gm[bj][n] = g * (sc + 1.0f); }
#pragma unroll
        for (int ai = 0; ai < 2; ++ai)
#pragma unroll
            for (int m = 0; m < 4; ++m) { const int rl = ai * 128 + wr * 64 + m * 16 + fr; const size_t r = (size_t)u.pm * 256 + rl; float ss = 0.f;
#pragma unroll
                for (int bj = 0; bj < 2; ++bj)
#pragma unroll
                    for (int n = 0; n < 2; ++n) { const int c = col0 + bj * 128 + n * 16;
                        const f32x4 x = *(const f32x4*)(xb + (size_t)rl * D + c); const f32x4 x1 = x + ga[bj][n] * acc[ai][bj][m][n];
                        *(f32x4*)(X1 + r * D + c) = x1; ss += (x1[0] * x1[0] + x1[1] * x1[1]) + (x1[2] * x1[2] + x1[3] * x1[3]);
                        const f32x4 a = x1 * gm[bj][n]; v2u w; w.x = pkbf(a[0], a[1]); w.y = pkbf(a[2], a[3]); *(v2u*)(A2 + r * D + c) = w; }
                ss += __shfl_xor(ss, 16); ss += __shfl_xor(ss, 32);
                if (fq == 0) atomicAdd(rowss + r, ss); }
    }
};
struct EpiFF1 {
    static constexpr bool PERM = true, AFTER_DRAIN = false;
    const float* rowss; const float* c1; bf16* ACT;
    __device__ __forceinline__ void operator()(const f32x4 (&acc)[2][2][4][2], const pg8::Unit& u, int wr, int wc, int fr, int fq) const {
        const int ci = cvec_of_row(u.pm * 256);
        const int row0 = u.pm * 256 + wr * 64 + fr, col0 = u.pn * 256 + wc * 32 + 8 * fq;
        f32x4 cb[2][2];
#pragma unroll
        for (int bj = 0; bj < 2; ++bj)
#pragma unroll
            for (int n = 0; n < 2; ++n) cb[bj][n] = *(const f32x4*)(c1 + ci * FF + col0 + bj * 128 + 4 * n);
#pragma unroll
        for (int ai = 0; ai < 2; ++ai)
#pragma unroll
            for (int m = 0; m < 4; ++m) { const int r = row0 + ai * 128 + m * 16; const float rstd = rsqrtf(rowss[r] * (1.0f / D) + 1e-6f);
                bf16* rowp = ACT + (size_t)r * FF + col0;
#pragma unroll
                for (int bj = 0; bj < 2; ++bj) { f32x4 v0 = acc[ai][bj][m][0] * rstd + cb[bj][0], v1 = acc[ai][bj][m][1] * rstd + cb[bj][1];
#pragma unroll
                    for (int e = 0; e < 4; ++e) { const float a = fmaxf(v0[e], 0.f), b = fmaxf(v1[e], 0.f); v0[e] = a * a; v1[e] = b * b; }
                    v4u w; w.x = pkbf(v0[0], v0[1]); w.y = pkbf(v0[2], v0[3]); w.z = pkbf(v1[0], v1[1]); w.w = pkbf(v1[2], v1[3]);
                    *(v4u*)(rowp + bj * 128) = w; } }
    }
};
struct EpiOut2 {
    static constexpr bool PERM = false, AFTER_DRAIN = false;
    float* X; const float* mod; float* rowss;
    __device__ __forceinline__ void operator()(const f32x4 (&acc)[2][2][4][2], const pg8::Unit& u, int wr, int wc, int fr, int fq) const {
        const int ci = cvec_of_row(u.pm * 256);
        const int col0 = u.pn * 256 + wc * 32 + 4 * fq;
        f32x4 ga[2][2];
#pragma unroll
        for (int bj = 0; bj < 2; ++bj)
#pragma unroll
            for (int n = 0; n < 2; ++n) ga[bj][n] = *(const f32x4*)(mod + ci * NMOD + 5 * D + col0 + bj * 128 + n * 16);
#pragma unroll
        for (int ai = 0; ai < 2; ++ai)
#pragma unroll
            for (int m = 0; m < 4; ++m) { const size_t r = (size_t)u.pm * 256 + ai * 128 + wr * 64 + m * 16 + fr; float ss = 0.f;
#pragma unroll
                for (int bj = 0; bj < 2; ++bj)
#pragma unroll
                    for (int n = 0; n < 2; ++n) { const int c = col0 + bj * 128 + n * 16;
                        const f32x4 x = *(const f32x4*)(X + r * D + c); const f32x4 x2 = x + ga[bj][n] * acc[ai][bj][m][n];
                        *(f32x4*)(X + r * D + c) = x2; ss += (x2[0] * x2[0] + x2[1] * x2[1]) + (x2[2] * x2[2] + x2[3] * x2[3]); }
                ss += __shfl_xor(ss, 16); ss += __shfl_xor(ss, 32);
                if (fq == 0) atomicAdd(rowss + r, ss); }
    }
};

struct Args { const float* in[31]; float* out; unsigned char* ws; int ph_lo, ph_hi; };
struct Frame {
    LAS unsigned char* lds;
    int tid, lane, wave, G, bid;
    const float* const* in;
    float* out; unsigned char* ws;
};

__device__ __forceinline__ void tr_item(const float* W, int ldw, const float* mu, int mode, bf16* WT, int ldk, LAS float* scr, int kb, int nb, int lane) {
    const int k0 = 64 * kb, n0 = 32 * nb;
#pragma unroll 8
    for (int i = 0; i < 32; ++i) { const int kk = 2 * i + (lane >> 5); float v = W[(size_t)(k0 + kk) * ldw + n0 + (lane & 31)];
        if (mode) { const float mm = mu[k0 + kk]; v *= (mode == 1) ? (1.0f - mm) : mm; }
        scr[kk * 33 + (lane & 31)] = v; }
    LDS_WAIT(); asm volatile("" ::: "memory");
    const int c = lane & 7;
#pragma unroll
    for (int j = 0; j < 4; ++j) { const int n = (lane >> 3) + 8 * j; const LAS float* s = scr + (8 * c) * 33 + n;
        v4u o; o.x = pkbf(s[0 * 33], s[1 * 33]); o.y = pkbf(s[2 * 33], s[3 * 33]); o.z = pkbf(s[4 * 33], s[5 * 33]); o.w = pkbf(s[6 * 33], s[7 * 33]);
        *(GAS v4u*)(WT + (size_t)(n0 + n) * ldk + k0 + 8 * c) = o; }
    LDS_WAIT(); asm volatile("" ::: "memory");
}
__device__ __forceinline__ void p0_prologue(Frame& F) {
    const float* const* in = F.in;
    {
        LAS float* sl = (LAS float*)(F.lds + 98304);
        LAS float* red = (LAS float*)(F.lds + 98304 + 20480);
        if (F.bid < 192 || F.G < 192) {
            for (int i = F.tid; i < 5 * D; i += NWAVES * 64) { const int ci = i >> 10, k = i & 1023; const float x = ci == 0 ? in[4][k] : in[3][(ci - 1) * D + k]; sl[i] = x * frcp(1.0f + __expf(-x)); }
            __syncthreads();
            float* mod = (float*)(F.ws + WS_MOD);
            for (int item = F.bid; item < 192; item += F.G) {
                const int col = F.tid & 31, ks = F.tid >> 5, n = item * 32 + col;
                float a0 = 0.f, a1 = 0.f, a2 = 0.f, a3 = 0.f, a4 = 0.f;
                const float* wp = in[5] + (size_t)(ks * 64) * NMOD + n;
#pragma unroll 8
                for (int k = 0; k < 64; ++k) { const float w = wp[(size_t)k * NMOD]; const int kk = ks * 64 + k;
                    a0 += sl[kk] * w; a1 += sl[1024 + kk] * w; a2 += sl[2048 + kk] * w; a3 += sl[3072 + kk] * w; a4 += sl[4096 + kk] * w; }
                LAS float* rp = red + (ks * 32 + col) * 5; rp[0] = a0; rp[1] = a1; rp[2] = a2; rp[3] = a3; rp[4] = a4;
                __syncthreads();
                if (F.tid < 160) { const int ci = F.tid >> 5, cc = F.tid & 31; float s = in[6][item * 32 + cc];
#pragma unroll
                    for (int q = 0; q < 16; ++q) s += red[(q * 32 + cc) * 5 + ci];
                    mod[ci * NMOD + item * 32 + cc] = s; }
                __syncthreads();
            }
        }
    }
    LAS float* scr = (LAS float*)(F.lds + F.wave * 12288);
    const int gw = F.bid * NWAVES + F.wave, NGW = F.G * NWAVES;
    bf16* WcatT = (bf16*)(F.ws + WS_WCAT); bf16* WoutT = (bf16*)(F.ws + WS_WOUT); bf16* Wff1T = (bf16*)(F.ws + WS_WFF1); bf16* Wff2T = (bf16*)(F.ws + WS_WFF2);
    bf16* poolWT = (bf16*)(F.ws + WS_POOLW); bf16* gw2T = (bf16*)(F.ws + WS_GW2T);
    constexpr int I_IN = 16 * 176, I_LORA = 6 * 64, I_OUT = 16 * 32, I_F1 = 16 * 128, I_F2 = 64 * 32, I_POOL = 4 * 16, I_G2 = 2 * 32;
    constexpr int NITEMS = I_IN + I_LORA + I_OUT + I_F1 + I_F2 + I_POOL + I_G2;
    for (int it = gw; it < NITEMS; it += NGW) {
        int r = it;
        if (r < I_IN) { tr_item(in[9], 5632, nullptr, 0, WcatT, D, scr, r / 176, r % 176, F.lane); continue; } r -= I_IN;
        if (r < I_LORA) { const int qs = r / 64, q = qs >> 1, s = qs & 1, rr = r % 64, kb = rr / 4, nb = rr % 4;
            const float* W; int ldw;
            if (q < 2) { W = (q == 0 ? in[13] : in[16]) + (size_t)(nb >> 1) * D * 64 + (nb & 1) * 32; ldw = 64; } else { W = in[18] + nb * 32; ldw = 128; }
            tr_item(W, ldw, in[11] + q * D, s + 1, WcatT + (size_t)(ZC_LW_A + q * 256 + s * 128 + nb * 32) * D, D, scr, kb, 0, F.lane); continue; } r -= I_LORA;
        if (r < I_OUT) { tr_item(in[27], D, nullptr, 0, WoutT, D, scr, r / 32, r % 32, F.lane); continue; } r -= I_OUT;
        if (r < I_F1) { tr_item(in[28], FF, nullptr, 0, Wff1T, D, scr, r / 128, r % 128, F.lane); continue; } r -= I_F1;
        if (r < I_F2) { tr_item(in[29], D, nullptr, 0, Wff2T, FF, scr, r / 32, r % 32, F.lane); continue; } r -= I_F2;
        if (r < I_POOL) { const int g = r / 16, rr = r % 16; tr_item(in[25] + (size_t)g * 128 * 256, 256, nullptr, 0, poolWT + (size_t)g * 256 * 128, 128, scr, rr / 8, rr % 8, F.lane); continue; } r -= I_POOL;
        tr_item(in[19], D, nullptr, 0, gw2T, 128, scr, r / 32, r % 32, F.lane);
    }
}

__device__ __forceinline__ void p1_hprep(Frame& F) {
    const float* const* in = F.in;
    const int gw = F.bid * NWAVES + F.wave, NGW = F.G * NWAVES;
    const float* mod = (const float*)(F.ws + WS_MOD);
    bf16* H = (bf16*)(F.ws + WS_H);
    for (int m = gw; m < M; m += NGW) {
        const float* xrow = m < M_CTX ? in[0] + (size_t)m * D : in[1] + (size_t)(m - M_CTX) * D;
        const int ci = cvec_of_row(m);
        f32x4 v[4]; float s = 0.f;
#pragma unroll
        for (int j = 0; j < 4; ++j) { v[j] = *(const f32x4*)(xrow + 4 * (F.lane + 64 * j)); s += (v[j].x * v[j].x + v[j].y * v[j].y) + (v[j].z * v[j].z + v[j].w * v[j].w); }
        const float rstd = rsqrtf(wave_sum(s) * (1.0f / D) + 1e-6f);
#pragma unroll
        for (int j = 0; j < 4; ++j) { const int c = 4 * (F.lane + 64 * j);
            const f32x4 g = *(const f32x4*)(in[7] + c), sh = *(const f32x4*)(mod + ci * NMOD + c), sc = *(const f32x4*)(mod + ci * NMOD + D + c);
            const f32x4 y = (v[j] * rstd) * g * (sc + 1.0f) + sh;
            v2u w; w.x = pkbf(y.x, y.y); w.y = pkbf(y.z, y.w); *(v2u*)(H + (size_t)m * D + c) = w; }
    }
    const bf16* Wff1T = (const bf16*)(F.ws + WS_WFF1); float* c1 = (float*)(F.ws + WS_C1);
    for (int n = gw; n < FF; n += NGW) {
        const bf16* wr = Wff1T + (size_t)n * D + F.lane * 16;
        const v4u w0 = *(const v4u*)wr, w1 = *(const v4u*)(wr + 8);
        float w[16];
#pragma unroll
        for (int e = 0; e < 4; ++e) { w[2 * e] = __builtin_bit_cast(float, w0[e] << 16); w[2 * e + 1] = __builtin_bit_cast(float, w0[e] & 0xffff0000u);
            w[8 + 2 * e] = __builtin_bit_cast(float, w1[e] << 16); w[8 + 2 * e + 1] = __builtin_bit_cast(float, w1[e] & 0xffff0000u); }
#pragma unroll
        for (int ci = 0; ci < 5; ++ci) { const float* sh = mod + ci * NMOD + 3 * D + F.lane * 16; float s = 0.f;
#pragma unroll
            for (int q = 0; q < 4; ++q) { const f32x4 x = *(const f32x4*)(sh + 4 * q); s += x.x * w[4 * q] + x.y * w[4 * q + 1] + x.z * w[4 * q + 2] + x.w * w[4 * q + 3]; }
            s = wave_sum(s); if (F.lane == 0) c1[ci * FF + n] = s; }
    }
}

constexpr int SC = 32;
__device__ __forceinline__ void p3_scan(Frame& F) {
    const float* const* in = F.in;
    const f16* Z = (const f16*)(F.ws + WS_Z);
    LAS float* OPS = (LAS float*)(F.lds);
    LAS float* HW = (LAS float*)(F.lds + 49152);
    LAS float* HA = (LAS float*)(F.lds + 57344);
    LAS float* WD2 = (LAS float*)(F.lds + 65536);
    LAS float* WA2 = (LAS float*)(F.lds + 81920);
    LAS float* YB = (LAS float*)(F.lds + 98304);
    const int tid = F.tid, i = tid >> 3, g = tid & 7;
    const int ptt = tid >> 4, pc4 = (tid & 15) * 4;
    constexpr int NLAT = 4 * NH * 2, NCTX = 16 * NH * 2, NCH = NLAT + NCTX;
    for (int slot = 0;; ++slot) {
        int chain;
        if (F.G == 256) { if (F.bid < 128) { if (slot > 0) break; chain = F.bid; } else { if (slot > 3) break; chain = NLAT + (F.bid - 128) + 128 * slot; } }
        else { chain = F.bid + slot * F.G; if (chain >= NCH) break; }
        const bool isLat = chain < NLAT; const int cid = isLat ? chain : chain - NLAT;
        const int b = cid / 32, head = (cid >> 1) & 15, d = cid & 1;
        const int L = isLat ? L_LAT : L_CTX, m0 = isLat ? M_CTX + b * L_LAT : b * L_CTX;
        bf16* Y = (bf16*)F.out + (size_t)d * M * D;
        __syncthreads();
        for (int idx = tid; idx < 4096; idx += NWAVES * 64) { const int k = idx >> 6, c = idx & 63;
            WD2[idx] = in[14][(size_t)(d * 64 + k) * D + head * 64 + c]; WA2[idx] = in[17][(size_t)(d * 64 + k) * D + head * 64 + c]; }
        float S[8];
        if (isLat) { const float* sp = in[2] + ((size_t)((b * 2 + d) * NH + head)) * 4096 + i * 64 + g * 8; const f32x4 s0 = *(const f32x4*)sp, s1 = *(const f32x4*)(sp + 4);
            S[0] = s0.x; S[1] = s0.y; S[2] = s0.z; S[3] = s0.w; S[4] = s1.x; S[5] = s1.y; S[6] = s1.z; S[7] = s1.w; }
        else {
#pragma unroll
            for (int j = 0; j < 8; ++j) S[j] = 0.f; }
        const int hc = head * 64 + pc4;
        const f32x4 mu_r = *(const f32x4*)(in[10] + hc), mu_k = *(const f32x4*)(in[10] + D + hc), mu_v = *(const f32x4*)(in[10] + 2 * D + hc);
        const f32x4 kkw = *(const f32x4*)(in[20] + hc), kaw = *(const f32x4*)(in[21] + hc);
        const f32x4 wd0 = *(const f32x4*)(in[12] + d * D + hc), a0v = *(const f32x4*)(in[15] + d * D + hc);
        const int nch = L / SC;
        for (int ch = 0; ch < nch; ++ch) {
            const int t0 = d == 0 ? SC * ch : L - SC * (ch + 1);
            f32x4 k4, kk4;
            {
                const int t = t0 + ptt; const f16* zr = Z + (size_t)(m0 + t) * NZ;
                const float fp = t > 0 ? 0.5f : 0.f, fn = t < L - 1 ? 0.5f : 0.f;
                const f16* zp = t > 0 ? zr - NZ : zr; const f16* zn = t < L - 1 ? zr + NZ : zr;
                const f32x4 rz = ld_h4(zr + ZC_R + hc), kz = ld_h4(zr + ZC_K + hc), vz = ld_h4(zr + ZC_V + hc);
                const f32x4 rs = ld_h4(zp + ZC_R + hc) * fp + ld_h4(zn + ZC_R + hc) * fn;
                const f32x4 ks = ld_h4(zp + ZC_K + hc) * fp + ld_h4(zn + ZC_K + hc) * fn;
                const f32x4 vs = ld_h4(zp + ZC_V + hc) * fp + ld_h4(zn + ZC_V + hc) * fn;
                const f32x4 r4 = rz + (rs - rz) * mu_r; k4 = kz + (ks - kz) * mu_k; const f32x4 v4 = vz + (vs - vz) * mu_v;
                const int lc = d * 64 + pc4;
                f32x4 hw = ld_h4(zr + ZC_LW_A + lc) + ld_h4(zp + ZC_LW_B + lc) * fp + ld_h4(zn + ZC_LW_B + lc) * fn;
                const f32x4 ha = ld_h4(zr + ZC_LA_A + lc) + ld_h4(zp + ZC_LA_B + lc) * fp + ld_h4(zn + ZC_LA_B + lc) * fn;
#pragma unroll
                for (int e = 0; e < 4; ++e) hw[e] = 1.0f - 2.0f * frcp(__expf(2.0f * hw[e]) + 1.0f);
                const f32x4 ku = k4 * kkw; float ssq = (ku.x * ku.x + ku.y * ku.y) + (ku.z * ku.z + ku.w * ku.w);
                ssq += __shfl_xor(ssq, 1); ssq += __shfl_xor(ssq, 2); ssq += __shfl_xor(ssq, 4); ssq += __shfl_xor(ssq, 8);
                kk4 = ku * rsqrtf(ssq + 1e-12f);
                *(LAS f32x4*)(HW + ptt * 64 + pc4) = hw; *(LAS f32x4*)(HA + ptt * 64 + pc4) = ha;
                *(LAS f32x4*)(OPS + ptt * 384 + 64 + pc4) = kk4; *(LAS f32x4*)(OPS + ptt * 384 + 256 + pc4) = r4; *(LAS f32x4*)(OPS + ptt * 384 + 320 + pc4) = v4;
            }
            __syncthreads();
            {
                f32x4 aw = {0.f, 0.f, 0.f, 0.f}, aa = {0.f, 0.f, 0.f, 0.f};
#pragma unroll 8
                for (int k = 0; k < 64; ++k) { const float hwk = HW[ptt * 64 + k], hak = HA[ptt * 64 + k];
                    aw += *(const LAS f32x4*)(WD2 + k * 64 + pc4) * hwk; aa += *(const LAS f32x4*)(WA2 + k * 64 + pc4) * hak; }
                f32x4 dec, av, kd, bb;
#pragma unroll
                for (int e = 0; e < 4; ++e) { dec[e] = __expf(-0.6065306597126334f * sigmoidf_(wd0[e] + aw[e])); av[e] = sigmoidf_(a0v[e] + aa[e]); }
                kd = k4 * ((av - 1.0f) * kaw + 1.0f); bb = kk4 * av;
                *(LAS f32x4*)(OPS + ptt * 384 + pc4) = dec; *(LAS f32x4*)(OPS + ptt * 384 + 128 + pc4) = bb; *(LAS f32x4*)(OPS + ptt * 384 + 192 + pc4) = kd;
            }
            __syncthreads();
#pragma unroll 2
            for (int s = 0; s < SC; ++s) {
                const int tt = d == 0 ? s : SC - 1 - s;
                const LAS float* op = OPS + tt * 384 + g * 8;
                const f32x4 w0 = *(const LAS f32x4*)(op), w1 = *(const LAS f32x4*)(op + 4);
                const f32x4 q0 = *(const LAS f32x4*)(op + 64), q1 = *(const LAS f32x4*)(op + 68);
                const f32x4 b0 = *(const LAS f32x4*)(op + 128), b1 = *(const LAS f32x4*)(op + 132);
                const f32x4 d0 = *(const LAS f32x4*)(op + 192), d1 = *(const LAS f32x4*)(op + 196);
                const f32x4 r0 = *(const LAS f32x4*)(op + 256), r1 = *(const LAS f32x4*)(op + 260);
                const float v = OPS[tt * 384 + 320 + i];
                float p = (S[0] * q0.x + S[1] * q0.y) + (S[2] * q0.z + S[3] * q0.w) + (S[4] * q1.x + S[5] * q1.y) + (S[6] * q1.z + S[7] * q1.w);
                p += __shfl_xor(p, 1); p += __shfl_xor(p, 2); p += __shfl_xor(p, 4);
                S[0] = S[0] * w0.x - p * b0.x + v * d0.x; S[1] = S[1] * w0.y - p * b0.y + v * d0.y; S[2] = S[2] * w0.z - p * b0.z + v * d0.z; S[3] = S[3] * w0.w - p * b0.w + v * d0.w;
                S[4] = S[4] * w1.x - p * b1.x + v * d1.x; S[5] = S[5] * w1.y - p * b1.y + v * d1.y; S[6] = S[6] * w1.z - p * b1.z + v * d1.z; S[7] = S[7] * w1.w - p * b1.w + v * d1.w;
                float y = (S[0] * r0.x + S[1] * r0.y) + (S[2] * r0.z + S[3] * r0.w) + (S[4] * r1.x + S[5] * r1.y) + (S[6] * r1.z + S[7] * r1.w);
                y += __shfl_xor(y, 1); y += __shfl_xor(y, 2); y += __shfl_xor(y, 4);
                if (g == 0) YB[tt * 64 + i] = y;
            }
            __syncthreads();
            { const f32x4 y4 = *(const LAS f32x4*)(YB + ptt * 64 + pc4); v2u w; w.x = pkbf(y4.x, y4.y); w.y = pkbf(y4.z, y4.w);
              *(v2u*)(Y + (size_t)(m0 + t0 + ptt) * D + hc) = w; }
        }
        if (!isLat) { float* so = F.out + (size_t)M * D + ((size_t)((b * 2 + d) * NH + head)) * 4096 + i * 64 + g * 8;
            *(f32x4*)so = (f32x4){S[0], S[1], S[2], S[3]}; *(f32x4*)(so + 4) = (f32x4){S[4], S[5], S[6], S[7]}; }
    }
}

typedef short s16x4 __attribute__((ext_vector_type(4)));
__device__ __forceinline__ int sw(int row, int col) { return row * 64 + ((((col >> 3) ^ (row >> 1)) & 7) << 3) + (col & 7); }
__device__ __forceinline__ bf16x8 ldfrag(const LAS bf16* buf, int row, int col) { return *(const LAS bf16x8*)(buf + sw(row, col)); }
__device__ __forceinline__ void mm_blk(f32x4 (&acc)[2][2], const LAS bf16* X, int xr0, const LAS bf16* Yt, int yr0, int fr, int fq) {
#pragma unroll
    for (int ks = 0; ks < 2; ++ks) {
        bf16x8 a[2], b[2];
#pragma unroll
        for (int t = 0; t < 2; ++t) { a[t] = ldfrag(X, xr0 + 16 * t + fr, 32 * ks + 8 * fq); b[t] = ldfrag(Yt, yr0 + 16 * t + fr, 32 * ks + 8 * fq); }
#pragma unroll
        for (int ti = 0; ti < 2; ++ti)
#pragma unroll
            for (int tj = 0; tj < 2; ++tj) acc[ti][tj] = __builtin_amdgcn_mfma_f32_16x16x32_bf16(a[ti], b[tj], acc[ti][tj], 0, 0, 0);
    }
}
__device__ __forceinline__ void zero_blk(f32x4 (&acc)[2][2]) {
#pragma unroll
    for (int ti = 0; ti < 2; ++ti)
#pragma unroll
        for (int tj = 0; tj < 2; ++tj) acc[ti][tj] = (f32x4){0.f, 0.f, 0.f, 0.f};
}
__device__ __forceinline__ void st_blk_t(LAS bf16* dst, const f32x4 (&acc)[2][2], int xr0, int yr0, int fr, int fq) {
#pragma unroll
    for (int ti = 0; ti < 2; ++ti)
#pragma unroll
        for (int tj = 0; tj < 2; ++tj) { v2u w; w.x = pkbf(acc[ti][tj][0], acc[ti][tj][1]); w.y = pkbf(acc[ti][tj][2], acc[ti][tj][3]);
            *(LAS v2u*)(dst + sw(yr0 + 16 * tj + fr, xr0 + 16 * ti + 4 * fq)) = w; }
}
#ifndef SREP_MASK
#define SREP_MASK 0
#endif
#ifndef SREP_N
#define SREP_N 2
#endif
#define SREP(k) for (int srep_ = 0; srep_ < (((SREP_MASK >> (k)) & 1) ? 1 + SREP_N : 1); ++srep_)
constexpr int CS = 64;
__device__ __forceinline__ void p3_scan2(Frame& F) {
    const float* const* in = F.in;
    const f16* Z = (const f16*)(F.ws + WS_Z);
    LAS bf16* const B0 = (LAS bf16*)(F.lds);
#define MB(n) (B0 + (n) * 4096)
    LAS bf16* const KKg = MB(0); LAS bf16* const Rg = MB(1); LAS bf16* const Bi = MB(2); LAS bf16* const Ki = MB(3);
    LAS bf16* const nBct = MB(4); LAS bf16* const Kct = MB(5); LAS bf16* const Vt = MB(6); LAS bf16* const Sb = MB(7);
    LAS bf16* const Aab = MB(8); LAS bf16* const Aak = MB(9); LAS bf16* const nArb = MB(10); LAS bf16* const Ark = MB(11); LAS bf16* const Minv = MB(12);
    LAS bf16* const RHSt = Bi; LAS bf16* const Ut = Ki; LAS bf16* const YB = KKg; LAS bf16* const HW = Bi; LAS bf16* const HA = Ki;
    LAS f16* const r16 = (LAS f16*)MB(8); LAS f16* const k16 = (LAS f16*)MB(9); LAS f16* const v16 = (LAS f16*)MB(10); LAS f16* const kk16 = (LAS f16*)MB(11); LAS f16* const a16 = (LAS f16*)MB(12);
    LAS bf16* const Wd2t = MB(13); LAS bf16* const Wa2t = MB(14);
    LAS float* const LW = (LAS float*)(F.lds + 15 * 8192);
    LAS float* const AD = LW;
    LAS float* const SEG = (LAS float*)(F.lds + 15 * 8192 + 16384);
    LAS float* const GC = SEG + 512;
    LAS bf16* const XT = (LAS bf16*)(GC + 64);
    LAS float* const CST = (LAS float*)(XT + 1024);
    const int tid = F.tid, lane = F.lane, wave = F.wave;
#define OPQ_LANE() int ln_ = lane; asm volatile("" : "+v"(ln_)); const int fr = ln_ & 15, fq = ln_ >> 4
#define OPQ_TID() int td_ = tid; asm volatile("" : "+v"(td_)); const int ptt = td_ >> 3, pc8 = (td_ & 7) * 8, cch = td_ & 63, cseg = td_ >> 6; (void)ptt; (void)pc8; (void)cch; (void)cseg
    constexpr int NLAT = 4 * NH * 2, NCTX = 16 * NH * 2, NCH = NLAT + NCTX;
    for (int slot = 0;; ++slot) {
        int chain;
        if (F.G == 256) { if (F.bid < 128) { if (slot > 0) break; chain = F.bid; } else { if (slot > 3) break; chain = NLAT + (F.bid - 128) + 128 * slot; } }
        else { chain = F.bid + slot * F.G; if (chain >= NCH) break; }
        const bool isLat = chain < NLAT; const int cid = isLat ? chain : chain - NLAT;
        const int b = cid / 32, head = (cid >> 1) & 15, d = cid & 1;
        const int L = isLat ? L_LAT : L_CTX, m0 = isLat ? M_CTX + b * L_LAT : b * L_CTX;
        bf16* Y = (bf16*)F.out + (size_t)d * M * D;
        __syncthreads();
        for (int idx = tid; idx < 4096; idx += NWAVES * 64) { const int k = idx >> 6, c = idx & 63;
            const float wv = in[14][(size_t)(d * 64 + k) * D + head * 64 + c], av = in[17][(size_t)(d * 64 + k) * D + head * 64 + c];
            Wd2t[sw(c, k)] = (bf16)(pkbf(wv, 0.f) & 0xffffu); Wa2t[sw(c, k)] = (bf16)(pkbf(av, 0.f) & 0xffffu); }
        const int v4 = wave & 3, bi = v4 >> 1, bj = v4 & 1;
        f32x4 Tacc[2][2]; zero_blk(Tacc);
        if (wave >= 4) { OPQ_LANE();
            if (isLat) { const float* sp = in[2] + ((size_t)((b * 2 + d) * NH + head)) * 4096;
#pragma unroll
                for (int ti = 0; ti < 2; ++ti)
#pragma unroll
                    for (int tj = 0; tj < 2; ++tj) Tacc[ti][tj] = *(const f32x4*)(sp + (32 * bj + 16 * tj + fr) * 64 + 32 * bi + 16 * ti + 4 * fq); }
            st_blk_t(Sb, Tacc, 32 * bi, 32 * bj, fr, fq);
        }
        if (tid < 256) { const int q = tid >> 6, c = tid & 63; CST[tid] = q < 3 ? in[10][q * D + head * 64 + c] : in[20][head * 64 + c]; }
        const float kac = in[21][head * 64 + (tid & 63)];
        f32x4 biasv[2];
        { const int fq0 = lane >> 4;
#pragma unroll
          for (int ti = 0; ti < 2; ++ti) biasv[ti] = *(const f32x4*)((wave < 4 ? in[12] : in[15]) + d * D + head * 64 + 32 * bi + 16 * ti + 4 * fq0); }
        const int nch = L / CS;
        f16x8 pz[15];
#define ZLOAD(chn) do { OPQ_TID(); const int tau_ = CS * (chn) + ptt, t_ = d == 0 ? tau_ : L - 1 - tau_; const int hc8_ = head * 64 + pc8, lc_ = d * 64 + pc8; \
            const f16* zr_ = Z + (size_t)(m0 + t_) * NZ; const f16* zp_ = t_ > 0 ? zr_ - NZ : zr_; const f16* zn_ = t_ < L - 1 ? zr_ + NZ : zr_; \
            pz[0] = *(const f16x8*)(zr_ + ZC_R + hc8_); pz[1] = *(const f16x8*)(zp_ + ZC_R + hc8_); pz[2] = *(const f16x8*)(zn_ + ZC_R + hc8_); \
            pz[3] = *(const f16x8*)(zr_ + ZC_K + hc8_); pz[4] = *(const f16x8*)(zp_ + ZC_K + hc8_); pz[5] = *(const f16x8*)(zn_ + ZC_K + hc8_); \
            pz[6] = *(const f16x8*)(zr_ + ZC_V + hc8_); pz[7] = *(const f16x8*)(zp_ + ZC_V + hc8_); pz[8] = *(const f16x8*)(zn_ + ZC_V + hc8_); \
            pz[9] = *(const f16x8*)(zr_ + ZC_LW_A + lc_); pz[10] = *(const f16x8*)(zp_ + ZC_LW_B + lc_); pz[11] = *(const f16x8*)(zn_ + ZC_LW_B + lc_); \
            pz[12] = *(const f16x8*)(zr_ + ZC_LA_A + lc_); pz[13] = *(const f16x8*)(zp_ + ZC_LA_B + lc_); pz[14] = *(const f16x8*)(zn_ + ZC_LA_B + lc_); } while (0)
        ZLOAD(0);
        for (int ch = 0; ch < nch; ++ch) {
            SREP(0) {
                OPQ_TID();
                const int tau = CS * ch + ptt, t = d == 0 ? tau : L - 1 - tau;
                const float fp = t > 0 ? 0.5f : 0.f, fn = t < L - 1 ? 0.5f : 0.f;
                const f16x8 rz = pz[0], rp = pz[1], rn = pz[2], kz = pz[3], kp = pz[4], kn = pz[5], vz = pz[6], vp = pz[7], vn = pz[8];
                const f16x8 wa = pz[9], wbp = pz[10], wbn = pz[11], aa = pz[12], abp = pz[13], abn = pz[14];
                float mur[8], muk[8], muv[8], kkw[8];
#pragma unroll
                for (int h = 0; h < 2; ++h) { const f32x4 a_ = *(const LAS f32x4*)(CST + pc8 + 4 * h), b_ = *(const LAS f32x4*)(CST + 64 + pc8 + 4 * h), c_ = *(const LAS f32x4*)(CST + 128 + pc8 + 4 * h), d_ = *(const LAS f32x4*)(CST + 192 + pc8 + 4 * h);
#pragma unroll
                    for (int e = 0; e < 4; ++e) { mur[4 * h + e] = a_[e]; muk[4 * h + e] = b_[e]; muv[4 * h + e] = c_[e]; kkw[4 * h + e] = d_[e]; } }
                float rr[8], kk_[8], vv[8], ku[8], hw[8], ha[8]; float ssq = 0.f;
#pragma unroll
                for (int e = 0; e < 8; ++e) {
                    const float r0 = (float)rz[e], k0 = (float)kz[e], v0 = (float)vz[e];
                    rr[e] = r0 + (((float)rp[e] * fp + (float)rn[e] * fn) - r0) * mur[e];
                    kk_[e] = k0 + (((float)kp[e] * fp + (float)kn[e] * fn) - k0) * muk[e];
                    vv[e] = v0 + (((float)vp[e] * fp + (float)vn[e] * fn) - v0) * muv[e];
                    ku[e] = kk_[e] * kkw[e]; ssq += ku[e] * ku[e];
                    const float h = (float)wa[e] + (float)wbp[e] * fp + (float)wbn[e] * fn;
                    hw[e] = 1.0f - 2.0f * frcp(__expf(2.0f * h) + 1.0f);
                    ha[e] = (float)aa[e] + (float)abp[e] * fp + (float)abn[e] * fn; }
                ssq += __shfl_xor(ssq, 1); ssq += __shfl_xor(ssq, 2); ssq += __shfl_xor(ssq, 4);
                const float rn_ = rsqrtf(ssq + 1e-12f);
                v4u o;
                o.x = pkh(rr[0], rr[1]); o.y = pkh(rr[2], rr[3]); o.z = pkh(rr[4], rr[5]); o.w = pkh(rr[6], rr[7]); *(LAS v4u*)(r16 + ptt * 64 + pc8) = o;
                o.x = pkh(kk_[0], kk_[1]); o.y = pkh(kk_[2], kk_[3]); o.z = pkh(kk_[4], kk_[5]); o.w = pkh(kk_[6], kk_[7]); *(LAS v4u*)(k16 + ptt * 64 + pc8) = o;
                o.x = pkh(vv[0], vv[1]); o.y = pkh(vv[2], vv[3]); o.z = pkh(vv[4], vv[5]); o.w = pkh(vv[6], vv[7]); *(LAS v4u*)(v16 + ptt * 64 + pc8) = o;
                o.x = pkh(ku[0] * rn_, ku[1] * rn_); o.y = pkh(ku[2] * rn_, ku[3] * rn_); o.z = pkh(ku[4] * rn_, ku[5] * rn_); o.w = pkh(ku[6] * rn_, ku[7] * rn_); *(LAS v4u*)(kk16 + ptt * 64 + pc8) = o;
                o.x = pkbf(hw[0], hw[1]); o.y = pkbf(hw[2], hw[3]); o.z = pkbf(hw[4], hw[5]); o.w = pkbf(hw[6], hw[7]); *(LAS v4u*)(HW + sw(ptt, pc8)) = o;
                o.x = pkbf(ha[0], ha[1]); o.y = pkbf(ha[2], ha[3]); o.z = pkbf(ha[4], ha[5]); o.w = pkbf(ha[6], ha[7]); *(LAS v4u*)(HA + sw(ptt, pc8)) = o;
            }
            if (ch + 1 < nch) ZLOAD(ch + 1);
            __syncthreads();
            SREP(1) {
                OPQ_LANE();
                f32x4 acc[2][2]; zero_blk(acc);
                mm_blk(acc, wave < 4 ? Wd2t : Wa2t, 32 * bi, wave < 4 ? HW : HA, 32 * bj, fr, fq);
#pragma unroll
                for (int ti = 0; ti < 2; ++ti) { const int c0 = 32 * bi + 16 * ti + 4 * fq;
                    const f32x4 bias = biasv[ti];
#pragma unroll
                    for (int tj = 0; tj < 2; ++tj) { const int tt = 32 * bj + 16 * tj + fr; f32x4 x = acc[ti][tj] + bias;
#pragma unroll
                        for (int e = 0; e < 4; ++e) x[e] = sigmoidf_(x[e]);
                        if (wave < 4) *(LAS f32x4*)(LW + tt * 64 + c0) = x * (-0.6065306597126334f);
                        else { v2u w; w.x = pkh(x[0], x[1]); w.y = pkh(x[2], x[3]); *(LAS v2u*)(a16 + tt * 64 + c0) = w; } } }
            }
            __syncthreads();
            float lwv[8];
            { OPQ_TID(); float run = 0.f;
#pragma unroll
              for (int e = 0; e < 8; ++e) { lwv[e] = LW[(8 * cseg + e) * 64 + cch]; run += lwv[e]; }
              SEG[cseg * 64 + cch] = run; }
            __syncthreads();
            SREP(2) {
                OPQ_TID();
                float pre = 0.f, tot = 0.f;
#pragma unroll
                for (int s = 0; s < 8; ++s) { const float x = SEG[s * 64 + cch]; tot += x; pre += (s < cseg) ? x : 0.f; }
                const float gC = __expf(tot); float E = __expf(pre);
                if (cseg == 0) GC[cch] = gC;
                float nb[8], kc[8], vt[8];
#pragma unroll
                for (int e = 0; e < 8; ++e) { const int tt = 8 * cseg + e;
                    const float gprev = E; E *= __expf(lwv[e]); const float inv = frcp(E), e4 = gC * inv;
                    const float kkv = (float)kk16[tt * 64 + cch], rv = (float)r16[tt * 64 + cch], kv = (float)k16[tt * 64 + cch], vv = (float)v16[tt * 64 + cch], av = (float)a16[tt * 64 + cch];
                    const float kd = kv * (1.0f + (av - 1.0f) * kac), bb = kkv * av;
                    KKg[sw(tt, cch)] = (bf16)(pkbf(kkv * gprev, 0.f) & 0xffffu); Rg[sw(tt, cch)] = (bf16)(pkbf(rv * E, 0.f) & 0xffffu);
                    Bi[sw(tt, cch)] = (bf16)(pkbf(bb * inv, 0.f) & 0xffffu); Ki[sw(tt, cch)] = (bf16)(pkbf(kd * inv, 0.f) & 0xffffu);
                    nb[e] = -bb * e4; kc[e] = kd * e4; vt[e] = vv; }
                v4u o;
                o.x = pkbf(nb[0], nb[1]); o.y = pkbf(nb[2], nb[3]); o.z = pkbf(nb[4], nb[5]); o.w = pkbf(nb[6], nb[7]); *(LAS v4u*)(nBct + sw(cch, 8 * cseg)) = o;
                o.x = pkbf(kc[0], kc[1]); o.y = pkbf(kc[2], kc[3]); o.z = pkbf(kc[4], kc[5]); o.w = pkbf(kc[6], kc[7]); *(LAS v4u*)(Kct + sw(cch, 8 * cseg)) = o;
                o.x = pkbf(vt[0], vt[1]); o.y = pkbf(vt[2], vt[3]); o.z = pkbf(vt[4], vt[5]); o.w = pkbf(vt[6], vt[7]); *(LAS v4u*)(Vt + sw(cch, 8 * cseg)) = o;
            }
            __syncthreads();
            SREP(3) {
                OPQ_LANE();
                const int mtx = wave >> 1, sb = wave & 1;
                const LAS bf16* X = (mtx & 1) ? Ki : Bi; const LAS bf16* Yt = (mtx >> 1) ? Rg : KKg;
                LAS bf16* dst = mtx == 0 ? Aab : mtx == 1 ? Aak : mtx == 2 ? nArb : Ark;
                const bool incl = mtx >= 2; const float sgn = mtx == 2 ? -1.0f : 1.0f;
#pragma unroll
                for (int tb = 0; tb < 2; ++tb) {
                    f32x4 acc[2][2]; zero_blk(acc);
                    if (tb >= sb) mm_blk(acc, X, 32 * sb, Yt, 32 * tb, fr, fq);
#pragma unroll
                    for (int ti = 0; ti < 2; ++ti)
#pragma unroll
                        for (int tj = 0; tj < 2; ++tj) { const int t = 32 * tb + 16 * tj + fr, s0 = 32 * sb + 16 * ti + 4 * fq; f32x4 x = acc[ti][tj] * sgn;
                            if (tb == sb && ti >= tj) {
#pragma unroll
                                for (int e = 0; e < 4; ++e) { const bool keep = incl ? (s0 + e <= t) : (s0 + e < t); x[e] = keep ? x[e] : 0.f; } }
                            v2u w; w.x = pkbf(x[0], x[1]); w.y = pkbf(x[2], x[3]); *(LAS v2u*)(dst + sw(t, s0)) = w;
                            if (mtx == 0 && tb == sb && ti == tj) *(LAS f32x4*)(AD + (2 * tb + tj) * 256 + fr * 16 + 4 * fq) = x; }
                }
            }
            __syncthreads();
            f32x4 Yacc[2][2]; zero_blk(Yacc);
            SREP(4) if (wave < 3) {
                OPQ_LANE();
                float x[16];
#pragma unroll
                for (int r = 0; r < 16; ++r) x[r] = (r == fr) ? 1.0f : 0.0f;
#pragma unroll
                for (int r = 1; r < 16; ++r) { float s = 0.f;
#pragma unroll
                    for (int k4 = 0; k4 < (r + 3) / 4; ++k4) { const f32x4 nr = *(const LAS f32x4*)(AD + fq * 256 + r * 16 + 4 * k4);
#pragma unroll
                        for (int e = 0; e < 4; ++e) if (4 * k4 + e < r) s += nr[e] * x[4 * k4 + e]; }
                    x[r] = (r > fr) ? -s : x[r]; }
#pragma unroll
                for (int r = 0; r < 16; ++r) Minv[sw(16 * fq + r, 16 * fq + fr)] = (bf16)(pkbf(x[r], 0.f) & 0xffffu);
                { v4u o; o.x = pkbf(x[0], x[1]); o.y = pkbf(x[2], x[3]); o.z = pkbf(x[4], x[5]); o.w = pkbf(x[6], x[7]); *(LAS v4u*)(XT + fq * 256 + fr * 16) = o;
                  o.x = pkbf(x[8], x[9]); o.y = pkbf(x[10], x[11]); o.z = pkbf(x[12], x[13]); o.w = pkbf(x[14], x[15]); *(LAS v4u*)(XT + fq * 256 + fr * 16 + 8) = o; }
                const int j = wave;
                s16x4 xb[3];
                xb[0] = *(const LAS s16x4*)(XT + j * 256 + fr * 16 + 4 * fq);
                xb[1] = xb[0]; xb[2] = xb[0];
#pragma unroll
                for (int dl = 1; dl <= 3; ++dl) { if (j + dl <= 3) { const int i = j + dl;
                    f32x4 p = {0.f, 0.f, 0.f, 0.f};
#pragma unroll
                    for (int mm = 0; mm < dl; ++mm) { const s16x4 n = *(const LAS s16x4*)(Aab + sw(16 * i + fr, 16 * (j + mm) + 4 * fq));
                        p = __builtin_amdgcn_mfma_f32_16x16x16bf16_1k(n, xb[mm], p, 0, 0, 0); }
                    v2u pw; pw.x = pkbf(p[0], p[1]); pw.y = pkbf(p[2], p[3]);
                    const s16x4 xi = *(const LAS s16x4*)(Minv + sw(16 * i + fr, 16 * i + 4 * fq));
                    f32x4 z = {0.f, 0.f, 0.f, 0.f};
                    z = __builtin_amdgcn_mfma_f32_16x16x16bf16_1k(xi, __builtin_bit_cast(s16x4, pw), z, 0, 0, 0);
                    v2u zw; zw.x = pkbf(-z[0], -z[1]); zw.y = pkbf(-z[2], -z[3]);
                    if (dl < 3) xb[dl] = __builtin_bit_cast(s16x4, zw);
                    Minv[sw(16 * i + 4 * fq + 0, 16 * j + fr)] = (bf16)(zw.x & 0xffffu); Minv[sw(16 * i + 4 * fq + 1, 16 * j + fr)] = (bf16)(zw.x >> 16);
                    Minv[sw(16 * i + 4 * fq + 2, 16 * j + fr)] = (bf16)(zw.y & 0xffffu); Minv[sw(16 * i + 4 * fq + 3, 16 * j + fr)] = (bf16)(zw.y >> 16); } }
            }
            if (wave == 3) { OPQ_LANE();
#pragma unroll
                for (int bc = 1; bc < 4; ++bc)
                    for (int r = 0; r < 16 * bc; r += 4) *(LAS unsigned short*)(Minv + sw(r + fq, 16 * bc + fr)) = 0; }
            if (wave >= 4) {
                OPQ_LANE();
                f32x4 R[2][2]; zero_blk(R);
                mm_blk(R, Aak, 32 * bi, Vt, 32 * bj, fr, fq);
                mm_blk(R, KKg, 32 * bi, Sb, 32 * bj, fr, fq);
                st_blk_t(RHSt, R, 32 * bi, 32 * bj, fr, fq);
#pragma unroll
                for (int ti = 0; ti < 2; ++ti) { const f32x4 g = *(const LAS f32x4*)(GC + 32 * bi + 16 * ti + 4 * fq);
#pragma unroll
                    for (int tj = 0; tj < 2; ++tj) Tacc[ti][tj] *= g; }
                mm_blk(Tacc, Kct, 32 * bi, Vt, 32 * bj, fr, fq);
                mm_blk(Yacc, Sb, 32 * bi, Rg, 32 * bj, fr, fq);
                mm_blk(Yacc, Vt, 32 * bi, Ark, 32 * bj, fr, fq);
            }
            __syncthreads();
            SREP(6) if (wave >= 4) {
                OPQ_LANE();
                f32x4 Uc[2][2]; zero_blk(Uc);
                mm_blk(Uc, Minv, 32 * bi, RHSt, 32 * bj, fr, fq);
                st_blk_t(Ut, Uc, 32 * bi, 32 * bj, fr, fq);
            }
            __syncthreads();
            if (wave >= 4) {
                OPQ_LANE();
                mm_blk(Tacc, nBct, 32 * bi, Ut, 32 * bj, fr, fq);
                mm_blk(Yacc, Ut, 32 * bi, nArb, 32 * bj, fr, fq);
                st_blk_t(Sb, Tacc, 32 * bi, 32 * bj, fr, fq);
                st_blk_t(YB, Yacc, 32 * bi, 32 * bj, fr, fq);
            }
            __syncthreads();
            { OPQ_TID(); const int tau = CS * ch + ptt, t = d == 0 ? tau : L - 1 - tau;
              *(v4u*)(Y + (size_t)(m0 + t) * D + head * 64 + pc8) = *(const LAS v4u*)(YB + sw(ptt, pc8)); }
        }
        if (!isLat && wave >= 4) { OPQ_LANE(); float* so = F.out + (size_t)M * D + ((size_t)((b * 2 + d) * NH + head)) * 4096;
#pragma unroll
            for (int ti = 0; ti < 2; ++ti)
#pragma unroll
                for (int tj = 0; tj < 2; ++tj) *(f32x4*)(so + (32 * bj + 16 * tj + fr) * 64 + 32 * bi + 16 * ti + 4 * fq) = Tacc[ti][tj]; }
    }
#undef MB
#undef ZLOAD
#undef OPQ_LANE
#undef OPQ_TID
}
constexpr int MXS = 136;
__device__ __forceinline__ void p4_mix(Frame& F) {
    const float* const* in = F.in;
    const f16* Z = (const f16*)(F.ws + WS_Z);
    const bf16* Y0 = (const bf16*)F.out; const bf16* Y1 = Y0 + (size_t)M * D;
    bf16* MIX = (bf16*)(F.ws + WS_H);
    const bf16* poolWT = (const bf16*)(F.ws + WS_POOLW); const bf16* gw2T = (const bf16*)(F.ws + WS_GW2T);
    LAS bf16* SG = (LAS bf16*)(F.lds);
    LAS f32x4* ST = (LAS f32x4*)(F.lds + 17408);
    LAS f16* ZP = (LAS f16*)(F.lds + 17408 + 16384);
    LAS bf16* MX = (LAS bf16*)(F.lds + 17408 + 16384 + 20480);
    const int tid = F.tid, lane = F.lane, wave = F.wave;
    for (int tile = F.bid; tile < M / 64; tile += F.G) {
        const int m0t = tile * 64;
        const bool isCtx = m0t < M_CTX;
        const int ms = isCtx ? (m0t / L_CTX) * L_CTX : M_CTX + ((m0t - M_CTX) / L_LAT) * L_LAT, L = isCtx ? L_CTX : L_LAT;
        const int vlo = isCtx ? ms - m0t : 0, vhi = isCtx ? ms + L_CTX - m0t : 64;
        __syncthreads();
        { const int tt = tid >> 3, c16 = (tid & 7) * 16; const int m = m0t + tt, t = m - ms;
          const f16* zr = Z + (size_t)m * NZ; const f16* zp = t > 0 ? zr - NZ : zr; const f16* zn = t < L - 1 ? zr + NZ : zr;
          const float fp = t > 0 ? 0.5f : 0.f, fn = t < L - 1 ? 0.5f : 0.f;
          unsigned o[8];
#pragma unroll
          for (int q = 0; q < 4; ++q) { const f32x4 h = ld_h4(zr + ZC_LG_A + c16 + 4 * q) + ld_h4(zp + ZC_LG_B + c16 + 4 * q) * fp + ld_h4(zn + ZC_LG_B + c16 + 4 * q) * fn;
              o[2 * q] = pkbf(sigmoidf_(h.x), sigmoidf_(h.y)); o[2 * q + 1] = pkbf(sigmoidf_(h.z), sigmoidf_(h.w)); }
          *(LAS v4u*)(SG + tt * MXS + c16) = (v4u){o[0], o[1], o[2], o[3]}; *(LAS v4u*)(SG + tt * MXS + c16 + 8) = (v4u){o[4], o[5], o[6], o[7]}; }
#pragma unroll 1
        for (int it = 0; it < 8; ++it) { const int item = it * 512 + tid, pair = item >> 2, q = item & 3, tt = pair >> 4, head = pair & 15; const int m = m0t + tt, t = m - ms, c0 = head * 64 + q * 16;
            const f16* zr = Z + (size_t)m * NZ; const f16* zp = t > 0 ? zr - NZ : zr; const f16* zn = t < L - 1 ? zr + NZ : zr;
            const float fp = t > 0 ? 0.5f : 0.f, fn = t < L - 1 ? 0.5f : 0.f;
            float y[16]; float s1 = 0.f, rk = 0.f;
#pragma unroll
            for (int e = 0; e < 4; ++e) { const f32x4 a = ld_bf4(Y0 + (size_t)m * D + c0 + 4 * e) + ld_bf4(Y1 + (size_t)m * D + c0 + 4 * e);
                y[4 * e] = a.x; y[4 * e + 1] = a.y; y[4 * e + 2] = a.z; y[4 * e + 3] = a.w; s1 += (a.x + a.y) + (a.z + a.w);
                const int c = c0 + 4 * e;
                const f32x4 rz = ld_h4(zr + ZC_R + c), kz = ld_h4(zr + ZC_K + c);
                const f32x4 rs = ld_h4(zp + ZC_R + c) * fp + ld_h4(zn + ZC_R + c) * fn, ks = ld_h4(zp + ZC_K + c) * fp + ld_h4(zn + ZC_K + c) * fn;
                const f32x4 r4 = rz + (rs - rz) * *(const f32x4*)(in[10] + c), k4 = kz + (ks - kz) * *(const f32x4*)(in[10] + D + c), w4 = *(const f32x4*)(in[22] + c);
                rk += (r4.x * k4.x * w4.x + r4.y * k4.y * w4.y) + (r4.z * k4.z * w4.z + r4.w * k4.w * w4.w); }
            s1 += __shfl_xor(s1, 1); s1 += __shfl_xor(s1, 2); rk += __shfl_xor(rk, 1); rk += __shfl_xor(rk, 2);
            const float mean = s1 * (1.0f / 64.0f); float s2 = 0.f;
#pragma unroll
            for (int e = 0; e < 16; ++e) { const float dd = y[e] - mean; s2 += dd * dd; }
            s2 += __shfl_xor(s2, 1); s2 += __shfl_xor(s2, 2);
            if (q == 0) ST[tt * 16 + head] = (f32x4){mean, rsqrtf(s2 * (1.0f / 64.0f) + 64e-5f), rk, 0.f}; }
#pragma unroll 1
        for (int g = 0; g < 4; ++g) {
            __syncthreads();
            for (int idx = tid; idx < 80 * 16; idx += NWAVES * 64) { const int rr = idx >> 4, c8 = (idx & 15) * 8, tl = rr - 8;
                v4u val = {0u, 0u, 0u, 0u};
                if (tl >= vlo && tl < vhi) val = *(const v4u*)(Z + (size_t)(m0t + tl) * NZ + ZC_POOL + g * 128 + c8);
                *(LAS v4u*)(ZP + rr * 128 + c8) = val; }
            __syncthreads();
            { const int win = 2 << g;
              for (int it = 0; it < 2; ++it) { const int item = it * 512 + tid, tt = item >> 4, c8 = (item & 15) * 8;
                  int lo = tt - win / 2, hi = tt + win - win / 2; lo = lo < vlo ? vlo : lo; hi = hi > vhi ? vhi : hi;
                  float acc8[8];
#pragma unroll
                  for (int e = 0; e < 8; ++e) acc8[e] = 0.f;
                  for (int u = lo; u < hi; ++u) { const f16x8 zv = *(const LAS f16x8*)(ZP + (u + 8) * 128 + c8);
#pragma unroll
                      for (int e = 0; e < 8; ++e) acc8[e] += (float)zv[e]; }
                  const float inv = frcp((float)(hi - lo)); const f16x8 zc = *(const LAS f16x8*)(ZP + (tt + 8) * 128 + c8);
                  unsigned o[4];
#pragma unroll
                  for (int e = 0; e < 4; ++e) o[e] = pkbf(acc8[2 * e] * inv - (float)zc[2 * e], acc8[2 * e + 1] * inv - (float)zc[2 * e + 1]);
                  *(LAS v4u*)(MX + tt * MXS + c8) = (v4u){o[0], o[1], o[2], o[3]}; } }
            __syncthreads();
            const int ch0 = wave * 32;
            bf16x8 wP[4][2], wG[4][2];
#pragma unroll
            for (int ks = 0; ks < 4; ++ks)
#pragma unroll
                for (int ct = 0; ct < 2; ++ct) { const int chl = ch0 + ct * 16 + (lane & 15);
                    wP[ks][ct] = *(const bf16x8*)(poolWT + ((size_t)g * 256 + chl) * 128 + ks * 32 + 8 * (lane >> 4));
                    wG[ks][ct] = *(const bf16x8*)(gw2T + ((size_t)g * 256 + chl) * 128 + ks * 32 + 8 * (lane >> 4)); }
#pragma unroll 1
            for (int tk = 0; tk < 4; ++tk) {
                f32x4 aP[2], aG[2];
                aP[0] = aP[1] = aG[0] = aG[1] = (f32x4){0.f, 0.f, 0.f, 0.f};
                const int tt = tk * 16 + (lane & 15), m = m0t + tt, t = m - ms;
#pragma unroll
                for (int ks = 0; ks < 4; ++ks) {
                    const bf16x8 bm = *(const LAS bf16x8*)(MX + tt * MXS + ks * 32 + 8 * (lane >> 4));
                    const bf16x8 bg = *(const LAS bf16x8*)(SG + tt * MXS + ks * 32 + 8 * (lane >> 4));
#pragma unroll
                    for (int ct = 0; ct < 2; ++ct) { aP[ct] = __builtin_amdgcn_mfma_f32_16x16x32_bf16(wP[ks][ct], bm, aP[ct], 0, 0, 0);
                                                     aG[ct] = __builtin_amdgcn_mfma_f32_16x16x32_bf16(wG[ks][ct], bg, aG[ct], 0, 0, 0); }
                }
                const f16* zr = Z + (size_t)m * NZ; const f16* zp = t > 0 ? zr - NZ : zr; const f16* zn = t < L - 1 ? zr + NZ : zr;
                const float fp = t > 0 ? 0.5f : 0.f, fn = t < L - 1 ? 0.5f : 0.f;
#pragma unroll
                for (int ct = 0; ct < 2; ++ct) { const int c = g * 256 + ch0 + ct * 16 + 4 * (lane >> 4), head = c >> 6;
                    const f32x4 lw = *(const f32x4*)(in[23] + c), lb = *(const f32x4*)(in[24] + c), muv = *(const f32x4*)(in[10] + 2 * D + c), psc = *(const f32x4*)(in[26] + c);
                    const f32x4 st = ST[tt * 16 + head];
                    const f32x4 y = ld_bf4(Y0 + (size_t)m * D + c) + ld_bf4(Y1 + (size_t)m * D + c);
                    const f32x4 vz = ld_h4(zr + ZC_V + c), vs = ld_h4(zp + ZC_V + c) * fp + ld_h4(zn + ZC_V + c) * fn; const f32x4 v4 = vz + (vs - vz) * muv;
                    const f32x4 yn = (y - st.x) * st.y * lw + lb + v4 * st.z;
                    const f32x4 bo = yn * aG[ct], ao = aP[ct] * psc;
                    const f32x4 ga = ld_h4(zr + ZC_GA + c), gb = ld_h4(zr + ZC_GB + c);
                    const f32x4 mx = ga * ao + gb * bo;
                    v2u w; w.x = pkbf(mx.x, mx.y); w.y = pkbf(mx.z, mx.w); *(v2u*)(MIX + (size_t)m * D + c) = w; }
            }
        }
    }
}

__device__ __forceinline__ void p8_final(Frame& F) {
    const int gw = F.bid * NWAVES + F.wave, NGW = F.G * NWAVES;
    const float* rss = (const float*)(F.ws + WS_RSS2); const float* gf = F.in[30];
    for (int m = gw; m < M; m += NGW) { const float rstd = rsqrtf(rss[m] * (1.0f / D) + 1e-6f); float* row = F.out + (size_t)m * D;
#pragma unroll
        for (int j = 0; j < 4; ++j) { const int c = 4 * (F.lane + 64 * j); const f32x4 x = *(const f32x4*)(row + c), g = *(const f32x4*)(gf + c); *(f32x4*)(row + c) = x * rstd * g; } }
}

__global__ void __launch_bounds__(NWAVES * 64, 2) fwd(Args args) {
    extern __shared__ __attribute__((aligned(16))) unsigned char lds_raw[];
    Frame F;
    F.lds = (LAS unsigned char*)lds_raw;
    F.tid = threadIdx.x; F.lane = F.tid & 63; F.wave = __builtin_amdgcn_readfirstlane(F.tid >> 6);
    F.G = gridDim.x; F.bid = blockIdx.x;
    F.in = args.in; F.out = args.out; F.ws = args.ws;
    volatile LAS unsigned* MISC = (volatile LAS unsigned*)(F.lds + MISC_OFF);
    if (F.tid < 32) MISC[F.tid] = 0u;
    __syncthreads();
    const int lo = args.ph_lo, hi = args.ph_hi;
    unsigned* ctl = (unsigned*)(F.ws + WS_CTL);
    XcdBarrier bar; bar.bar = ctl + CW_BAR; bar.x = 0; bar.st = nullptr;
    if (hi - lo > 1) bar = xcd_barrier_post(ctl + CW_BAR, MISC + 8);
#ifndef PH_MASK
#define PH_MASK 0x1ff
#endif
#ifndef REPEAT_MASK
#define REPEAT_MASK 0
#endif
#define REP(k) (((REPEAT_MASK >> (k)) & 1) ? 2 : 1)
#define IN(k) (((PH_MASK >> (k)) & 1) && lo <= (k) && (k) < hi)
#define BOTH(k) (IN(k) && IN((k) + 1))
#define GRID_BAR() xcd_barrier(bar)
    bf16* H = (bf16*)(F.ws + WS_H);
    float* mod = (float*)(F.ws + WS_MOD);
    if (IN(0)) { for (int rep = 0; rep < REP(0); ++rep) p0_prologue(F); if (BOTH(0)) GRID_BAR(); }
    if (IN(1)) { for (int rep = 0; rep < REP(1); ++rep) p1_hprep(F); if (BOTH(1)) GRID_BAR(); }
    if (IN(2)) {
        pg8::Gemm g{H, (const bf16*)(F.ws + WS_WCAT), M, NZ, D}; pg8::StaticOrder S; S.init(M, NZ, F.G, F.bid);
        EpiZ E{(f16*)(F.ws + WS_Z)};
        for (int rep = 0; rep < REP(2); ++rep) pg8::gemm_phase<EpiZ, pg8::StaticOrder, true, true>(F.lds, g, S, E);
        if (BOTH(2)) GRID_BAR();
    }
    if (IN(3)) { for (int rep = 0; rep < REP(3); ++rep) p3_scan2(F); if (BOTH(3)) GRID_BAR(); }
    if (IN(4)) { for (int rep = 0; rep < REP(4); ++rep) p4_mix(F); if (BOTH(4)) GRID_BAR(); }
    if (IN(5)) {
        pg8::Gemm g{H, (const bf16*)(F.ws + WS_WOUT), M, D, D}; pg8::StaticOrder S; S.init(M, D, F.G, F.bid);
        EpiOut1 E{args.in[0], args.in[1], F.out, (bf16*)(F.ws + WS_A2), mod, args.in[8], (float*)(F.ws + WS_RSS1)};
        pg8::gemm_phase<EpiOut1, pg8::StaticOrder, true, true>(F.lds, g, S, E);
        if (BOTH(5)) GRID_BAR();
    }
    if (IN(6)) {
        pg8::Gemm g{(const bf16*)(F.ws + WS_A2), (const bf16*)(F.ws + WS_WFF1), M, FF, D}; pg8::StaticOrder S; S.init(M, FF, F.G, F.bid);
        EpiFF1 E{(const float*)(F.ws + WS_RSS1), (const float*)(F.ws + WS_C1), (bf16*)(F.ws + WS_ACT)};
        for (int rep = 0; rep < REP(6); ++rep) pg8::gemm_phase<EpiFF1, pg8::StaticOrder, true, true>(F.lds, g, S, E);
        if (BOTH(6)) GRID_BAR();
    }
    if (IN(7)) {
        pg8::Gemm g{(const bf16*)(F.ws + WS_ACT), (const bf16*)(F.ws + WS_WFF2), M, D, FF}; pg8::StaticOrder S; S.init(M, D, F.G, F.bid);
        EpiOut2 E{F.out, mod, (float*)(F.ws + WS_RSS2)};
        pg8::gemm_phase<EpiOut2, pg8::StaticOrder, true, true>(F.lds, g, S, E);
        if (BOTH(7)) GRID_BAR();
    }
    if (IN(8)) { p8_final(F); }
#undef IN
#undef BOTH
#undef GRID_BAR
}

extern "C" void kernel_launch(void* const* d_in, const int* in_sizes, int n_in, void* d_out, int out_size, void* d_ws, size_t ws_size, hipStream_t stream) {
    static int grid = 0;
    if (grid == 0) {
        if (n_in != 31 || ws_size < WS_END) { fprintf(stderr, "kernel_launch: expected 31 inputs and >= %zu bytes of workspace; got %d, %zu\n", (size_t)WS_END, n_in, ws_size); grid = -1; return; }
        int dev = 0, cus = 0, per_cu = 0;
        if (hipGetDevice(&dev) != hipSuccess || hipDeviceGetAttribute(&cus, hipDeviceAttributeMultiprocessorCount, dev) != hipSuccess) { grid = -1; return; }
        if (hipFuncSetAttribute((const void*)fwd, hipFuncAttributeMaxDynamicSharedMemorySize, LDS_BYTES) != hipSuccess) { fprintf(stderr, "kernel_launch: hipFuncSetAttribute failed\n"); grid = -1; return; }
        if (hipOccupancyMaxActiveBlocksPerMultiprocessor(&per_cu, (const void*)fwd, NWAVES * 64, LDS_BYTES) != hipSuccess || per_cu < 1) { fprintf(stderr, "kernel_launch: occupancy query says %d workgroups per CU\n", per_cu); (void)hipGetLastError(); grid = -1; return; }
        grid = cus;
    }
    if (grid < 0) return;
    if (hipMemsetAsync((char*)d_ws + WS_CTL, 0, CTL_ZERO_BYTES, stream) != hipSuccess) return;
    Args a{};
    for (int i = 0; i < 31; ++i) a.in[i] = (const float*)d_in[i];
    a.out = (float*)d_out; a.ws = (unsigned char*)d_ws;
    if (MK_N_LAUNCHES == 1) {
        a.ph_lo = 0; a.ph_hi = NPHASE;
        void* kargs[] = {&a};
        hipError_t e = hipLaunchCooperativeKernel((const void*)fwd, dim3(grid), dim3(NWAVES * 64), kargs, LDS_BYTES, stream);
        if (e != hipSuccess) fprintf(stderr, "kernel_launch: cooperative launch failed: %s (grid %d)\n", hipGetErrorString(e), grid);
    } else {
        for (int p = 0; p < NPHASE; ++p) { a.ph_lo = p; a.ph_hi = p + 1; hipLaunchKernelGGL(fwd, dim3(grid), dim3(NWAVES * 64), LDS_BYTES, stream, a); }
    }
}
```

```cpp
#include <hip/hip_runtime.h>
#include <cstdio>
#include <cstdint>
namespace pg8 {
#define PG8_LAS __attribute__((address_space(3)))
typedef unsigned short bf16_t;
typedef short bf16x8 __attribute__((ext_vector_type(8)));
typedef float f32x4 __attribute__((ext_vector_type(4)));
typedef unsigned u32x4 __attribute__((ext_vector_type(4)));
constexpr int BM = 256, BK = 64, HALF = 128, HTB = HALF * BK * 2  , STAGE_BYTES = 8 * HTB, NXCD = 8, WGM = 8;

__host__ __device__ __forceinline__ int lds_byte(int r, int c) { const int st = (r >> 4) * 2 + (c >> 5), rr = r & 15, cc = c & 31, ob = rr * 64 + cc * 2; return st * 1024 + (ob ^ (((ob >> 9) & 1) << 5)); }
__host__ __device__ __forceinline__ void stage_rc(int b, int& R, int& C) { const int st = b / 1024, sb = b % 1024, swz = sb ^ (((sb >> 9) & 1) << 5); R = (st >> 1) * 16 + swz / 64; C = (st & 1) * 32 + (swz % 64) / 2; }
__host__ __device__ __forceinline__ int perm32(int rho) { const int n = rho >> 4, i = rho & 15; return 8 * (i >> 2) + 4 * n + (i & 3); }

struct Unit { int pm, pn; };
struct Gemm { const bf16_t* A; const bf16_t* Bt; int M, N, K; };

struct StaticOrder {
    int nM, nN, nwg, G, c;
    __host__ __device__ void init(int M, int N, int G_, int c_) { nM = M / BM; nN = N / BM; nwg = nM * nN; G = G_; c = c_; }
    __host__ __device__ bool next(int i, Unit& u) const {
        const long L = (long)i * G + c; if (L >= nwg) return false;
        int wgid = (int)L; { const int q = nwg / NXCD, r = nwg % NXCD, xcd = wgid % NXCD, off = wgid / NXCD; wgid = (xcd < r ? xcd * (q + 1) : r * (q + 1) + (xcd - r) * q) + off; }
        const int nig = WGM * nN, gid = wgid / nig, fm = gid * WGM, gsz = (nM - fm) < WGM ? (nM - fm) : WGM;
        u.pm = fm + ((wgid % nig) % gsz); u.pn = (wgid % nig) / gsz; return true;
    }
    __device__ __forceinline__ void a_ready(const Unit&) const {}
    __device__ __forceinline__ void done(const Unit&) const {}
};

__device__ __forceinline__ unsigned cvt_pk_bf16(float lo, float hi) { unsigned r; asm volatile("v_cvt_pk_bf16_f32 %0, %1, %2" : "=v"(r) : "v"(lo), "v"(hi)); return r; }
typedef float f32x2 __attribute__((ext_vector_type(2)));
template <class Epi, class Sched, bool ALIGN_EPI = false, bool SP2 = false>
__device__ __forceinline__ void gemm_phase(PG8_LAS unsigned char* lds, const Gemm g, const Sched& S, const Epi& E) {
    const int tid = threadIdx.x, wid = __builtin_amdgcn_readfirstlane(tid >> 6), lane = tid & 63, wr = wid >> 2, wc = wid & 3, fr = lane & 15, fq = lane >> 4;
    const int K = g.K, nt = K / BK;
    unsigned voffA[2], voffB[2];
#pragma unroll
    for (int i = 0; i < 2; ++i) { int R, C; stage_rc(tid * 16 + i * 8192, R, C); const int Rb = Epi::PERM ? ((R & ~31) + perm32(R & 31)) : R;
        voffA[i] = (unsigned)(R * K + C) * 2u; voffB[i] = (unsigned)(Rb * K + C) * 2u; }
    const size_t kstep = (size_t)(BK * 2);
    const size_t hstep = (size_t)HALF * K * 2;
    const size_t tstep = 2 * hstep;
    const unsigned ldsw = (unsigned)wid * 1024u;
    const int aoff = lds_byte(wr * 64 + fr, fq * 8), boff = lds_byte(wc * 32 + fr, fq * 8);
#define PG8_SA(b, h) (((b) * 2 + (h)) * HTB)
#define PG8_SB(b, h) ((4 + (b) * 2 + (h)) * HTB)
#define PG8_STAGE(bufoff, gbase, voff) do { _Pragma("unroll") for (int _i = 0; _i < 2; ++_i) \
        __builtin_amdgcn_global_load_lds((const unsigned*)((const char*)(gbase) + (voff)[_i]), (PG8_LAS unsigned*)(lds + (bufoff) + ldsw + _i * 8192), 16, 0, 0); } while (0)
#define PG8_LDA(dst, b, h) do { _Pragma("unroll") for (int m = 0; m < 4; ++m) _Pragma("unroll") for (int k = 0; k < 2; ++k) dst[m][k] = *(const PG8_LAS bf16x8*)(lds + PG8_SA(b, h) + aoff + m * 2048 + k * 1024); } while (0)
#define PG8_LDB(dst, b, h) do { _Pragma("unroll") for (int n = 0; n < 2; ++n) _Pragma("unroll") for (int k = 0; k < 2; ++k) dst[n][k] = *(const PG8_LAS bf16x8*)(lds + PG8_SB(b, h) + boff + n * 2048 + k * 1024); } while (0)
#define PG8_MMA(ai, bj, At, Bt) do { __builtin_amdgcn_s_setprio(1); _Pragma("unroll") for (int m = 0; m < 4; ++m) _Pragma("unroll") for (int n = 0; n < 2; ++n) _Pragma("unroll") for (int k = 0; k < 2; ++k) \
        acc[ai][bj][m][n] = __builtin_amdgcn_mfma_f32_16x16x32_bf16(Bt[n][k], At[m][k], acc[ai][bj][m][n], 0, 0, 0); __builtin_amdgcn_s_setprio(0); } while (0)
#define PG8_WAIT_V(n) asm volatile("s_waitcnt vmcnt(" #n ")" ::: "memory")
#define PG8_WAIT_L(n) asm volatile("s_waitcnt lgkmcnt(" #n ")" ::: "memory")
#define PG8_BAR __builtin_amdgcn_s_barrier()
#define PG8_SCHED __builtin_amdgcn_sched_barrier(0)
    Unit cur, nxt; int ui = 0;
    if (!S.next(0, cur)) return;
    f32x4 acc[2][2][4][2];
#pragma unroll
    for (int a = 0; a < 2; ++a)
#pragma unroll
        for (int b = 0; b < 2; ++b)
#pragma unroll
            for (int m = 0; m < 4; ++m)
#pragma unroll
                for (int n = 0; n < 2; ++n) acc[a][b][m][n] = (f32x4){0.f, 0.f, 0.f, 0.f};
    bf16x8 At[4][2], B0[2][2], B1[2][2];
    const char* cA = (const char*)g.A + (size_t)cur.pm * tstep; const char* cB = (const char*)g.Bt + (size_t)cur.pn * tstep;
    S.a_ready(cur);
    if constexpr (SP2) {
        PG8_STAGE(PG8_SB(0, 0), cB, voffB); PG8_STAGE(PG8_SB(0, 1), cB + hstep, voffB); PG8_STAGE(PG8_SA(0, 0), cA, voffA); PG8_STAGE(PG8_SA(0, 1), cA + hstep, voffA);
        if (wr == 1) PG8_BAR;
        PG8_WAIT_V(2); PG8_BAR;
        PG8_STAGE(PG8_SB(1, 0), cB + kstep, voffB); PG8_STAGE(PG8_SA(1, 0), cA + kstep, voffA); PG8_STAGE(PG8_SB(1, 1), cB + hstep + kstep, voffB);
        PG8_WAIT_V(6); PG8_BAR;
    } else {
        PG8_STAGE(PG8_SB(0, 0), cB, voffB); PG8_STAGE(PG8_SA(0, 0), cA, voffA); PG8_STAGE(PG8_SB(0, 1), cB + hstep, voffB); PG8_STAGE(PG8_SA(0, 1), cA + hstep, voffA);
        if (wr == 1) PG8_BAR;
        PG8_WAIT_V(4); PG8_BAR;
        PG8_STAGE(PG8_SB(1, 0), cB + kstep, voffB); PG8_STAGE(PG8_SA(1, 0), cA + kstep, voffA); PG8_STAGE(PG8_SB(1, 1), cB + hstep + kstep, voffB);
        PG8_WAIT_V(6); PG8_BAR;
    }
    for (;;) {
        const bool has_next = S.next(ui + 1, nxt);
        const char* nA = has_next ? (const char*)g.A + (size_t)nxt.pm * tstep : cA; const char* nB = has_next ? (const char*)g.Bt + (size_t)nxt.pn * tstep : cB;
        for (int t = 0; t < nt; t += 2) {
            const bool last = (t == nt - 2);
            const char* a1 = cA + (size_t)(t + 1) * kstep;
            const char* a2 = last ? nA : cA + (size_t)(t + 2) * kstep; const char* b2 = last ? nB : cB + (size_t)(t + 2) * kstep;
            const char* a3 = a2 + kstep; const char* b3 = b2 + kstep;
            if (last && has_next) S.a_ready(nxt);
            if constexpr (SP2) {
            PG8_LDB(B0, 0, 0); PG8_LDB(B1, 0, 1); PG8_SCHED; PG8_LDA(At, 0, 0); PG8_STAGE(PG8_SA(1, 1), a1 + hstep, voffA);
            PG8_WAIT_V(8); PG8_WAIT_L(0); PG8_BAR; PG8_MMA(0, 0, At, B0); PG8_MMA(0, 1, At, B1); PG8_BAR; PG8_SCHED;
            PG8_LDA(At, 0, 1); PG8_STAGE(PG8_SB(0, 0), b2, voffB); PG8_STAGE(PG8_SB(0, 1), b2 + hstep, voffB); PG8_STAGE(PG8_SA(0, 0), a2, voffA);
            PG8_WAIT_V(8); PG8_WAIT_L(0); PG8_BAR; PG8_MMA(1, 0, At, B0); PG8_MMA(1, 1, At, B1); PG8_BAR; PG8_SCHED;
            PG8_LDB(B0, 1, 0); PG8_LDB(B1, 1, 1); PG8_SCHED; PG8_LDA(At, 1, 0); PG8_STAGE(PG8_SA(0, 1), a2 + hstep, voffA);
            PG8_WAIT_V(8); PG8_WAIT_L(0); PG8_BAR; PG8_MMA(0, 0, At, B0); PG8_MMA(0, 1, At, B1); PG8_BAR; PG8_SCHED;
            PG8_LDA(At, 1, 1); PG8_STAGE(PG8_SB(1, 0), b3, voffB); PG8_STAGE(PG8_SB(1, 1), b3 + hstep, voffB); PG8_STAGE(PG8_SA(1, 0), a3, voffA);
            PG8_WAIT_V(8); PG8_WAIT_L(0); PG8_BAR; PG8_MMA(1, 0, At, B0); PG8_MMA(1, 1, At, B1); PG8_BAR; PG8_SCHED;
            } else {
            PG8_LDB(B0, 0, 0); PG8_SCHED; PG8_LDA(At, 0, 0); PG8_STAGE(PG8_SA(1, 1), a1 + hstep, voffA);
            PG8_WAIT_L(8); PG8_BAR; PG8_WAIT_L(0); PG8_MMA(0, 0, At, B0); PG8_BAR; PG8_SCHED;
            PG8_LDB(B1, 0, 1); PG8_STAGE(PG8_SB(0, 0), b2, voffB);
            PG8_BAR; PG8_WAIT_L(0); PG8_MMA(0, 1, At, B1); PG8_BAR;
            PG8_LDA(At, 0, 1); PG8_STAGE(PG8_SA(0, 0), a2, voffA);
            PG8_BAR; PG8_WAIT_L(0); PG8_MMA(1, 0, At, B0); PG8_BAR; PG8_SCHED;
            PG8_STAGE(PG8_SB(0, 1), b2 + hstep, voffB);
            PG8_WAIT_V(6); PG8_BAR; PG8_MMA(1, 1, At, B1); PG8_BAR;
            PG8_LDB(B0, 1, 0); PG8_SCHED; PG8_LDA(At, 1, 0); PG8_STAGE(PG8_SA(0, 1), a2 + hstep, voffA);
            PG8_WAIT_L(8); PG8_BAR; PG8_WAIT_L(0); PG8_MMA(0, 0, At, B0); PG8_BAR; PG8_SCHED;
            PG8_LDB(B1, 1, 1); PG8_STAGE(PG8_SB(1, 0), b3, voffB);
            PG8_BAR; PG8_WAIT_L(0); PG8_MMA(0, 1, At, B1); PG8_BAR;
            PG8_LDA(At, 1, 1); PG8_STAGE(PG8_SA(1, 0), a3, voffA);
            PG8_BAR; PG8_WAIT_L(0); PG8_MMA(1, 0, At, B0); PG8_BAR; PG8_SCHED;
            PG8_STAGE(PG8_SB(1, 1), b3 + hstep, voffB);
            PG8_WAIT_V(6); PG8_BAR; PG8_MMA(1, 1, At, B1); PG8_BAR;
            }
        }
        if constexpr (ALIGN_EPI) { if (wr == 0) PG8_BAR; }
        if constexpr (!Epi::AFTER_DRAIN) { E(acc, cur, wr, wc, fr, fq); S.done(cur); }
        if (!has_next) break;
#pragma unroll
        for (int a = 0; a < 2; ++a)
#pragma unroll
            for (int b = 0; b < 2; ++b)
#pragma unroll
                for (int m = 0; m < 4; ++m)
#pragma unroll
                    for (int n = 0; n < 2; ++n) acc[a][b][m][n] = (f32x4){0.f, 0.f, 0.f, 0.f};
        cur = nxt; cA = nA; cB = nB; ++ui;
        if constexpr (ALIGN_EPI) { if (wr == 1) PG8_BAR; }
    }
    PG8_WAIT_V(0);
    if constexpr (!ALIGN_EPI) { if (wr == 0) PG8_BAR; }
    PG8_BAR;
    if constexpr (Epi::AFTER_DRAIN) { E.fused(acc, cur, wr, wc, fr, fq, lds, wid, lane); S.done(cur); }
#undef PG8_SA
#undef PG8_SB
#undef PG8_STAGE
#undef PG8_LDA
#undef PG8_LDB
#undef PG8_MMA
#undef PG8_WAIT_V
#undef PG8_WAIT_L
#undef PG8_BAR
#undef PG8_SCHED
}
}

#ifndef MK_N_LAUNCHES
#define MK_N_LAUNCHES 1
#endif
constexpr int NWAVES = 8;
constexpr int D = 1024, NH = 16, HD = 64, FF = 4096;
constexpr int M_CTX = 16 * 256, M_LAT = 4 * 2048, M = M_CTX + M_LAT;
constexpr int L_CTX = 256, L_LAT = 2048;
constexpr int NMOD = 6 * D;
constexpr int ZC_POOL = 0, ZC_R = 512, ZC_K = 1536, ZC_V = 2560, ZC_GA = 3584, ZC_GB = 4608;
constexpr int ZC_LW_A = 5632, ZC_LW_B = 5760, ZC_LA_A = 5888, ZC_LA_B = 6016, ZC_LG_A = 6144, ZC_LG_B = 6272, NZ = 6400;
constexpr int NPHASE = 9;

constexpr size_t MiB = 1u << 20;
constexpr size_t WS_CTL = 0, CTL_ZERO_BYTES = 1 * MiB;
constexpr int CW_BAR = 4096;
constexpr size_t WS_RSS1 = 256 * 1024, WS_RSS2 = 320 * 1024;
constexpr size_t WS_MOD = 1 * MiB, WS_C1 = 1 * MiB + 128 * 1024;
constexpr size_t WS_WCAT = 2 * MiB, WS_WOUT = 15 * MiB, WS_WFF1 = 17 * MiB, WS_WFF2 = 25 * MiB;
constexpr size_t WS_POOLW = 33 * MiB, WS_GW2T = 33 * MiB + 256 * 1024;
constexpr size_t WS_H = 34 * MiB;
constexpr size_t WS_Z = 58 * MiB;
constexpr size_t WS_ACT = 58 * MiB;
constexpr size_t WS_A2 = 154 * MiB;
constexpr size_t WS_END = 256 * MiB;
static_assert(WS_WCAT + (size_t)NZ * D * 2 <= WS_WOUT && WS_Z + (size_t)M * NZ * 2 <= WS_END && WS_ACT + (size_t)M * FF * 2 <= WS_A2 && WS_A2 + (size_t)M * D * 2 <= WS_END, "ws map");

constexpr int LDS_BYTES = 147456;
constexpr int RING_BYTES = 131072, MISC_OFF = 147200;

#define GAS __attribute__((address_space(1)))
#define LAS __attribute__((address_space(3)))
typedef unsigned short bf16;
typedef _Float16 f16;
typedef unsigned v4u __attribute__((ext_vector_type(4)));
typedef unsigned v2u __attribute__((ext_vector_type(2)));
typedef float f32x4 __attribute__((ext_vector_type(4)));
typedef float f32x2 __attribute__((ext_vector_type(2)));
typedef short bf16x8 __attribute__((ext_vector_type(8)));
typedef _Float16 f16x4 __attribute__((ext_vector_type(4)));
typedef _Float16 f16x8 __attribute__((ext_vector_type(8)));
typedef _Float16 f16x2 __attribute__((ext_vector_type(2)));
typedef GAS unsigned gu32;
#define RLX_AGENT __ATOMIC_RELAXED, __HIP_MEMORY_SCOPE_AGENT
#define LDS_WAIT() asm volatile("s_waitcnt lgkmcnt(0)" ::: "memory")
#define VM_WAIT() asm volatile("s_waitcnt vmcnt(0)" ::: "memory")

typedef __bf16 bf16x2_t __attribute__((ext_vector_type(2)));
__device__ __forceinline__ unsigned pkbf(float lo, float hi) { f32x2 v = {lo, hi}; bf16x2_t b = __builtin_convertvector(v, bf16x2_t); return __builtin_bit_cast(unsigned, b); }
__device__ __forceinline__ unsigned pkh(float lo, float hi) { f16x2 v = {(f16)lo, (f16)hi}; return __builtin_bit_cast(unsigned, v); }
__device__ __forceinline__ float bf2f(unsigned short b) { return __builtin_bit_cast(float, (unsigned)b << 16); }
__device__ __forceinline__ f32x4 ld_h4(const f16* p) { const f16x4 v = *(const f16x4*)p; return __builtin_convertvector(v, f32x4); }
__device__ __forceinline__ f32x4 ld_bf4(const bf16* p) { const v2u v = *(const v2u*)p; f32x4 r; r.x = __builtin_bit_cast(float, v.x << 16); r.y = __builtin_bit_cast(float, v.x & 0xffff0000u);
    r.z = __builtin_bit_cast(float, v.y << 16); r.w = __builtin_bit_cast(float, v.y & 0xffff0000u); return r; }
__device__ __forceinline__ float frcp(float x) { return __builtin_amdgcn_rcpf(x); }
__device__ __forceinline__ float sigmoidf_(float x) { return frcp(1.0f + __expf(-x)); }
__device__ __forceinline__ float wave_sum(float v) {
#pragma unroll
    for (int o = 1; o < 64; o <<= 1) v += __shfl_xor(v, o);
    return v;
}
__device__ __forceinline__ int cvec_of_row(int m) { return m < M_CTX ? 0 : 1 + (m - M_CTX) / L_LAT; }

#define XB_TMO      128
#define XB_XCNT(j)  (256  + 64 * (j))
#define XB_XSUB(j)  (1280 + 64 * (j))
#define XB_XGEN(j)  (2304 + 64 * (j))
#define XB_TOP      3328
#define XB_TOPGEN   3392
#define XCD_BAR_WORDS 3456
#define XB_SPIN_CAP (1u << 18)
__device__ __forceinline__ unsigned xb_ld(unsigned* p)              { return __hip_atomic_load(p, __ATOMIC_RELAXED, __HIP_MEMORY_SCOPE_AGENT); }
__device__ __forceinline__ unsigned xb_add(unsigned* p, unsigned v) { return __hip_atomic_fetch_add(p, v, __ATOMIC_RELAXED, __HIP_MEMORY_SCOPE_AGENT); }
__device__ __forceinline__ unsigned xb_xcc_id() { return (unsigned)__builtin_amdgcn_s_getreg((3 << 11) | 20) & 0xFu; }
#define XB_SPIN(cond, bar) do { unsigned _sp = 0; while (cond) { __builtin_amdgcn_s_sleep(1); \
    if ((++_sp & 255u) == 0u) { if (xb_ld(&(bar)[XB_TMO])) break; if (_sp > XB_SPIN_CAP) { atomicAdd(&(bar)[XB_TMO], 1u); break; } } } } while (0)
struct XcdBarrier { unsigned* bar; unsigned x; volatile LAS unsigned* st; };
__device__ __forceinline__ XcdBarrier xcd_barrier_post(unsigned* bar, volatile LAS unsigned* st) {
    XcdBarrier b; b.bar = bar; b.x = xb_xcc_id(); b.st = st;
    if (threadIdx.x == 0) (void)xb_add(&bar[XB_XCNT(b.x)], 1u);
    return b;
}
__device__ __forceinline__ void xcd_barrier_complete(unsigned* bar, unsigned x, unsigned& nloc, unsigned& nx) {
    const unsigned G = gridDim.x * gridDim.y * gridDim.z;
    unsigned sum, cnt, mine, sp = 0u;
    for (;;) {
        sum = 0u; cnt = 0u; mine = 0u;
#pragma unroll
        for (unsigned j = 0; j < 16; ++j) { const unsigned c = xb_ld(&bar[XB_XCNT(j)]); sum += c; cnt += (c > 0u) ? 1u : 0u; mine = (j == x) ? c : mine; }
        if (sum == G) break;
        __builtin_amdgcn_s_sleep(1);
        if ((++sp & 255u) == 0u) { if (xb_ld(&bar[XB_TMO])) break; if (sp > XB_SPIN_CAP) { atomicAdd(&bar[XB_TMO], 1u); break; } }
    }
    nloc = mine > 0u ? mine : 1u; nx = cnt > 0u ? cnt : 1u;
}
__device__ __forceinline__ void xcd_barrier(const XcdBarrier& b) {
    asm volatile("s_waitcnt vmcnt(0)" ::: "memory");
    __syncthreads();
    if (threadIdx.x == 0) {
        unsigned* bar = b.bar;
        __builtin_amdgcn_s_waitcnt(0);
        unsigned nloc = b.st[0], nx = b.st[1];
        if (nloc == 0u) { xcd_barrier_complete(bar, b.x, nloc, nx); b.st[0] = nloc; b.st[1] = nx; }
        const unsigned old = xb_add(&bar[XB_XSUB(b.x)], 1u);
        const unsigned gen = old / nloc;
        if (old + 1u == (gen + 1u) * nloc) {
            __builtin_amdgcn_fence(__ATOMIC_RELEASE, "agent");
            asm volatile("s_waitcnt vmcnt(0)" ::: "memory");
            const unsigned og = xb_add(&bar[XB_TOP], 1u);
            const unsigned tg = og / nx;
            if (og + 1u == (tg + 1u) * nx) xb_add(&bar[XB_TOPGEN], 1u);
            else XB_SPIN(xb_ld(&bar[XB_TOPGEN]) == tg, bar);
            __builtin_amdgcn_fence(__ATOMIC_ACQUIRE, "agent");
            xb_add(&bar[XB_XGEN(b.x)], 1u);
            asm volatile("s_waitcnt vmcnt(0)" ::: "memory");
        } else {
            XB_SPIN(xb_ld(&bar[XB_XGEN(b.x)]) == gen, bar);
            __builtin_amdgcn_fence(__ATOMIC_ACQUIRE, "agent");
            asm volatile("s_waitcnt vmcnt(0)" ::: "memory");
        }
    }
    __syncthreads();
}

struct EpiZ {
    static constexpr bool PERM = true, AFTER_DRAIN = false;
    f16* Z;
    __device__ __forceinline__ void operator()(const f32x4 (&acc)[2][2][4][2], const pg8::Unit& u, int wr, int wc, int fr, int fq) const {
        const int row0 = u.pm * 256 + wr * 64 + fr, col0 = u.pn * 256 + wc * 32 + 8 * fq;
        const bool sig = (u.pn >= ZC_GA / 256) && (u.pn < ZC_LW_A / 256);
#pragma unroll
        for (int ai = 0; ai < 2; ++ai)
#pragma unroll
            for (int m = 0; m < 4; ++m) { f16* rowp = Z + (size_t)(row0 + ai * 128 + m * 16) * NZ + col0;
#pragma unroll
                for (int bj = 0; bj < 2; ++bj) { f32x4 v0 = acc[ai][bj][m][0], v1 = acc[ai][bj][m][1];
                    if (sig) {
#pragma unroll
                        for (int e = 0; e < 4; ++e) { v0[e] = sigmoidf_(v0[e]); v1[e] = sigmoidf_(v1[e]); } }
                    v4u w; w.x = pkh(v0[0], v0[1]); w.y = pkh(v0[2], v0[3]); w.z = pkh(v1[0], v1[1]); w.w = pkh(v1[2], v1[3]);
                    *(v4u*)(rowp + bj * 128) = w; } }
    }
};
struct EpiOut1 {
    static constexpr bool PERM = false, AFTER_DRAIN = false;
    const float* xp; const float* xs; float* X1; bf16* A2; const float* mod; const float* g2; float* rowss;
    __device__ __forceinline__ void operator()(const f32x4 (&acc)[2][2][4][2], const pg8::Unit& u, int wr, int wc, int fr, int fq) const {
        const int ci = cvec_of_row(u.pm * 256);
        const float* xb = (u.pm < M_CTX / 256) ? xp + (size_t)u.pm * 256 * D : xs + (size_t)(u.pm - M_CTX / 256) * 256 * D;
        const int col0 = u.pn * 256 + wc * 32 + 4 * fq;
#pragma unroll
        for (int ai = 0; ai < 2; ++ai)
#pragma unroll
            for (int m = 0; m < 4; ++m) { const int rl = ai * 128 + wr * 64 + m * 16 + fr; const size_t r = (size_t)u.pm * 256 + rl; float ss = 0.f;
#pragma unroll
                for (int bj = 0; bj < 2; ++bj)
#pragma unroll
                    for (int n = 0; n < 2; ++n) { const int c = col0 + bj * 128 + n * 16;
                        const f32x4 ga = *(const f32x4*)(mod + ci * NMOD + 2 * D + c);
                        const f32x4 gm = *(const f32x4*)(g2 + c) * (*(const f32x4*)(mod + ci * NMOD + 4 * D + c) + 1.0f);
                        const f32x4 x = *(const f32x4*)(xb + (size_t)rl * D + c); const f32x4 x1 = x + ga * acc[ai][bj][m][n];
                        *(f32x4*)(X1 + r * D + c) = x1; ss += (x1[0] * x1[0] + x1[1] * x1[1]) + (x1[2] * x1[2] + x1[3] * x1[3]);
                        const f32x4 a = x1 * gm; v2u w; w.x = pkbf(a[0], a[1]); w.y = pkbf(a[2], a[3]); *(v2u*)(A2 + r * D + c) = w; }
                asm volatile("" ::: "memory");
                ss += __shfl_xor(ss, 16); ss += __shfl_xor(ss, 32);
                if (fq == 0) atomicAdd(rowss + r, ss); }
    }
};
struct EpiFF1 {
    static constexpr bool PERM = true, AFTER_DRAIN = false;
    const float* rowss; const float* c1; bf16* ACT;
    __device__ __forceinline__ void operator()(const f32x4 (&acc)[2][2][4][2], const pg8::Unit& u, int wr, int wc, int fr, int fq) const {
        const int ci = cvec_of_row(u.pm * 256);
        const int row0 = u.pm * 256 + wr * 64 + fr, col0 = u.pn * 256 + wc * 32 + 8 * fq;
        f32x4 cb[2][2];
#pragma unroll
        for (int bj = 0; bj < 2; ++bj)
#pragma unroll
            for (int n = 0; n < 2; ++n) cb[bj][n] = *(const f32x4*)(c1 + ci * FF + col0 + bj * 128 + 4 * n);
#pragma unroll
        for (int ai = 0; ai < 2; ++ai)
#pragma unroll
            for (int m = 0; m < 4; ++m) { const int r = row0 + ai * 128 + m * 16; const float rstd = rsqrtf(rowss[r] * (1.0f / D) + 1e-6f);
                bf16* rowp = ACT + (size_t)r * FF + col0;
#pragma unroll
                for (int bj = 0; bj < 2; ++bj) { f32x4 v0 = acc[ai][bj][m][0] * rstd + cb[bj][0], v1 = acc[ai][bj][m][1] * rstd + cb[bj][1];
#pragma unroll
                    for (int e = 0; e < 4; ++e) { const float a = fmaxf(v0[e], 0.f), b = fmaxf(v1[e], 0.f); v0[e] = a * a; v1[e] = b * b; }
                    v4u w; w.x = pkbf(v0[0], v0[1]); w.y = pkbf(v0[2], v0[3]); w.z = pkbf(v1[0], v1[1]); w.w = pkbf(v1[2], v1[3]);
                    *(v4u*)(rowp + bj * 128) = w; } }
    }
};
struct EpiOut2 {
    static constexpr bool PERM = false, AFTER_DRAIN = false;
    float* X; const float* mod; float* rowss;
    __device__ __forceinline__ void operator()(const f32x4 (&acc)[2][2][4][2], const pg8::Unit& u, int wr, int wc, int fr, int fq) const {
        const int ci = cvec_of_row(u.pm * 256);
        const int col0 = u.pn * 256 + wc * 32 + 4 * fq;
        f32x4 ga[2][2];
#pragma unroll
        for (int bj = 0; bj < 2; ++bj)
#pragma unroll
            for (int n = 0; n < 2; ++n) ga[bj][n] = *(const f32x4*)(mod + ci * NMOD + 5 * D + col0 + bj * 128 + n * 16);
#pragma unroll
        for (int ai = 0; ai < 2; ++ai)
#pragma unroll
            for (int m = 0; m < 4; ++m) { const size_t r = (size_t)u.pm * 256 + ai * 128 + wr * 64 + m * 16 + fr; float ss = 0.f;
#pragma unroll
                for (int bj = 0; bj < 2; ++bj)
#pragma unroll
                    for (int n = 0; n < 2; ++n) { const int c = col0 + bj * 128 + n * 16;
                        const f32x4 x = *(const f32x4*)(X + r * D + c); const f32x4 x2 = x + ga[bj][n] * acc[ai][bj][m][n];
                        *(f32x4*)(X + r * D + c) = x2; ss += (x2[0] * x2[0] + x2[1] * x2[1]) + (x2[2] * x2[2] + x2[3] * x2[3]); }
                ss += __shfl_xor(ss, 16); ss += __shfl_xor(ss, 32);
                if (fq == 0) atomicAdd(rowss + r, ss); }
    }
};

struct Args { const float* in[31]; float* out; unsigned char* ws; int ph_lo, ph_hi; };
struct Frame {
    LAS unsigned char* lds;
    int tid, lane, wave, G, bid;
    const float* const* in;
    float* out; unsigned char* ws;
};

__device__ __forceinline__ void tr_item(const float* W, int ldw, const float* mu, int mode, bf16* WT, int ldk, LAS float* scr, int kb, int nb, int lane) {
    const int k0 = 64 * kb, n0 = 32 * nb;
#pragma unroll 8
    for (int i = 0; i < 32; ++i) { const int kk = 2 * i + (lane >> 5); float v = W[(size_t)(k0 + kk) * ldw + n0 + (lane & 31)];
        if (mode) { const float mm = mu[k0 + kk]; v *= (mode == 1) ? (1.0f - mm) : mm; }
        scr[kk * 33 + (lane & 31)] = v; }
    LDS_WAIT(); asm volatile("" ::: "memory");
    const int c = lane & 7;
#pragma unroll
    for (int j = 0; j < 4; ++j) { const int n = (lane >> 3) + 8 * j; const LAS float* s = scr + (8 * c) * 33 + n;
        v4u o; o.x = pkbf(s[0 * 33], s[1 * 33]); o.y = pkbf(s[2 * 33], s[3 * 33]); o.z = pkbf(s[4 * 33], s[5 * 33]); o.w = pkbf(s[6 * 33], s[7 * 33]);
        *(GAS v4u*)(WT + (size_t)(n0 + n) * ldk + k0 + 8 * c) = o; }
    LDS_WAIT(); asm volatile("" ::: "memory");
}
__device__ __forceinline__ void p0_prologue(Frame& F) {
    const float* const* in = F.in;
    {
        LAS float* sl = (LAS float*)(F.lds + 98304);
        LAS float* red = (LAS float*)(F.lds + 98304 + 20480);
        if (F.bid < 192 || F.G < 192) {
            for (int i = F.tid; i < 5 * D; i += NWAVES * 64) { const int ci = i >> 10, k = i & 1023; const float x = ci == 0 ? in[4][k] : in[3][(ci - 1) * D + k]; sl[i] = x * frcp(1.0f + __expf(-x)); }
            __syncthreads();
            float* mod = (float*)(F.ws + WS_MOD);
            for (int item = F.bid; item < 192; item += F.G) {
                const int col = F.tid & 31, ks = F.tid >> 5, n = item * 32 + col;
                float a0 = 0.f, a1 = 0.f, a2 = 0.f, a3 = 0.f, a4 = 0.f;
                const float* wp = in[5] + (size_t)(ks * 64) * NMOD + n;
#pragma unroll 8
                for (int k = 0; k < 64; ++k) { const float w = wp[(size_t)k * NMOD]; const int kk = ks * 64 + k;
                    a0 += sl[kk] * w; a1 += sl[1024 + kk] * w; a2 += sl[2048 + kk] * w; a3 += sl[3072 + kk] * w; a4 += sl[4096 + kk] * w; }
                LAS float* rp = red + (ks * 32 + col) * 5; rp[0] = a0; rp[1] = a1; rp[2] = a2; rp[3] = a3; rp[4] = a4;
                __syncthreads();
                if (F.tid < 160) { const int ci = F.tid >> 5, cc = F.tid & 31; float s = in[6][item * 32 + cc];
#pragma unroll
                    for (int q = 0; q < 16; ++q) s += red[(q * 32 + cc) * 5 + ci];
                    mod[ci * NMOD + item * 32 + cc] = s; }
                __syncthreads();
            }
        }
    }
    LAS float* scr = (LAS float*)(F.lds + F.wave * 12288);
    const int gw = F.bid * NWAVES + F.wave, NGW = F.G * NWAVES;
    bf16* WcatT = (bf16*)(F.ws + WS_WCAT); bf16* WoutT = (bf16*)(F.ws + WS_WOUT); bf16* Wff1T = (bf16*)(F.ws + WS_WFF1); bf16* Wff2T = (bf16*)(F.ws + WS_WFF2);
    bf16* poolWT = (bf16*)(F.ws + WS_POOLW); bf16* gw2T = (bf16*)(F.ws + WS_GW2T);
    constexpr int I_IN = 16 * 176, I_LORA = 6 * 64, I_OUT = 16 * 32, I_F1 = 16 * 128, I_F2 = 64 * 32, I_POOL = 4 * 16, I_G2 = 2 * 32;
    constexpr int NITEMS = I_IN + I_LORA + I_OUT + I_F1 + I_F2 + I_POOL + I_G2;
    for (int it = gw; it < NITEMS; it += NGW) {
        int r = it;
        if (r < I_IN) { tr_item(in[9], 5632, nullptr, 0, WcatT, D, scr, r / 176, r % 176, F.lane); continue; } r -= I_IN;
        if (r < I_LORA) { const int qs = r / 64, q = qs >> 1, s = qs & 1, rr = r % 64, kb = rr / 4, nb = rr % 4;
            const float* W; int ldw;
            if (q < 2) { W = (q == 0 ? in[13] : in[16]) + (size_t)(nb >> 1) * D * 64 + (nb & 1) * 32; ldw = 64; } else { W = in[18] + nb * 32; ldw = 128; }
            tr_item(W, ldw, in[11] + q * D, s + 1, WcatT + (size_t)(ZC_LW_A + q * 256 + s * 128 + nb * 32) * D, D, scr, kb, 0, F.lane); continue; } r -= I_LORA;
        if (r < I_OUT) { tr_item(in[27], D, nullptr, 0, WoutT, D, scr, r / 32, r % 32, F.lane); continue; } r -= I_OUT;
        if (r < I_F1) { tr_item(in[28], FF, nullptr, 0, Wff1T, D, scr, r / 128, r % 128, F.lane); continue; } r -= I_F1;
        if (r < I_F2) { tr_item(in[29], D, nullptr, 0, Wff2T, FF, scr, r / 32, r % 32, F.lane); continue; } r -= I_F2;
        if (r < I_POOL) { const int g = r / 16, rr = r % 16; tr_item(in[25] + (size_t)g * 128 * 256, 256, nullptr, 0, poolWT + (size_t)g * 256 * 128, 128, scr, rr / 8, rr % 8, F.lane); continue; } r -= I_POOL;
        tr_item(in[19], D, nullptr, 0, gw2T, 128, scr, r / 32, r % 32, F.lane);
    }
}

__device__ __forceinline__ void p1_hprep(Frame& F) {
    const float* const* in = F.in;
    const int gw = F.bid * NWAVES + F.wave, NGW = F.G * NWAVES;
    const float* mod = (const float*)(F.ws + WS_MOD);
    bf16* H = (bf16*)(F.ws + WS_H);
    for (int m = gw; m < M; m += NGW) {
        const float* xrow = m < M_CTX ? in[0] + (size_t)m * D : in[1] + (size_t)(m - M_CTX) * D;
        const int ci = cvec_of_row(m);
        f32x4 v[4]; float s = 0.f;
#pragma unroll
        for (int j = 0; j < 4; ++j) { v[j] = *(const f32x4*)(xrow + 4 * (F.lane + 64 * j)); s += (v[j].x * v[j].x + v[j].y * v[j].y) + (v[j].z * v[j].z + v[j].w * v[j].w); }
        const float rstd = rsqrtf(wave_sum(s) * (1.0f / D) + 1e-6f);
#pragma unroll
        for (int j = 0; j < 4; ++j) { const int c = 4 * (F.lane + 64 * j);
            const f32x4 g = *(const f32x4*)(in[7] + c), sh = *(const f32x4*)(mod + ci * NMOD + c), sc = *(const f32x4*)(mod + ci * NMOD + D + c);
            const f32x4 y = (v[j] * rstd) * g * (sc + 1.0f) + sh;
            v2u w; w.x = pkbf(y.x, y.y); w.y = pkbf(y.z, y.w); *(v2u*)(H + (size_t)m * D + c) = w; }
    }
    const bf16* Wff1T = (const bf16*)(F.ws + WS_WFF1); float* c1 = (float*)(F.ws + WS_C1);
    for (int n = gw; n < FF; n += NGW) {
        const bf16* wr = Wff1T + (size_t)n * D + F.lane * 16;
        const v4u w0 = *(const v4u*)wr, w1 = *(const v4u*)(wr + 8);
        float w[16];
#pragma unroll
        for (int e = 0; e < 4; ++e) { w[2 * e] = __builtin_bit_cast(float, w0[e] << 16); w[2 * e + 1] = __builtin_bit_cast(float, w0[e] & 0xffff0000u);
            w[8 + 2 * e] = __builtin_bit_cast(float, w1[e] << 16); w[8 + 2 * e + 1] = __builtin_bit_cast(float, w1[e] & 0xffff0000u); }
#pragma unroll
        for (int ci = 0; ci < 5; ++ci) { const float* sh = mod + ci * NMOD + 3 * D + F.lane * 16; float s = 0.f;
#pragma unroll
            for (int q = 0; q < 4; ++q) { const f32x4 x = *(const f32x4*)(sh + 4 * q); s += x.x * w[4 * q] + x.y * w[4 * q + 1] + x.z * w[4 * q + 2] + x.w * w[4 * q + 3]; }
            s = wave_sum(s); if (F.lane == 0) c1[ci * FF + n] = s; }
    }
}

constexpr int SC = 32;
__device__ __forceinline__ void p3_scan(Frame& F) {
    const float* const* in = F.in;
    const f16* Z = (const f16*)(F.ws + WS_Z);
    LAS float* OPS = (LAS float*)(F.lds);
    LAS float* HW = (LAS float*)(F.lds + 49152);
    LAS float* HA = (LAS float*)(F.lds + 57344);
    LAS float* WD2 = (LAS float*)(F.lds + 65536);
    LAS float* WA2 = (LAS float*)(F.lds + 81920);
    LAS float* YB = (LAS float*)(F.lds + 98304);
    const int tid = F.tid, i = tid >> 3, g = tid & 7;
    const int ptt = tid >> 4, pc4 = (tid & 15) * 4;
    constexpr int NLAT = 4 * NH * 2, NCTX = 16 * NH * 2, NCH = NLAT + NCTX;
    for (int slot = 0;; ++slot) {
        int chain;
        if (F.G == 256) { if (F.bid < 128) { if (slot > 0) break; chain = F.bid; } else { if (slot > 3) break; chain = NLAT + (F.bid - 128) + 128 * slot; } }
        else { chain = F.bid + slot * F.G; if (chain >= NCH) break; }
        const bool isLat = chain < NLAT; const int cid = isLat ? chain : chain - NLAT;
        const int b = cid / 32, head = (cid >> 1) & 15, d = cid & 1;
        const int L = isLat ? L_LAT : L_CTX, m0 = isLat ? M_CTX + b * L_LAT : b * L_CTX;
        bf16* Y = (bf16*)F.out + (size_t)d * M * D;
        __syncthreads();
        for (int idx = tid; idx < 4096; idx += NWAVES * 64) { const int k = idx >> 6, c = idx & 63;
            WD2[idx] = in[14][(size_t)(d * 64 + k) * D + head * 64 + c]; WA2[idx] = in[17][(size_t)(d * 64 + k) * D + head * 64 + c]; }
        float S[8];
        if (isLat) { const float* sp = in[2] + ((size_t)((b * 2 + d) * NH + head)) * 4096 + i * 64 + g * 8; const f32x4 s0 = *(const f32x4*)sp, s1 = *(const f32x4*)(sp + 4);
            S[0] = s0.x; S[1] = s0.y; S[2] = s0.z; S[3] = s0.w; S[4] = s1.x; S[5] = s1.y; S[6] = s1.z; S[7] = s1.w; }
        else {
#pragma unroll
            for (int j = 0; j < 8; ++j) S[j] = 0.f; }
        const int hc = head * 64 + pc4;
        const f32x4 mu_r = *(const f32x4*)(in[10] + hc), mu_k = *(const f32x4*)(in[10] + D + hc), mu_v = *(const f32x4*)(in[10] + 2 * D + hc);
        const f32x4 kkw = *(const f32x4*)(in[20] + hc), kaw = *(const f32x4*)(in[21] + hc);
        const f32x4 wd0 = *(const f32x4*)(in[12] + d * D + hc), a0v = *(const f32x4*)(in[15] + d * D + hc);
        const int nch = L / SC;
        for (int ch = 0; ch < nch; ++ch) {
            const int t0 = d == 0 ? SC * ch : L - SC * (ch + 1);
            f32x4 k4, kk4;
            {
                const int t = t0 + ptt; const f16* zr = Z + (size_t)(m0 + t) * NZ;
                const float fp = t > 0 ? 0.5f : 0.f, fn = t < L - 1 ? 0.5f : 0.f;
                const f16* zp = t > 0 ? zr - NZ : zr; const f16* zn = t < L - 1 ? zr + NZ : zr;
                const f32x4 rz = ld_h4(zr + ZC_R + hc), kz = ld_h4(zr + ZC_K + hc), vz = ld_h4(zr + ZC_V + hc);
                const f32x4 rs = ld_h4(zp + ZC_R + hc) * fp + ld_h4(zn + ZC_R + hc) * fn;
                const f32x4 ks = ld_h4(zp + ZC_K + hc) * fp + ld_h4(zn + ZC_K + hc) * fn;
                const f32x4 vs = ld_h4(zp + ZC_V + hc) * fp + ld_h4(zn + ZC_V + hc) * fn;
                const f32x4 r4 = rz + (rs - rz) * mu_r; k4 = kz + (ks - kz) * mu_k; const f32x4 v4 = vz + (vs - vz) * mu_v;
                const int lc = d * 64 + pc4;
                f32x4 hw = ld_h4(zr + ZC_LW_A + lc) + ld_h4(zp + ZC_LW_B + lc) * fp + ld_h4(zn + ZC_LW_B + lc) * fn;
                const f32x4 ha = ld_h4(zr + ZC_LA_A + lc) + ld_h4(zp + ZC_LA_B + lc) * fp + ld_h4(zn + ZC_LA_B + lc) * fn;
#pragma unroll
                for (int e = 0; e < 4; ++e) hw[e] = 1.0f - 2.0f * frcp(__expf(2.0f * hw[e]) + 1.0f);
                const f32x4 ku = k4 * kkw; float ssq = (ku.x * ku.x + ku.y * ku.y) + (ku.z * ku.z + ku.w * ku.w);
                ssq += __shfl_xor(ssq, 1); ssq += __shfl_xor(ssq, 2); ssq += __shfl_xor(ssq, 4); ssq += __shfl_xor(ssq, 8);
                kk4 = ku * rsqrtf(ssq + 1e-12f);
                *(LAS f32x4*)(HW + ptt * 64 + pc4) = hw; *(LAS f32x4*)(HA + ptt * 64 + pc4) = ha;
                *(LAS f32x4*)(OPS + ptt * 384 + 64 + pc4) = kk4; *(LAS f32x4*)(OPS + ptt * 384 + 256 + pc4) = r4; *(LAS f32x4*)(OPS + ptt * 384 + 320 + pc4) = v4;
            }
            __syncthreads();
            {
                f32x4 aw = {0.f, 0.f, 0.f, 0.f}, aa = {0.f, 0.f, 0.f, 0.f};
#pragma unroll 8
                for (int k = 0; k < 64; ++k) { const float hwk = HW[ptt * 64 + k], hak = HA[ptt * 64 + k];
                    aw += *(const LAS f32x4*)(WD2 + k * 64 + pc4) * hwk; aa += *(const LAS f32x4*)(WA2 + k * 64 + pc4) * hak; }
                f32x4 dec, av, kd, bb;
#pragma unroll
                for (int e = 0; e < 4; ++e) { dec[e] = __expf(-0.6065306597126334f * sigmoidf_(wd0[e] + aw[e])); av[e] = sigmoidf_(a0v[e] + aa[e]); }
                kd = k4 * ((av - 1.0f) * kaw + 1.0f); bb = kk4 * av;
                *(LAS f32x4*)(OPS + ptt * 384 + pc4) = dec; *(LAS f32x4*)(OPS + ptt * 384 + 128 + pc4) = bb; *(LAS f32x4*)(OPS + ptt * 384 + 192 + pc4) = kd;
            }
            __syncthreads();
#pragma unroll 2
            for (int s = 0; s < SC; ++s) {
                const int tt = d == 0 ? s : SC - 1 - s;
                const LAS float* op = OPS + tt * 384 + g * 8;
                const f32x4 w0 = *(const LAS f32x4*)(op), w1 = *(const LAS f32x4*)(op + 4);
                const f32x4 q0 = *(const LAS f32x4*)(op + 64), q1 = *(const LAS f32x4*)(op + 68);
                const f32x4 b0 = *(const LAS f32x4*)(op + 128), b1 = *(const LAS f32x4*)(op + 132);
                const f32x4 d0 = *(const LAS f32x4*)(op + 192), d1 = *(const LAS f32x4*)(op + 196);
                const f32x4 r0 = *(const LAS f32x4*)(op + 256), r1 = *(const LAS f32x4*)(op + 260);
                const float v = OPS[tt * 384 + 320 + i];
                float p = (S[0] * q0.x + S[1] * q0.y) + (S[2] * q0.z + S[3] * q0.w) + (S[4] * q1.x + S[5] * q1.y) + (S[6] * q1.z + S[7] * q1.w);
                p += __shfl_xor(p, 1); p += __shfl_xor(p, 2); p += __shfl_xor(p, 4);
                S[0] = S[0] * w0.x - p * b0.x + v * d0.x; S[1] = S[1] * w0.y - p * b0.y + v * d0.y; S[2] = S[2] * w0.z - p * b0.z + v * d0.z; S[3] = S[3] * w0.w - p * b0.w + v * d0.w;
                S[4] = S[4] * w1.x - p * b1.x + v * d1.x; S[5] = S[5] * w1.y - p * b1.y + v * d1.y; S[6] = S[6] * w1.z - p * b1.z + v * d1.z; S[7] = S[7] * w1.w - p * b1.w + v * d1.w;
                float y = (S[0] * r0.x + S[1] * r0.y) + (S[2] * r0.z + S[3] * r0.w) + (S[4] * r1.x + S[5] * r1.y) + (S[6] * r1.z + S[7] * r1.w);
                y += __shfl_xor(y, 1); y += __shfl_xor(y, 2); y += __shfl_xor(y, 4);
                if (g == 0) YB[tt * 64 + i] = y;
            }
            __syncthreads();
            { const f32x4 y4 = *(const LAS f32x4*)(YB + ptt * 64 + pc4); v2u w; w.x = pkbf(y4.x, y4.y); w.y = pkbf(y4.z, y4.w);
              *(v2u*)(Y + (size_t)(m0 + t0 + ptt) * D + hc) = w; }
        }
        if (!isLat) { float* so = F.out + (size_t)M * D + ((size_t)((b * 2 + d) * NH + head)) * 4096 + i * 64 + g * 8;
            *(f32x4*)so = (f32x4){S[0], S[1], S[2], S[3]}; *(f32x4*)(so + 4) = (f32x4){S[4], S[5], S[6], S[7]}; }
    }
}

typedef short s16x4 __attribute__((ext_vector_type(4)));
__device__ __forceinline__ int sw(int row, int col) { return row * 64 + ((((col >> 3) ^ (row >> 1)) & 7) << 3) + (col & 7); }
__device__ __forceinline__ bf16x8 ldfrag(const LAS bf16* buf, int row, int col) { return *(const LAS bf16x8*)(buf + sw(row, col)); }
__device__ __forceinline__ void mm_blk(f32x4 (&acc)[2][2], const LAS bf16* X, int xr0, const LAS bf16* Yt, int yr0, int fr, int fq) {
#pragma unroll
    for (int ks = 0; ks < 2; ++ks) {
        bf16x8 a[2], b[2];
#pragma unroll
        for (int t = 0; t < 2; ++t) { a[t] = ldfrag(X, xr0 + 16 * t + fr, 32 * ks + 8 * fq); b[t] = ldfrag(Yt, yr0 + 16 * t + fr, 32 * ks + 8 * fq); }
#pragma unroll
        for (int ti = 0; ti < 2; ++ti)
#pragma unroll
            for (int tj = 0; tj < 2; ++tj) acc[ti][tj] = __builtin_amdgcn_mfma_f32_16x16x32_bf16(a[ti], b[tj], acc[ti][tj], 0, 0, 0);
    }
}
__device__ __forceinline__ void zero_blk(f32x4 (&acc)[2][2]) {
#pragma unroll
    for (int ti = 0; ti < 2; ++ti)
#pragma unroll
        for (int tj = 0; tj < 2; ++tj) acc[ti][tj] = (f32x4){0.f, 0.f, 0.f, 0.f};
}
__device__ __forceinline__ void st_blk_t(LAS bf16* dst, const f32x4 (&acc)[2][2], int xr0, int yr0, int fr, int fq) {
#pragma unroll
    for (int ti = 0; ti < 2; ++ti)
#pragma unroll
        for (int tj = 0; tj < 2; ++tj) { v2u w; w.x = pkbf(acc[ti][tj][0], acc[ti][tj][1]); w.y = pkbf(acc[ti][tj][2], acc[ti][tj][3]);
            *(LAS v2u*)(dst + sw(yr0 + 16 * tj + fr, xr0 + 16 * ti + 4 * fq)) = w; }
}
#ifndef SREP_MASK
#define SREP_MASK 0
#endif
#ifndef SREP_N
#define SREP_N 2
#endif
#define SREP(k) for (int srep_ = 0; srep_ < (((SREP_MASK >> (k)) & 1) ? 1 + SREP_N : 1); ++srep_)
constexpr int CS = 64;
__device__ __forceinline__ void p3_scan2(Frame& F) {
    const float* const* in = F.in;
    const f16* Z = (const f16*)(F.ws + WS_Z);
    LAS bf16* const B0 = (LAS bf16*)(F.lds);
#define MB(n) (B0 + (n) * 4096)
    LAS bf16* const KKg = MB(0); LAS bf16* const Rg = MB(1); LAS bf16* const Bi = MB(2); LAS bf16* const Ki = MB(3);
    LAS bf16* const nBct = MB(4); LAS bf16* const Kct = MB(5); LAS bf16* const Vt = MB(6); LAS bf16* const Sb = MB(7);
    LAS bf16* const Aab = MB(8); LAS bf16* const Aak = MB(9); LAS bf16* const nArb = MB(10); LAS bf16* const Ark = MB(11); LAS bf16* const Minv = MB(12);
    LAS bf16* const RHSt = Bi; LAS bf16* const Ut = Ki; LAS bf16* const YB = KKg; LAS bf16* const HW = Bi; LAS bf16* const HA = Ki;
    LAS f16* const r16 = (LAS f16*)MB(8); LAS f16* const k16 = (LAS f16*)MB(9); LAS f16* const v16 = (LAS f16*)MB(10); LAS f16* const kk16 = (LAS f16*)MB(11); LAS f16* const a16 = (LAS f16*)MB(12);
    LAS bf16* const Wd2t = MB(13); LAS bf16* const Wa2t = MB(14);
    LAS float* const LW = (LAS float*)(F.lds + 15 * 8192);
    LAS float* const AD = LW;
    LAS float* const SEG = (LAS float*)(F.lds + 15 * 8192 + 16384);
    LAS float* const GC = SEG + 512;
    LAS bf16* const XT = (LAS bf16*)(GC + 64);
    LAS float* const CST = (LAS float*)(XT + 1024);
    const int tid = F.tid, lane = F.lane, wave = F.wave;
#define OPQ_LANE() int ln_ = lane; asm volatile("" : "+v"(ln_)); const int fr = ln_ & 15, fq = ln_ >> 4
#define OPQ_TID() int td_ = tid; asm volatile("" : "+v"(td_)); const int ptt = td_ >> 3, pc8 = (td_ & 7) * 8, cch = td_ & 63, cseg = td_ >> 6; (void)ptt; (void)pc8; (void)cch; (void)cseg
    constexpr int NLAT = 4 * NH * 2, NCTX = 16 * NH * 2, NCH = NLAT + NCTX;
    for (int slot = 0;; ++slot) {
        int chain;
        if (F.G == 256) { if (F.bid < 128) { if (slot > 0) break; chain = F.bid; } else { if (slot > 3) break; chain = NLAT + (F.bid - 128) + 128 * slot; } }
        else { chain = F.bid + slot * F.G; if (chain >= NCH) break; }
        const bool isLat = chain < NLAT; const int cid = isLat ? chain : chain - NLAT;
        const int b = cid / 32, head = (cid >> 1) & 15, d = cid & 1;
        const int L = isLat ? L_LAT : L_CTX, m0 = isLat ? M_CTX + b * L_LAT : b * L_CTX;
        bf16* Y = (bf16*)F.out + (size_t)d * M * D;
        __syncthreads();
        for (int idx = tid; idx < 4096; idx += NWAVES * 64) { const int k = idx >> 6, c = idx & 63;
            const float wv = in[14][(size_t)(d * 64 + k) * D + head * 64 + c], av = in[17][(size_t)(d * 64 + k) * D + head * 64 + c];
            Wd2t[sw(c, k)] = (bf16)(pkbf(wv, 0.f) & 0xffffu); Wa2t[sw(c, k)] = (bf16)(pkbf(av, 0.f) & 0xffffu); }
        const int v4 = wave & 3, bi = v4 >> 1, bj = v4 & 1;
        f32x4 Tacc[2][2]; zero_blk(Tacc);
        if (wave >= 4) { OPQ_LANE();
            if (isLat) { const float* sp = in[2] + ((size_t)((b * 2 + d) * NH + head)) * 4096;
#pragma unroll
                for (int ti = 0; ti < 2; ++ti)
#pragma unroll
                    for (int tj = 0; tj < 2; ++tj) Tacc[ti][tj] = *(const f32x4*)(sp + (32 * bj + 16 * tj + fr) * 64 + 32 * bi + 16 * ti + 4 * fq); }
            st_blk_t(Sb, Tacc, 32 * bi, 32 * bj, fr, fq);
        }
        if (tid < 384) { const int q = tid >> 6, c = tid & 63; CST[tid] = q < 3 ? in[10][q * D + head * 64 + c] : q == 3 ? in[20][head * 64 + c] : q == 4 ? in[12][d * D + head * 64 + c] : in[15][d * D + head * 64 + c]; }
        const float kac = in[21][head * 64 + (tid & 63)];
        const int nch = L / CS;
        f16x8 pz[15];
#define ZLOAD(chn) do { OPQ_TID(); const int tau_ = CS * (chn) + ptt, t_ = d == 0 ? tau_ : L - 1 - tau_; const int hc8_ = head * 64 + pc8, lc_ = d * 64 + pc8; \
            const f16* zr_ = Z + (size_t)(m0 + t_) * NZ; const f16* zp_ = t_ > 0 ? zr_ - NZ : zr_; const f16* zn_ = t_ < L - 1 ? zr_ + NZ : zr_; \
            pz[0] = *(const f16x8*)(zr_ + ZC_R + hc8_); pz[1] = *(const f16x8*)(zp_ + ZC_R + hc8_); pz[2] = *(const f16x8*)(zn_ + ZC_R + hc8_); \
            pz[3] = *(const f16x8*)(zr_ + ZC_K + hc8_); pz[4] = *(const f16x8*)(zp_ + ZC_K + hc8_); pz[5] = *(const f16x8*)(zn_ + ZC_K + hc8_); \
            pz[6] = *(const f16x8*)(zr_ + ZC_V + hc8_); pz[7] = *(const f16x8*)(zp_ + ZC_V + hc8_); pz[8] = *(const f16x8*)(zn_ + ZC_V + hc8_); \
            pz[9] = *(const f16x8*)(zr_ + ZC_LW_A + lc_); pz[10] = *(const f16x8*)(zp_ + ZC_LW_B + lc_); pz[11] = *(const f16x8*)(zn_ + ZC_LW_B + lc_); \
            pz[12] = *(const f16x8*)(zr_ + ZC_LA_A + lc_); pz[13] = *(const f16x8*)(zp_ + ZC_LA_B + lc_); pz[14] = *(const f16x8*)(zn_ + ZC_LA_B + lc_); } while (0)
        ZLOAD(0);
        __syncthreads();
        for (int ch = 0; ch < nch; ++ch) {
            SREP(0) {
                OPQ_TID();
                const int tau = CS * ch + ptt, t = d == 0 ? tau : L - 1 - tau;
                const float fp = t > 0 ? 0.5f : 0.f, fn = t < L - 1 ? 0.5f : 0.f;
                const f16x8 rz = pz[0], rp = pz[1], rn = pz[2], kz = pz[3], kp = pz[4], kn = pz[5], vz = pz[6], vp = pz[7], vn = pz[8];
                const f16x8 wa = pz[9], wbp = pz[10], wbn = pz[11], aa = pz[12], abp = pz[13], abn = pz[14];
                float mur[8], muk[8], muv[8], kkw[8];
#pragma unroll
                for (int h = 0; h < 2; ++h) { const f32x4 a_ = *(const LAS f32x4*)(CST + pc8 + 4 * h), b_ = *(const LAS f32x4*)(CST + 64 + pc8 + 4 * h), c_ = *(const LAS f32x4*)(CST + 128 + pc8 + 4 * h), d_ = *(const LAS f32x4*)(CST + 192 + pc8 + 4 * h);
#pragma unroll
                    for (int e = 0; e < 4; ++e) { mur[4 * h + e] = a_[e]; muk[4 * h + e] = b_[e]; muv[4 * h + e] = c_[e]; kkw[4 * h + e] = d_[e]; } }
                float rr[8], kk_[8], vv[8], ku[8], hw[8], ha[8]; float ssq = 0.f;
#pragma unroll
                for (int e = 0; e < 8; ++e) {
                    const float r0 = (float)rz[e], k0 = (float)kz[e], v0 = (float)vz[e];
                    rr[e] = r0 + (((float)rp[e] * fp + (float)rn[e] * fn) - r0) * mur[e];
                    kk_[e] = k0 + (((float)kp[e] * fp + (float)kn[e] * fn) - k0) * muk[e];
                    vv[e] = v0 + (((float)vp[e] * fp + (float)vn[e] * fn) - v0) * muv[e];
                    ku[e] = kk_[e] * kkw[e]; ssq += ku[e] * ku[e];
                    const float h = (float)wa[e] + (float)wbp[e] * fp + (float)wbn[e] * fn;
                    hw[e] = 1.0f - 2.0f * frcp(__expf(2.0f * h) + 1.0f);
                    ha[e] = (float)aa[e] + (float)abp[e] * fp + (float)abn[e] * fn; }
                ssq += __shfl_xor(ssq, 1); ssq += __shfl_xor(ssq, 2); ssq += __shfl_xor(ssq, 4);
                const float rn_ = rsqrtf(ssq + 1e-12f);
                v4u o;
                o.x = pkh(rr[0], rr[1]); o.y = pkh(rr[2], rr[3]); o.z = pkh(rr[4], rr[5]); o.w = pkh(rr[6], rr[7]); *(LAS v4u*)(r16 + ptt * 64 + pc8) = o;
                o.x = pkh(kk_[0], kk_[1]); o.y = pkh(kk_[2], kk_[3]); o.z = pkh(kk_[4], kk_[5]); o.w = pkh(kk_[6], kk_[7]); *(LAS v4u*)(k16 + ptt * 64 + pc8) = o;
                o.x = pkh(vv[0], vv[1]); o.y = pkh(vv[2], vv[3]); o.z = pkh(vv[4], vv[5]); o.w = pkh(vv[6], vv[7]); *(LAS v4u*)(v16 + ptt * 64 + pc8) = o;
                o.x = pkh(ku[0] * rn_, ku[1] * rn_); o.y = pkh(ku[2] * rn_, ku[3] * rn_); o.z = pkh(ku[4] * rn_, ku[5] * rn_); o.w = pkh(ku[6] * rn_, ku[7] * rn_); *(LAS v4u*)(kk16 + ptt * 64 + pc8) = o;
                o.x = pkbf(hw[0], hw[1]); o.y = pkbf(hw[2], hw[3]); o.z = pkbf(hw[4], hw[5]); o.w = pkbf(hw[6], hw[7]); *(LAS v4u*)(HW + sw(ptt, pc8)) = o;
                o.x = pkbf(ha[0], ha[1]); o.y = pkbf(ha[2], ha[3]); o.z = pkbf(ha[4], ha[5]); o.w = pkbf(ha[6], ha[7]); *(LAS v4u*)(HA + sw(ptt, pc8)) = o;
            }
            if (ch + 1 < nch) ZLOAD(ch + 1);
            __syncthreads();
            SREP(1) {
                OPQ_LANE();
                f32x4 acc[2][2]; zero_blk(acc);
                mm_blk(acc, wave < 4 ? Wd2t : Wa2t, 32 * bi, wave < 4 ? HW : HA, 32 * bj, fr, fq);
#pragma unroll
                for (int ti = 0; ti < 2; ++ti) { const int c0 = 32 * bi + 16 * ti + 4 * fq;
                    const f32x4 bias = *(const LAS f32x4*)(CST + (wave < 4 ? 256 : 320) + c0);
#pragma unroll
                    for (int tj = 0; tj < 2; ++tj) { const int tt = 32 * bj + 16 * tj + fr; f32x4 x = acc[ti][tj] + bias;
#pragma unroll
                        for (int e = 0; e < 4; ++e) x[e] = sigmoidf_(x[e]);
                        if (wave < 4) *(LAS f32x4*)(LW + tt * 64 + c0) = x * (-0.6065306597126334f);
                        else { v2u w; w.x = pkh(x[0], x[1]); w.y = pkh(x[2], x[3]); *(LAS v2u*)(a16 + tt * 64 + c0) = w; } } }
            }
            __syncthreads();
            float lwv[8];
            { OPQ_TID(); float run = 0.f;
#pragma unroll
              for (int e = 0; e < 8; ++e) { lwv[e] = LW[(8 * cseg + e) * 64 + cch]; run += lwv[e]; }
              SEG[cseg * 64 + cch] = run; }
            __syncthreads();
            SREP(2) {
                OPQ_TID();
                float pre = 0.f, tot = 0.f;
#pragma unroll
                for (int s = 0; s < 8; ++s) { const float x = SEG[s * 64 + cch]; tot += x; pre += (s < cseg) ? x : 0.f; }
                const float gC = __expf(tot); float E = __expf(pre);
                if (cseg == 0) GC[cch] = gC;
                float nb[8], kc[8], vt[8];
#pragma unroll
                for (int e = 0; e < 8; ++e) { const int tt = 8 * cseg + e;
                    const float gprev = E; E *= __expf(lwv[e]); const float inv = frcp(E), e4 = gC * inv;
                    const float kkv = (float)kk16[tt * 64 + cch], rv = (float)r16[tt * 64 + cch], kv = (float)k16[tt * 64 + cch], vv = (float)v16[tt * 64 + cch], av = (float)a16[tt * 64 + cch];
                    const float kd = kv * (1.0f + (av - 1.0f) * kac), bb = kkv * av;
                    KKg[sw(tt, cch)] = (bf16)(pkbf(kkv * gprev, 0.f) & 0xffffu); Rg[sw(tt, cch)] = (bf16)(pkbf(rv * E, 0.f) & 0xffffu);
                    Bi[sw(tt, cch)] = (bf16)(pkbf(bb * inv, 0.f) & 0xffffu); Ki[sw(tt, cch)] = (bf16)(pkbf(kd * inv, 0.f) & 0xffffu);
                    nb[e] = -bb * e4; kc[e] = kd * e4; vt[e] = vv; }
                v4u o;
                o.x = pkbf(nb[0], nb[1]); o.y = pkbf(nb[2], nb[3]); o.z = pkbf(nb[4], nb[5]); o.w = pkbf(nb[6], nb[7]); *(LAS v4u*)(nBct + sw(cch, 8 * cseg)) = o;
                o.x = pkbf(kc[0], kc[1]); o.y = pkbf(kc[2], kc[3]); o.z = pkbf(kc[4], kc[5]); o.w = pkbf(kc[6], kc[7]); *(LAS v4u*)(Kct + sw(cch, 8 * cseg)) = o;
                o.x = pkbf(vt[0], vt[1]); o.y = pkbf(vt[2], vt[3]); o.z = pkbf(vt[4], vt[5]); o.w = pkbf(vt[6], vt[7]); *(LAS v4u*)(Vt + sw(cch, 8 * cseg)) = o;
            }
            __syncthreads();
            SREP(3) {
                OPQ_LANE();
                const int mtx = wave >> 1, sb = wave & 1;
                const LAS bf16* X = (mtx & 1) ? Ki : Bi; const LAS bf16* Yt = (mtx >> 1) ? Rg : KKg;
                LAS bf16* dst = mtx == 0 ? Aab : mtx == 1 ? Aak : mtx == 2 ? nArb : Ark;
                const bool incl = mtx >= 2; const float sgn = mtx == 2 ? -1.0f : 1.0f;
#pragma unroll
                for (int tb = 0; tb < 2; ++tb) {
                    f32x4 acc[2][2]; zero_blk(acc);
                    if (tb >= sb) mm_blk(acc, X, 32 * sb, Yt, 32 * tb, fr, fq);
#pragma unroll
                    for (int ti = 0; ti < 2; ++ti)
#pragma unroll
                        for (int tj = 0; tj < 2; ++tj) { const int t = 32 * tb + 16 * tj + fr, s0 = 32 * sb + 16 * ti + 4 * fq; f32x4 x = acc[ti][tj] * sgn;
                            if (tb == sb && ti >= tj) {
#pragma unroll
                                for (int e = 0; e < 4; ++e) { const bool keep = incl ? (s0 + e <= t) : (s0 + e < t); x[e] = keep ? x[e] : 0.f; } }
                            v2u w; w.x = pkbf(x[0], x[1]); w.y = pkbf(x[2], x[3]); *(LAS v2u*)(dst + sw(t, s0)) = w;
                            if (mtx == 0 && tb == sb && ti == tj) *(LAS f32x4*)(AD + (2 * tb + tj) * 256 + fr * 16 + 4 * fq) = x; }
                }
            }
            __syncthreads();
            f32x4 Yacc[2][2]; zero_blk(Yacc);
            SREP(4) if (wave < 3) {
                OPQ_LANE();
                float x[16];
#pragma unroll
                for (int r = 0; r < 16; ++r) x[r] = (r == fr) ? 1.0f : 0.0f;
#pragma unroll
                for (int r = 1; r < 16; ++r) { float s = 0.f;
#pragma unroll
                    for (int k4 = 0; k4 < (r + 3) / 4; ++k4) { const f32x4 nr = *(const LAS f32x4*)(AD + fq * 256 + r * 16 + 4 * k4);
#pragma unroll
                        for (int e = 0; e < 4; ++e) if (4 * k4 + e < r) s += nr[e] * x[4 * k4 + e]; }
                    x[r] = (r > fr) ? -s : x[r]; }
#pragma unroll
                for (int r = 0; r < 16; ++r) Minv[sw(16 * fq + r, 16 * fq + fr)] = (bf16)(pkbf(x[r], 0.f) & 0xffffu);
                { v4u o; o.x = pkbf(x[0], x[1]); o.y = pkbf(x[2], x[3]); o.z = pkbf(x[4], x[5]); o.w = pkbf(x[6], x[7]); *(LAS v4u*)(XT + fq * 256 + fr * 16) = o;
                  o.x = pkbf(x[8], x[9]); o.y = pkbf(x[10], x[11]); o.z = pkbf(x[12], x[13]); o.w = pkbf(x[14], x[15]); *(LAS v4u*)(XT + fq * 256 + fr * 16 + 8) = o; }
                const int j = wave;
                s16x4 xb[3];
                xb[0] = *(const LAS s16x4*)(XT + j * 256 + fr * 16 + 4 * fq);
                xb[1] = xb[0]; xb[2] = xb[0];
#pragma unroll
                for (int dl = 1; dl <= 3; ++dl) { if (j + dl <= 3) { const int i = j + dl;
                    f32x4 p = {0.f, 0.f, 0.f, 0.f};
#pragma unroll
                    for (int mm = 0; mm < dl; ++mm) { const s16x4 n = *(const LAS s16x4*)(Aab + sw(16 * i + fr, 16 * (j + mm) + 4 * fq));
                        p = __builtin_amdgcn_mfma_f32_16x16x16bf16_1k(n, xb[mm], p, 0, 0, 0); }
                    v2u pw; pw.x = pkbf(p[0], p[1]); pw.y = pkbf(p[2], p[3]);
                    const s16x4 xi = *(const LAS s16x4*)(Minv + sw(16 * i + fr, 16 * i + 4 * fq));
                    f32x4 z = {0.f, 0.f, 0.f, 0.f};
                    z = __builtin_amdgcn_mfma_f32_16x16x16bf16_1k(xi, __builtin_bit_cast(s16x4, pw), z, 0, 0, 0);
                    v2u zw; zw.x = pkbf(-z[0], -z[1]); zw.y = pkbf(-z[2], -z[3]);
                    if (dl < 3) xb[dl] = __builtin_bit_cast(s16x4, zw);
                    Minv[sw(16 * i + 4 * fq + 0, 16 * j + fr)] = (bf16)(zw.x & 0xffffu); Minv[sw(16 * i + 4 * fq + 1, 16 * j + fr)] = (bf16)(zw.x >> 16);
                    Minv[sw(16 * i + 4 * fq + 2, 16 * j + fr)] = (bf16)(zw.y & 0xffffu); Minv[sw(16 * i + 4 * fq + 3, 16 * j + fr)] = (bf16)(zw.y >> 16); } }
            }
            if (wave == 3) { OPQ_LANE();
#pragma unroll
                for (int bc = 1; bc < 4; ++bc)
                    for (int r = 0; r < 16 * bc; r += 4) *(LAS unsigned short*)(Minv + sw(r + fq, 16 * bc + fr)) = 0; }
            if (wave >= 4) {
                OPQ_LANE();
                f32x4 R[2][2]; zero_blk(R);
                mm_blk(R, Aak, 32 * bi, Vt, 32 * bj, fr, fq);
                mm_blk(R, KKg, 32 * bi, Sb, 32 * bj, fr, fq);
                st_blk_t(RHSt, R, 32 * bi, 32 * bj, fr, fq);
#pragma unroll
                for (int ti = 0; ti < 2; ++ti) { const f32x4 g = *(const LAS f32x4*)(GC + 32 * bi + 16 * ti + 4 * fq);
#pragma unroll
                    for (int tj = 0; tj < 2; ++tj) Tacc[ti][tj] *= g; }
                mm_blk(Tacc, Kct, 32 * bi, Vt, 32 * bj, fr, fq);
                mm_blk(Yacc, Sb, 32 * bi, Rg, 32 * bj, fr, fq);
                mm_blk(Yacc, Vt, 32 * bi, Ark, 32 * bj, fr, fq);
            }
            __syncthreads();
            SREP(6) if (wave >= 4) {
                OPQ_LANE();
                f32x4 Uc[2][2]; zero_blk(Uc);
                mm_blk(Uc, Minv, 32 * bi, RHSt, 32 * bj, fr, fq);
                st_blk_t(Ut, Uc, 32 * bi, 32 * bj, fr, fq);
            }
            __syncthreads();
            if (wave >= 4) {
                OPQ_LANE();
                mm_blk(Tacc, nBct, 32 * bi, Ut, 32 * bj, fr, fq);
                mm_blk(Yacc, Ut, 32 * bi, nArb, 32 * bj, fr, fq);
                st_blk_t(Sb, Tacc, 32 * bi, 32 * bj, fr, fq);
                st_blk_t(YB, Yacc, 32 * bi, 32 * bj, fr, fq);
            }
            __syncthreads();
            { OPQ_TID(); const int tau = CS * ch + ptt, t = d == 0 ? tau : L - 1 - tau;
              *(v4u*)(Y + (size_t)(m0 + t) * D + head * 64 + pc8) = *(const LAS v4u*)(YB + sw(ptt, pc8)); }
        }
        if (!isLat && wave >= 4) { OPQ_LANE(); float* so = F.out + (size_t)M * D + ((size_t)((b * 2 + d) * NH + head)) * 4096;
#pragma unroll
            for (int ti = 0; ti < 2; ++ti)
#pragma unroll
                for (int tj = 0; tj < 2; ++tj) *(f32x4*)(so + (32 * bj + 16 * tj + fr) * 64 + 32 * bi + 16 * ti + 4 * fq) = Tacc[ti][tj]; }
    }
#undef MB
#undef ZLOAD
#undef OPQ_LANE
#undef OPQ_TID
}
constexpr int MXS = 136;
constexpr int TT = 32, NMIXT = M / TT;
constexpr size_t WS_P2 = 208 * MiB, WS_GBL = 232 * MiB;
constexpr int CW_TQ = 2048;
__device__ __forceinline__ void mixA_tile(Frame& F, int tile) {
    const float* const* in = F.in;
    const f16* Z = (const f16*)(F.ws + WS_Z);
    bf16* P2 = (bf16*)(F.ws + WS_P2); bf16* GBL = (bf16*)(F.ws + WS_GBL);
    const bf16* poolWT = (const bf16*)(F.ws + WS_POOLW); const bf16* gw2T = (const bf16*)(F.ws + WS_GW2T);
    LAS bf16* SG = (LAS bf16*)(F.lds);
    LAS float* RK = (LAS float*)(F.lds + 8704);
    LAS f16* ZP = (LAS f16*)(F.lds + 8704 + 2048);
    LAS bf16* MX = (LAS bf16*)(F.lds + 8704 + 2048 + 12288);
    const int tid = F.tid, lane = F.lane, wave = F.wave;
    const int m0t = tile * TT;
    const bool isCtx = m0t < M_CTX;
    const int ms = isCtx ? (m0t / L_CTX) * L_CTX : M_CTX + ((m0t - M_CTX) / L_LAT) * L_LAT, L = isCtx ? L_CTX : L_LAT;
    const int prow = isCtx ? ms : (m0t & ~63);
    const int vlo = prow - m0t, vhi = vlo + (isCtx ? L_CTX : 64);
    __syncthreads();
    { const int tt = tid >> 4, c8 = (tid & 15) * 8; const int m = m0t + tt, t = m - ms;
      const f16* zr = Z + (size_t)m * NZ; const f16* zp = t > 0 ? zr - NZ : zr; const f16* zn = t < L - 1 ? zr + NZ : zr;
      const float fp = t > 0 ? 0.5f : 0.f, fn = t < L - 1 ? 0.5f : 0.f;
      const f16x8 a = *(const f16x8*)(zr + ZC_LG_A + c8), bp = *(const f16x8*)(zp + ZC_LG_B + c8), bn = *(const f16x8*)(zn + ZC_LG_B + c8);
      float h[8];
#pragma unroll
      for (int e = 0; e < 8; ++e) h[e] = sigmoidf_((float)a[e] + (float)bp[e] * fp + (float)bn[e] * fn);
      *(LAS v4u*)(SG + tt * MXS + c8) = (v4u){pkbf(h[0], h[1]), pkbf(h[2], h[3]), pkbf(h[4], h[5]), pkbf(h[6], h[7])}; }
#pragma unroll 1
    for (int it = 0; it < 4; ++it) { const int item = it * 512 + tid, pair = item >> 2, q = item & 3, tt = pair >> 4, head = pair & 15; const int m = m0t + tt, t = m - ms, c0 = head * 64 + q * 16;
        const f16* zr = Z + (size_t)m * NZ; const f16* zp = t > 0 ? zr - NZ : zr; const f16* zn = t < L - 1 ? zr + NZ : zr;
        const float fp = t > 0 ? 0.5f : 0.f, fn = t < L - 1 ? 0.5f : 0.f;
        float rk = 0.f;
#pragma unroll
        for (int e = 0; e < 4; ++e) { const int c = c0 + 4 * e;
            const f32x4 rz = ld_h4(zr + ZC_R + c), kz = ld_h4(zr + ZC_K + c);
            const f32x4 rs = ld_h4(zp + ZC_R + c) * fp + ld_h4(zn + ZC_R + c) * fn, ks = ld_h4(zp + ZC_K + c) * fp + ld_h4(zn + ZC_K + c) * fn;
            const f32x4 r4 = rz + (rs - rz) * *(const f32x4*)(in[10] + c), k4 = kz + (ks - kz) * *(const f32x4*)(in[10] + D + c), w4 = *(const f32x4*)(in[22] + c);
            rk += (r4.x * k4.x * w4.x + r4.y * k4.y * w4.y) + (r4.z * k4.z * w4.z + r4.w * k4.w * w4.w); }
        rk += __shfl_xor(rk, 1); rk += __shfl_xor(rk, 2);
        if (q == 0) RK[tt * 16 + head] = rk; }
#pragma unroll 1
    for (int g = 0; g < 4; ++g) {
        __syncthreads();
        for (int idx = tid; idx < (TT + 16) * 16; idx += NWAVES * 64) { const int rr = idx >> 4, c8 = (idx & 15) * 8, tl = rr - 8;
            v4u val = {0u, 0u, 0u, 0u};
            if (tl >= vlo && tl < vhi) val = *(const v4u*)(Z + (size_t)(m0t + tl) * NZ + ZC_POOL + g * 128 + c8);
            *(LAS v4u*)(ZP + rr * 128 + c8) = val; }
        __syncthreads();
        { const int win = 2 << g; const int tt = tid >> 4, c8 = (tid & 15) * 8;
          int lo = tt - win / 2, hi = tt + win - win / 2; lo = lo < vlo ? vlo : lo; hi = hi > vhi ? vhi : hi;
          float acc8[8];
#pragma unroll
          for (int e = 0; e < 8; ++e) acc8[e] = 0.f;
          for (int u = lo; u < hi; ++u) { const f16x8 zv = *(const LAS f16x8*)(ZP + (u + 8) * 128 + c8);
#pragma unroll
              for (int e = 0; e < 8; ++e) acc8[e] += (float)zv[e]; }
          const float inv = frcp((float)(hi - lo)); const f16x8 zc = *(const LAS f16x8*)(ZP + (tt + 8) * 128 + c8);
          unsigned o[4];
#pragma unroll
          for (int e = 0; e < 4; ++e) o[e] = pkbf(acc8[2 * e] * inv - (float)zc[2 * e], acc8[2 * e + 1] * inv - (float)zc[2 * e + 1]);
          *(LAS v4u*)(MX + tt * MXS + c8) = (v4u){o[0], o[1], o[2], o[3]}; }
        __syncthreads();
        const int ch0 = wave * 32;
        bf16x8 wP[4][2], wG[4][2];
#pragma unroll
        for (int ks = 0; ks < 4; ++ks)
#pragma unroll
            for (int ct = 0; ct < 2; ++ct) { const int chl = ch0 + ct * 16 + (lane & 15);
                wP[ks][ct] = *(const bf16x8*)(poolWT + ((size_t)g * 256 + chl) * 128 + ks * 32 + 8 * (lane >> 4));
                wG[ks][ct] = *(const bf16x8*)(gw2T + ((size_t)g * 256 + chl) * 128 + ks * 32 + 8 * (lane >> 4)); }
#pragma unroll 1
        for (int tk = 0; tk < TT / 16; ++tk) {
            f32x4 aP[2], aG[2];
            aP[0] = aP[1] = aG[0] = aG[1] = (f32x4){0.f, 0.f, 0.f, 0.f};
            const int tt = tk * 16 + (lane & 15), m = m0t + tt, t = m - ms;
#pragma unroll
            for (int ks = 0; ks < 4; ++ks) {
                const bf16x8 bm = *(const LAS bf16x8*)(MX + tt * MXS + ks * 32 + 8 * (lane >> 4));
                const bf16x8 bg = *(const LAS bf16x8*)(SG + tt * MXS + ks * 32 + 8 * (lane >> 4));
#pragma unroll
                for (int ct = 0; ct < 2; ++ct) { aP[ct] = __builtin_amdgcn_mfma_f32_16x16x32_bf16(wP[ks][ct], bm, aP[ct], 0, 0, 0);
                                                 aG[ct] = __builtin_amdgcn_mfma_f32_16x16x32_bf16(wG[ks][ct], bg, aG[ct], 0, 0, 0); }
            }
            const f16* zr = Z + (size_t)m * NZ; const f16* zp = t > 0 ? zr - NZ : zr; const f16* zn = t < L - 1 ? zr + NZ : zr;
            const float fp = t > 0 ? 0.5f : 0.f, fn = t < L - 1 ? 0.5f : 0.f;
#pragma unroll
            for (int ct = 0; ct < 2; ++ct) { const int c = g * 256 + ch0 + ct * 16 + 4 * (lane >> 4), head = c >> 6;
                const f32x4 lw = *(const f32x4*)(in[23] + c), lb = *(const f32x4*)(in[24] + c), muv = *(const f32x4*)(in[10] + 2 * D + c), psc = *(const f32x4*)(in[26] + c);
                const float rk = RK[tt * 16 + head];
                const f32x4 vz = ld_h4(zr + ZC_V + c), vs = ld_h4(zp + ZC_V + c) * fp + ld_h4(zn + ZC_V + c) * fn; const f32x4 v4 = vz + (vs - vz) * muv;
                const f32x4 ga = ld_h4(zr + ZC_GA + c), gb = ld_h4(zr + ZC_GB + c);
                const f32x4 gg = gb * aG[ct];
                const f32x4 p2 = ga * (aP[ct] * psc) + gg * (lb + v4 * rk), gl = gg * lw;
                v2u w; w.x = pkbf(p2.x, p2.y); w.y = pkbf(p2.z, p2.w); *(v2u*)(P2 + (size_t)m * D + c) = w;
                w.x = pkbf(gl.x, gl.y); w.y = pkbf(gl.z, gl.w); *(v2u*)(GBL + (size_t)m * D + c) = w; }
        }
    }
}
__device__ __forceinline__ void mixA_queue(Frame& F) {
    unsigned* head = (unsigned*)(F.ws + WS_CTL) + CW_TQ;
    volatile LAS unsigned* slot = (volatile LAS unsigned*)(F.lds + MISC_OFF) + 16;
    for (;;) {
        __syncthreads();
        if (F.tid == 0) *slot = __hip_atomic_fetch_add(head, 1u, __ATOMIC_RELAXED, __HIP_MEMORY_SCOPE_AGENT);
        __syncthreads();
        const unsigned tile = *slot;
        if (tile >= (unsigned)NMIXT) break;
        mixA_tile(F, (int)tile);
    }
}
__device__ __forceinline__ void p4_mixB(Frame& F) {
    const int gw = F.bid * NWAVES + F.wave, NGW = F.G * NWAVES;
    const bf16* Y0 = (const bf16*)F.out; const bf16* Y1 = Y0 + (size_t)M * D;
    const bf16* P2 = (const bf16*)(F.ws + WS_P2); const bf16* GBL = (const bf16*)(F.ws + WS_GBL);
    bf16* MIX = (bf16*)(F.ws + WS_H);
    for (int m = gw; m < M; m += NGW) { const size_t o = (size_t)m * D + F.lane * 16;
        float y[16], p[16], gl[16];
#pragma unroll
        for (int q = 0; q < 4; ++q) { const f32x4 a = ld_bf4(Y0 + o + 4 * q) + ld_bf4(Y1 + o + 4 * q), b = ld_bf4(P2 + o + 4 * q), c = ld_bf4(GBL + o + 4 * q);
#pragma unroll
            for (int e = 0; e < 4; ++e) { y[4 * q + e] = a[e]; p[4 * q + e] = b[e]; gl[4 * q + e] = c[e]; } }
        float s1 = 0.f;
#pragma unroll
        for (int e = 0; e < 16; ++e) s1 += y[e];
        s1 += __shfl_xor(s1, 1); s1 += __shfl_xor(s1, 2);
        const float mean = s1 * (1.0f / 64.0f); float s2 = 0.f;
#pragma unroll
        for (int e = 0; e < 16; ++e) { y[e] -= mean; s2 += y[e] * y[e]; }
        s2 += __shfl_xor(s2, 1); s2 += __shfl_xor(s2, 2);
        const float rstd = rsqrtf(s2 * (1.0f / 64.0f) + 64e-5f);
        unsigned w[8];
#pragma unroll
        for (int e = 0; e < 8; ++e) w[e] = pkbf(p[2 * e] + gl[2 * e] * (y[2 * e] * rstd), p[2 * e + 1] + gl[2 * e + 1] * (y[2 * e + 1] * rstd));
        *(v4u*)(MIX + o) = (v4u){w[0], w[1], w[2], w[3]}; *(v4u*)(MIX + o + 8) = (v4u){w[4], w[5], w[6], w[7]}; }
}

__device__ __forceinline__ void p8_final(Frame& F) {
    const int gw = F.bid * NWAVES + F.wave, NGW = F.G * NWAVES;
    const float* rss = (const float*)(F.ws + WS_RSS2); const float* gf = F.in[30];
    for (int m = gw; m < M; m += NGW) { const float rstd = rsqrtf(rss[m] * (1.0f / D) + 1e-6f); float* row = F.out + (size_t)m * D;
#pragma unroll
        for (int j = 0; j < 4; ++j) { const int c = 4 * (F.lane + 64 * j); const f32x4 x = *(const f32x4*)(row + c), g = *(const f32x4*)(gf + c); *(f32x4*)(row + c) = x * rstd * g; } }
}

__global__ void __launch_bounds__(NWAVES * 64, 2) fwd(Args args) {
    extern __shared__ __attribute__((aligned(16))) unsigned char lds_raw[];
    Frame F;
    F.lds = (LAS unsigned char*)lds_raw;
    F.tid = threadIdx.x; F.lane = F.tid & 63; F.wave = __builtin_amdgcn_readfirstlane(F.tid >> 6);
    F.G = gridDim.x; F.bid = blockIdx.x;
    F.in = args.in; F.out = args.out; F.ws = args.ws;
    volatile LAS unsigned* MISC = (volatile LAS unsigned*)(F.lds + MISC_OFF);
    if (F.tid < 32) MISC[F.tid] = 0u;
    __syncthreads();
    const int lo = args.ph_lo, hi = args.ph_hi;
    unsigned* ctl = (unsigned*)(F.ws + WS_CTL);
    XcdBarrier bar; bar.bar = ctl + CW_BAR; bar.x = 0; bar.st = nullptr;
    if (hi - lo > 1) bar = xcd_barrier_post(ctl + CW_BAR, MISC + 8);
#ifndef PH_MASK
#define PH_MASK 0x1ff
#endif
#ifndef REPEAT_MASK
#define REPEAT_MASK 0
#endif
#define REP(k) (((REPEAT_MASK >> (k)) & 1) ? 2 : 1)
#define IN(k) (((PH_MASK >> (k)) & 1) && lo <= (k) && (k) < hi)
#define BOTH(k) (IN(k) && IN((k) + 1))
#define GRID_BAR() xcd_barrier(bar)
    bf16* H = (bf16*)(F.ws + WS_H);
    float* mod = (float*)(F.ws + WS_MOD);
    if (IN(0)) { for (int rep = 0; rep < REP(0); ++rep) p0_prologue(F); if (BOTH(0)) GRID_BAR(); }
    if (IN(1)) { for (int rep = 0; rep < REP(1); ++rep) p1_hprep(F); if (BOTH(1)) GRID_BAR(); }
    if (IN(2)) {
        pg8::Gemm g{H, (const bf16*)(F.ws + WS_WCAT), M, NZ, D}; pg8::StaticOrder S; S.init(M, NZ, F.G, F.bid);
        EpiZ E{(f16*)(F.ws + WS_Z)};
        for (int rep = 0; rep < REP(2); ++rep) pg8::gemm_phase<EpiZ, pg8::StaticOrder, true, true>(F.lds, g, S, E);
        if (BOTH(2)) GRID_BAR();
    }
    if (IN(3)) { for (int rep = 0; rep < REP(3); ++rep) p3_scan2(F); mixA_queue(F); if (BOTH(3)) GRID_BAR(); }
    if (IN(4)) { for (int rep = 0; rep < REP(4); ++rep) p4_mixB(F); if (BOTH(4)) GRID_BAR(); }
    if (IN(5)) {
        pg8::Gemm g{H, (const bf16*)(F.ws + WS_WOUT), M, D, D}; pg8::StaticOrder S; S.init(M, D, F.G, F.bid);
        EpiOut1 E{args.in[0], args.in[1], F.out, (bf16*)(F.ws + WS_A2), mod, args.in[8], (float*)(F.ws + WS_RSS1)};
        pg8::gemm_phase<EpiOut1, pg8::StaticOrder, true, true>(F.lds, g, S, E);
        if (BOTH(5)) GRID_BAR();
    }
    if (IN(6)) {
        pg8::Gemm g{(const bf16*)(F.ws + WS_A2), (const bf16*)(F.ws + WS_WFF1), M, FF, D}; pg8::StaticOrder S; S.init(M, FF, F.G, F.bid);
        EpiFF1 E{(const float*)(F.ws + WS_RSS1), (const float*)(F.ws + WS_C1), (bf16*)(F.ws + WS_ACT)};
        for (int rep = 0; rep < REP(6); ++rep) pg8::gemm_phase<EpiFF1, pg8::StaticOrder, true, true>(F.lds, g, S, E);
        if (BOTH(6)) GRID_BAR();
    }
    if (IN(7)) {
        pg8::Gemm g{(const bf16*)(F.ws + WS_ACT), (const bf16*)(F.ws + WS_WFF2), M, D, FF}; pg8::StaticOrder S; S.init(M, D, F.G, F.bid);
        EpiOut2 E{F.out, mod, (float*)(F.ws + WS_RSS2)};
        pg8::gemm_phase<EpiOut2, pg8::StaticOrder, true, true>(F.lds, g, S, E);
        if (BOTH(7)) GRID_BAR();
    }
    if (IN(8)) { p8_final(F); }
#undef IN
#undef BOTH
#undef GRID_BAR
}

extern "C" void kernel_launch(void* const* d_in, const int* in_sizes, int n_in, void* d_out, int out_size, void* d_ws, size_t ws_size, hipStream_t stream) {
    static int grid = 0;
    if (grid == 0) {
        if (n_in != 31 || ws_size < WS_END) { fprintf(stderr, "kernel_launch: expected 31 inputs and >= %zu bytes of workspace; got %d, %zu\n", (size_t)WS_END, n_in, ws_size); grid = -1; return; }
        int dev = 0, cus = 0, per_cu = 0;
        if (hipGetDevice(&dev) != hipSuccess || hipDeviceGetAttribute(&cus, hipDeviceAttributeMultiprocessorCount, dev) != hipSuccess) { grid = -1; return; }
        if (hipFuncSetAttribute((const void*)fwd, hipFuncAttributeMaxDynamicSharedMemorySize, LDS_BYTES) != hipSuccess) { fprintf(stderr, "kernel_launch: hipFuncSetAttribute failed\n"); grid = -1; return; }
        if (hipOccupancyMaxActiveBlocksPerMultiprocessor(&per_cu, (const void*)fwd, NWAVES * 64, LDS_BYTES) != hipSuccess || per_cu < 1) { fprintf(stderr, "kernel_launch: occupancy query says %d workgroups per CU\n", per_cu); (void)hipGetLastError(); grid = -1; return; }
        grid = cus;
    }
    if (grid < 0) return;
    if (hipMemsetAsync((char*)d_ws + WS_CTL, 0, CTL_ZERO_BYTES, stream) != hipSuccess) return;
    Args a{};
    for (int i = 0; i < 31; ++i) a.in[i] = (const float*)d_in[i];
    a.out = (float*)d_out; a.ws = (unsigned char*)d_ws;
    if (MK_N_LAUNCHES == 1) {
        a.ph_lo = 0; a.ph_hi = NPHASE;
        void* kargs[] = {&a};
        hipError_t e = hipLaunchCooperativeKernel((const void*)fwd, dim3(grid), dim3(NWAVES * 64), kargs, LDS_BYTES, stream);
        if (e != hipSuccess) fprintf(stderr, "kernel_launch: cooperative launch failed: %s (grid %d)\n", hipGetErrorString(e), grid);
    } else {
        for (int p = 0; p < NPHASE; ++p) { a.ph_lo = p; a.ph_hi = p + 1; hipLaunchKernelGGL(fwd, dim3(grid), dim3(NWAVES * 64), LDS_BYTES, stream, a); }
    }
}
```

```cpp
#include <hip/hip_runtime.h>
#include <cstdio>
#include <cstdint>
namespace pg8 {
#define PG8_LAS __attribute__((address_space(3)))
typedef unsigned short bf16_t;
typedef short bf16x8 __attribute__((ext_vector_type(8)));
typedef float f32x4 __attribute__((ext_vector_type(4)));
typedef unsigned u32x4 __attribute__((ext_vector_type(4)));
constexpr int BM = 256, BK = 64, HALF = 128, HTB = HALF * BK * 2  , STAGE_BYTES = 8 * HTB, NXCD = 8, WGM = 8;

__host__ __device__ __forceinline__ int lds_byte(int r, int c) { const int st = (r >> 4) * 2 + (c >> 5), rr = r & 15, cc = c & 31, ob = rr * 64 + cc * 2; return st * 1024 + (ob ^ (((ob >> 9) & 1) << 5)); }
__host__ __device__ __forceinline__ void stage_rc(int b, int& R, int& C) { const int st = b / 1024, sb = b % 1024, swz = sb ^ (((sb >> 9) & 1) << 5); R = (st >> 1) * 16 + swz / 64; C = (st & 1) * 32 + (swz % 64) / 2; }
__host__ __device__ __forceinline__ int perm32(int rho) { const int n = rho >> 4, i = rho & 15; return 8 * (i >> 2) + 4 * n + (i & 3); }

struct Unit { int pm, pn; };
struct Gemm { const bf16_t* A; const bf16_t* Bt; int M, N, K; };

struct StaticOrder {
    int nM, nN, nwg, G, c;
    __host__ __device__ void init(int M, int N, int G_, int c_) { nM = M / BM; nN = N / BM; nwg = nM * nN; G = G_; c = c_; }
    __host__ __device__ bool next(int i, Unit& u) const {
        const long L = (long)i * G + c; if (L >= nwg) return false;
        int wgid = (int)L; { const int q = nwg / NXCD, r = nwg % NXCD, xcd = wgid % NXCD, off = wgid / NXCD; wgid = (xcd < r ? xcd * (q + 1) : r * (q + 1) + (xcd - r) * q) + off; }
        const int nig = WGM * nN, gid = wgid / nig, fm = gid * WGM, gsz = (nM - fm) < WGM ? (nM - fm) : WGM;
        u.pm = fm + ((wgid % nig) % gsz); u.pn = (wgid % nig) / gsz; return true;
    }
    __device__ __forceinline__ void a_ready(const Unit&) const {}
    __device__ __forceinline__ void done(const Unit&) const {}
};

__device__ __forceinline__ unsigned cvt_pk_bf16(float lo, float hi) { unsigned r; asm volatile("v_cvt_pk_bf16_f32 %0, %1, %2" : "=v"(r) : "v"(lo), "v"(hi)); return r; }
typedef float f32x2 __attribute__((ext_vector_type(2)));
template <class Epi, class Sched, bool ALIGN_EPI = false, bool SP2 = false>
__device__ __forceinline__ void gemm_phase(PG8_LAS unsigned char* lds, const Gemm g, const Sched& S, const Epi& E) {
    const int tid = threadIdx.x, wid = __builtin_amdgcn_readfirstlane(tid >> 6), lane = tid & 63, wr = wid >> 2, wc = wid & 3, fr = lane & 15, fq = lane >> 4;
    const int K = g.K, nt = K / BK;
    unsigned voffA[2], voffB[2];
#pragma unroll
    for (int i = 0; i < 2; ++i) { int R, C; stage_rc(tid * 16 + i * 8192, R, C); const int Rb = Epi::PERM ? ((R & ~31) + perm32(R & 31)) : R;
        voffA[i] = (unsigned)(R * K + C) * 2u; voffB[i] = (unsigned)(Rb * K + C) * 2u; }
    const size_t kstep = (size_t)(BK * 2);
    const size_t hstep = (size_t)HALF * K * 2;
    const size_t tstep = 2 * hstep;
    const unsigned ldsw = (unsigned)wid * 1024u;
    const int aoff = lds_byte(wr * 64 + fr, fq * 8), boff = lds_byte(wc * 32 + fr, fq * 8);
#define PG8_SA(b, h) (((b) * 2 + (h)) * HTB)
#define PG8_SB(b, h) ((4 + (b) * 2 + (h)) * HTB)
#define PG8_STAGE(bufoff, gbase, voff) do { _Pragma("unroll") for (int _i = 0; _i < 2; ++_i) \
        __builtin_amdgcn_global_load_lds((const unsigned*)((const char*)(gbase) + (voff)[_i]), (PG8_LAS unsigned*)(lds + (bufoff) + ldsw + _i * 8192), 16, 0, 0); } while (0)
#define PG8_LDA(dst, b, h) do { _Pragma("unroll") for (int m = 0; m < 4; ++m) _Pragma("unroll") for (int k = 0; k < 2; ++k) dst[m][k] = *(const PG8_LAS bf16x8*)(lds + PG8_SA(b, h) + aoff + m * 2048 + k * 1024); } while (0)
#define PG8_LDB(dst, b, h) do { _Pragma("unroll") for (int n = 0; n < 2; ++n) _Pragma("unroll") for (int k = 0; k < 2; ++k) dst[n][k] = *(const PG8_LAS bf16x8*)(lds + PG8_SB(b, h) + boff + n * 2048 + k * 1024); } while (0)
#define PG8_MMA(ai, bj, At, Bt) do { __builtin_amdgcn_s_setprio(1); _Pragma("unroll") for (int m = 0; m < 4; ++m) _Pragma("unroll") for (int n = 0; n < 2; ++n) _Pragma("unroll") for (int k = 0; k < 2; ++k) \
        acc[ai][bj][m][n] = __builtin_amdgcn_mfma_f32_16x16x32_bf16(Bt[n][k], At[m][k], acc[ai][bj][m][n], 0, 0, 0); __builtin_amdgcn_s_setprio(0); } while (0)
#define PG8_WAIT_V(n) asm volatile("s_waitcnt vmcnt(" #n ")" ::: "memory")
#define PG8_WAIT_L(n) asm volatile("s_waitcnt lgkmcnt(" #n ")" ::: "memory")
#define PG8_BAR __builtin_amdgcn_s_barrier()
#define PG8_SCHED __builtin_amdgcn_sched_barrier(0)
    Unit cur, nxt; int ui = 0;
    if (!S.next(0, cur)) return;
    f32x4 acc[2][2][4][2];
#pragma unroll
    for (int a = 0; a < 2; ++a)
#pragma unroll
        for (int b = 0; b < 2; ++b)
#pragma unroll
            for (int m = 0; m < 4; ++m)
#pragma unroll
                for (int n = 0; n < 2; ++n) acc[a][b][m][n] = (f32x4){0.f, 0.f, 0.f, 0.f};
    bf16x8 At[4][2], B0[2][2], B1[2][2];
    const char* cA = (const char*)g.A + (size_t)cur.pm * tstep; const char* cB = (const char*)g.Bt + (size_t)cur.pn * tstep;
    S.a_ready(cur);
    if constexpr (SP2) {
        PG8_STAGE(PG8_SB(0, 0), cB, voffB); PG8_STAGE(PG8_SB(0, 1), cB + hstep, voffB); PG8_STAGE(PG8_SA(0, 0), cA, voffA); PG8_STAGE(PG8_SA(0, 1), cA + hstep, voffA);
        if (wr == 1) PG8_BAR;
        PG8_WAIT_V(2); PG8_BAR;
        PG8_STAGE(PG8_SB(1, 0), cB + kstep, voffB); PG8_STAGE(PG8_SA(1, 0), cA + kstep, voffA); PG8_STAGE(PG8_SB(1, 1), cB + hstep + kstep, voffB);
        PG8_WAIT_V(6); PG8_BAR;
    } else {
        PG8_STAGE(PG8_SB(0, 0), cB, voffB); PG8_STAGE(PG8_SA(0, 0), cA, voffA); PG8_STAGE(PG8_SB(0, 1), cB + hstep, voffB); PG8_STAGE(PG8_SA(0, 1), cA + hstep, voffA);
        if (wr == 1) PG8_BAR;
        PG8_WAIT_V(4); PG8_BAR;
        PG8_STAGE(PG8_SB(1, 0), cB + kstep, voffB); PG8_STAGE(PG8_SA(1, 0), cA + kstep, voffA); PG8_STAGE(PG8_SB(1, 1), cB + hstep + kstep, voffB);
        PG8_WAIT_V(6); PG8_BAR;
    }
    for (;;) {
        const bool has_next = S.next(ui + 1, nxt);
        const char* nA = has_next ? (const char*)g.A + (size_t)nxt.pm * tstep : cA; const char* nB = has_next ? (const char*)g.Bt + (size_t)nxt.pn * tstep : cB;
        for (int t = 0; t < nt; t += 2) {
            const bool last = (t == nt - 2);
            const char* a1 = cA + (size_t)(t + 1) * kstep;
            const char* a2 = last ? nA : cA + (size_t)(t + 2) * kstep; const char* b2 = last ? nB : cB + (size_t)(t + 2) * kstep;
            const char* a3 = a2 + kstep; const char* b3 = b2 + kstep;
            if (last && has_next) S.a_ready(nxt);
            if constexpr (SP2) {
            PG8_LDB(B0, 0, 0); PG8_LDB(B1, 0, 1); PG8_SCHED; PG8_LDA(At, 0, 0); PG8_STAGE(PG8_SA(1, 1), a1 + hstep, voffA);
            PG8_WAIT_V(8); PG8_WAIT_L(0); PG8_BAR; PG8_MMA(0, 0, At, B0); PG8_MMA(0, 1, At, B1); PG8_BAR; PG8_SCHED;
            PG8_LDA(At, 0, 1); PG8_STAGE(PG8_SB(0, 0), b2, voffB); PG8_STAGE(PG8_SB(0, 1), b2 + hstep, voffB); PG8_STAGE(PG8_SA(0, 0), a2, voffA);
            PG8_WAIT_V(8); PG8_WAIT_L(0); PG8_BAR; PG8_MMA(1, 0, At, B0); PG8_MMA(1, 1, At, B1); PG8_BAR; PG8_SCHED;
            PG8_LDB(B0, 1, 0); PG8_LDB(B1, 1, 1); PG8_SCHED; PG8_LDA(At, 1, 0); PG8_STAGE(PG8_SA(0, 1), a2 + hstep, voffA);
            PG8_WAIT_V(8); PG8_WAIT_L(0); PG8_BAR; PG8_MMA(0, 0, At, B0); PG8_MMA(0, 1, At, B1); PG8_BAR; PG8_SCHED;
            PG8_LDA(At, 1, 1); PG8_STAGE(PG8_SB(1, 0), b3, voffB); PG8_STAGE(PG8_SB(1, 1), b3 + hstep, voffB); PG8_STAGE(PG8_SA(1, 0), a3, voffA);
            PG8_WAIT_V(8); PG8_WAIT_L(0); PG8_BAR; PG8_MMA(1, 0, At, B0); PG8_MMA(1, 1, At, B1); PG8_BAR; PG8_SCHED;
            } else {
            PG8_LDB(B0, 0, 0); PG8_SCHED; PG8_LDA(At, 0, 0); PG8_STAGE(PG8_SA(1, 1), a1 + hstep, voffA);
            PG8_WAIT_L(8); PG8_BAR; PG8_WAIT_L(0); PG8_MMA(0, 0, At, B0); PG8_BAR; PG8_SCHED;
            PG8_LDB(B1, 0, 1); PG8_STAGE(PG8_SB(0, 0), b2, voffB);
            PG8_BAR; PG8_WAIT_L(0); PG8_MMA(0, 1, At, B1); PG8_BAR;
            PG8_LDA(At, 0, 1); PG8_STAGE(PG8_SA(0, 0), a2, voffA);
            PG8_BAR; PG8_WAIT_L(0); PG8_MMA(1, 0, At, B0); PG8_BAR; PG8_SCHED;
            PG8_STAGE(PG8_SB(0, 1), b2 + hstep, voffB);
            PG8_WAIT_V(6); PG8_BAR; PG8_MMA(1, 1, At, B1); PG8_BAR;
            PG8_LDB(B0, 1, 0); PG8_SCHED; PG8_LDA(At, 1, 0); PG8_STAGE(PG8_SA(0, 1), a2 + hstep, voffA);
            PG8_WAIT_L(8); PG8_BAR; PG8_WAIT_L(0); PG8_MMA(0, 0, At, B0); PG8_BAR; PG8_SCHED;
            PG8_LDB(B1, 1, 1); PG8_STAGE(PG8_SB(1, 0), b3, voffB);
            PG8_BAR; PG8_WAIT_L(0); PG8_MMA(0, 1, At, B1); PG8_BAR;
            PG8_LDA(At, 1, 1); PG8_STAGE(PG8_SA(1, 0), a3, voffA);
            PG8_BAR; PG8_WAIT_L(0); PG8_MMA(1, 0, At, B0); PG8_BAR; PG8_SCHED;
            PG8_STAGE(PG8_SB(1, 1), b3 + hstep, voffB);
            PG8_WAIT_V(6); PG8_BAR; PG8_MMA(1, 1, At, B1); PG8_BAR;
            }
        }
        if constexpr (ALIGN_EPI) { if (wr == 0) PG8_BAR; }
        if constexpr (!Epi::AFTER_DRAIN) { E(acc, cur, wr, wc, fr, fq); S.done(cur); }
        if (!has_next) break;
#pragma unroll
        for (int a = 0; a < 2; ++a)
#pragma unroll
            for (int b = 0; b < 2; ++b)
#pragma unroll
                for (int m = 0; m < 4; ++m)
#pragma unroll
                    for (int n = 0; n < 2; ++n) acc[a][b][m][n] = (f32x4){0.f, 0.f, 0.f, 0.f};
        cur = nxt; cA = nA; cB = nB; ++ui;
        if constexpr (ALIGN_EPI) { if (wr == 1) PG8_BAR; }
    }
    PG8_WAIT_V(0);
    if constexpr (!ALIGN_EPI) { if (wr == 0) PG8_BAR; }
    PG8_BAR;
    if constexpr (Epi::AFTER_DRAIN) { E.fused(acc, cur, wr, wc, fr, fq, lds, wid, lane); S.done(cur); }
#undef PG8_SA
#undef PG8_SB
#undef PG8_STAGE
#undef PG8_LDA
#undef PG8_LDB
#undef PG8_MMA
#undef PG8_WAIT_V
#undef PG8_WAIT_L
#undef PG8_BAR
#undef PG8_SCHED
}
}

#ifndef MK_N_LAUNCHES
#define MK_N_LAUNCHES 1
#endif
constexpr int NWAVES = 8;
constexpr int D = 1024, NH = 16, HD = 64, FF = 4096;
constexpr int M_CTX = 16 * 256, M_LAT = 4 * 2048, M = M_CTX + M_LAT;
constexpr int L_CTX = 256, L_LAT = 2048;
constexpr int NMOD = 6 * D;
constexpr int ZC_POOL = 0, ZC_R = 512, ZC_K = 1536, ZC_V = 2560, ZC_GA = 3584, ZC_GB = 4608;
constexpr int ZC_LW_A = 5632, ZC_LW_B = 5760, ZC_LA_A = 5888, ZC_LA_B = 6016, ZC_LG_A = 6144, ZC_LG_B = 6272, NZ = 6400;
constexpr int NPHASE = 9;

constexpr size_t MiB = 1u << 20;
constexpr size_t WS_CTL = 0, CTL_ZERO_BYTES = 1 * MiB;
constexpr int CW_BAR = 4096;
constexpr size_t WS_RSS1 = 256 * 1024, WS_RSS2 = 320 * 1024;
constexpr size_t WS_MOD = 1 * MiB, WS_C1 = 1 * MiB + 128 * 1024;
constexpr size_t WS_WCAT = 2 * MiB, WS_WOUT = 15 * MiB, WS_WFF1 = 17 * MiB, WS_WFF2 = 25 * MiB;
constexpr size_t WS_POOLW = 33 * MiB, WS_GW2T = 33 * MiB + 256 * 1024;
constexpr size_t WS_H = 34 * MiB;
constexpr size_t WS_Z = 58 * MiB;
constexpr size_t WS_ACT = 58 * MiB;
constexpr size_t WS_A2 = 154 * MiB;
constexpr size_t WS_END = 256 * MiB;
static_assert(WS_WCAT + (size_t)NZ * D * 2 <= WS_WOUT && WS_Z + (size_t)M * NZ * 2 <= WS_END && WS_ACT + (size_t)M * FF * 2 <= WS_A2 && WS_A2 + (size_t)M * D * 2 <= WS_END, "ws map");

constexpr int LDS_BYTES = 147456;
constexpr int RING_BYTES = 131072, MISC_OFF = 147200;

#define GAS __attribute__((address_space(1)))
#define LAS __attribute__((address_space(3)))
typedef unsigned short bf16;
typedef _Float16 f16;
typedef unsigned v4u __attribute__((ext_vector_type(4)));
typedef unsigned v2u __attribute__((ext_vector_type(2)));
typedef float f32x4 __attribute__((ext_vector_type(4)));
typedef float f32x2 __attribute__((ext_vector_type(2)));
typedef short bf16x8 __attribute__((ext_vector_type(8)));
typedef _Float16 f16x4 __attribute__((ext_vector_type(4)));
typedef _Float16 f16x8 __attribute__((ext_vector_type(8)));
typedef _Float16 f16x2 __attribute__((ext_vector_type(2)));
typedef GAS unsigned gu32;
#define RLX_AGENT __ATOMIC_RELAXED, __HIP_MEMORY_SCOPE_AGENT
#define LDS_WAIT() asm volatile("s_waitcnt lgkmcnt(0)" ::: "memory")
#define VM_WAIT() asm volatile("s_waitcnt vmcnt(0)" ::: "memory")

typedef __bf16 bf16x2_t __attribute__((ext_vector_type(2)));
__device__ __forceinline__ unsigned pkbf(float lo, float hi) { f32x2 v = {lo, hi}; bf16x2_t b = __builtin_convertvector(v, bf16x2_t); return __builtin_bit_cast(unsigned, b); }
__device__ __forceinline__ unsigned pkh(float lo, float hi) { f16x2 v = {(f16)lo, (f16)hi}; return __builtin_bit_cast(unsigned, v); }
__device__ __forceinline__ float bf2f(unsigned short b) { return __builtin_bit_cast(float, (unsigned)b << 16); }
__device__ __forceinline__ f32x4 ld_h4(const f16* p) { const f16x4 v = *(const f16x4*)p; return __builtin_convertvector(v, f32x4); }
__device__ __forceinline__ f32x4 ld_bf4(const bf16* p) { const v2u v = *(const v2u*)p; f32x4 r; r.x = __builtin_bit_cast(float, v.x << 16); r.y = __builtin_bit_cast(float, v.x & 0xffff0000u);
    r.z = __builtin_bit_cast(float, v.y << 16); r.w = __builtin_bit_cast(float, v.y & 0xffff0000u); return r; }
__device__ __forceinline__ float frcp(float x) { return __builtin_amdgcn_rcpf(x); }
__device__ __forceinline__ float sigmoidf_(float x) { return frcp(1.0f + __expf(-x)); }
__device__ __forceinline__ float wave_sum(float v) {
#pragma unroll
    for (int o = 1; o < 64; o <<= 1) v += __shfl_xor(v, o);
    return v;
}
__device__ __forceinline__ int cvec_of_row(int m) { return m < M_CTX ? 0 : 1 + (m - M_CTX) / L_LAT; }

#define XB_TMO      128
#define XB_XCNT(j)  (256  + 64 * (j))
#define XB_XSUB(j)  (1280 + 64 * (j))
#define XB_XGEN(j)  (2304 + 64 * (j))
#define XB_TOP      3328
#define XB_TOPGEN   3392
#define XCD_BAR_WORDS 3456
#define XB_SPIN_CAP (1u << 18)
__device__ __forceinline__ unsigned xb_ld(unsigned* p)              { return __hip_atomic_load(p, __ATOMIC_RELAXED, __HIP_MEMORY_SCOPE_AGENT); }
__device__ __forceinline__ unsigned xb_add(unsigned* p, unsigned v) { return __hip_atomic_fetch_add(p, v, __ATOMIC_RELAXED, __HIP_MEMORY_SCOPE_AGENT); }
__device__ __forceinline__ unsigned xb_xcc_id() { return (unsigned)__builtin_amdgcn_s_getreg((3 << 11) | 20) & 0xFu; }
#define XB_SPIN(cond, bar) do { unsigned _sp = 0; while (cond) { __builtin_amdgcn_s_sleep(1); \
    if ((++_sp & 255u) == 0u) { if (xb_ld(&(bar)[XB_TMO])) break; if (_sp > XB_SPIN_CAP) { atomicAdd(&(bar)[XB_TMO], 1u); break; } } } } while (0)
struct XcdBarrier { unsigned* bar; unsigned x; volatile LAS unsigned* st; };
__device__ __forceinline__ XcdBarrier xcd_barrier_post(unsigned* bar, volatile LAS unsigned* st) {
    XcdBarrier b; b.bar = bar; b.x = xb_xcc_id(); b.st = st;
    if (threadIdx.x == 0) (void)xb_add(&bar[XB_XCNT(b.x)], 1u);
    return b;
}
__device__ __forceinline__ void xcd_barrier_complete(unsigned* bar, unsigned x, unsigned& nloc, unsigned& nx) {
    const unsigned G = gridDim.x * gridDim.y * gridDim.z;
    unsigned sum, cnt, mine, sp = 0u;
    for (;;) {
        sum = 0u; cnt = 0u; mine = 0u;
#pragma unroll
        for (unsigned j = 0; j < 16; ++j) { const unsigned c = xb_ld(&bar[XB_XCNT(j)]); sum += c; cnt += (c > 0u) ? 1u : 0u; mine = (j == x) ? c : mine; }
        if (sum == G) break;
        __builtin_amdgcn_s_sleep(1);
        if ((++sp & 255u) == 0u) { if (xb_ld(&bar[XB_TMO])) break; if (sp > XB_SPIN_CAP) { atomicAdd(&bar[XB_TMO], 1u); break; } }
    }
    nloc = mine > 0u ? mine : 1u; nx = cnt > 0u ? cnt : 1u;
}
__device__ __forceinline__ void xcd_barrier(const XcdBarrier& b) {
    asm volatile("s_waitcnt vmcnt(0)" ::: "memory");
    __syncthreads();
    if (threadIdx.x == 0) {
        unsigned* bar = b.bar;
        __builtin_amdgcn_s_waitcnt(0);
        unsigned nloc = b.st[0], nx = b.st[1];
        if (nloc == 0u) { xcd_barrier_complete(bar, b.x, nloc, nx); b.st[0] = nloc; b.st[1] = nx; }
        const unsigned old = xb_add(&bar[XB_XSUB(b.x)], 1u);
        const unsigned gen = old / nloc;
        if (old + 1u == (gen + 1u) * nloc) {
            __builtin_amdgcn_fence(__ATOMIC_RELEASE, "agent");
            asm volatile("s_waitcnt vmcnt(0)" ::: "memory");
            const unsigned og = xb_add(&bar[XB_TOP], 1u);
            const unsigned tg = og / nx;
            if (og + 1u == (tg + 1u) * nx) xb_add(&bar[XB_TOPGEN], 1u);
            else XB_SPIN(xb_ld(&bar[XB_TOPGEN]) == tg, bar);
            __builtin_amdgcn_fence(__ATOMIC_ACQUIRE, "agent");
            xb_add(&bar[XB_XGEN(b.x)], 1u);
            asm volatile("s_waitcnt vmcnt(0)" ::: "memory");
        } else {
            XB_SPIN(xb_ld(&bar[XB_XGEN(b.x)]) == gen, bar);
            __builtin_amdgcn_fence(__ATOMIC_ACQUIRE, "agent");
            asm volatile("s_waitcnt vmcnt(0)" ::: "memory");
        }
    }
    __syncthreads();
}

struct EpiZ {
    static constexpr bool PERM = true, AFTER_DRAIN = false;
    f16* Z;
    __device__ __forceinline__ void operator()(const f32x4 (&acc)[2][2][4][2], const pg8::Unit& u, int wr, int wc, int fr, int fq) const {
        const int row0 = u.pm * 256 + wr * 64 + fr, col0 = u.pn * 256 + wc * 32 + 8 * fq;
        const bool sig = (u.pn >= ZC_GA / 256) && (u.pn < ZC_LW_A / 256);
#pragma unroll
        for (int ai = 0; ai < 2; ++ai)
#pragma unroll
            for (int m = 0; m < 4; ++m) { f16* rowp = Z + (size_t)(row0 + ai * 128 + m * 16) * NZ + col0;
#pragma unroll
                for (int bj = 0; bj < 2; ++bj) { f32x4 v0 = acc[ai][bj][m][0], v1 = acc[ai][bj][m][1];
                    if (sig) {
#pragma unroll
                        for (int e = 0; e < 4; ++e) { v0[e] = sigmoidf_(v0[e]); v1[e] = sigmoidf_(v1[e]); } }
                    v4u w; w.x = pkh(v0[0], v0[1]); w.y = pkh(v0[2], v0[3]); w.z = pkh(v1[0], v1[1]); w.w = pkh(v1[2], v1[3]);
                    *(v4u*)(rowp + bj * 128) = w; } }
    }
};
struct EpiOut1 {
    static constexpr bool PERM = false, AFTER_DRAIN = false;
    const float* xp; const float* xs; float* X1; bf16* A2; const float* mod; const float* g2; float* rowss;
    __device__ __forceinline__ void operator()(const f32x4 (&acc)[2][2][4][2], const pg8::Unit& u, int wr, int wc, int fr, int fq) const {
        const int ci = cvec_of_row(u.pm * 256);
        const float* xb = (u.pm < M_CTX / 256) ? xp + (size_t)u.pm * 256 * D : xs + (size_t)(u.pm - M_CTX / 256) * 256 * D;
        const int col0 = u.pn * 256 + wc * 32 + 4 * fq;
#pragma unroll
        for (int ai = 0; ai < 2; ++ai)
#pragma unroll
            for (int m = 0; m < 4; ++m) { const int rl = ai * 128 + wr * 64 + m * 16 + fr; const size_t r = (size_t)u.pm * 256 + rl; float ss = 0.f;
#pragma unroll
                for (int bj = 0; bj < 2; ++bj)
#pragma unroll
                    for (int n = 0; n < 2; ++n) { const int c = col0 + bj * 128 + n * 16;
                        const f32x4 ga = *(const f32x4*)(mod + ci * NMOD + 2 * D + c);
                        const f32x4 gm = *(const f32x4*)(g2 + c) * (*(const f32x4*)(mod + ci * NMOD + 4 * D + c) + 1.0f);
                        const f32x4 x = *(const f32x4*)(xb + (size_t)rl * D + c); const f32x4 x1 = x + ga * acc[ai][bj][m][n];
                        *(f32x4*)(X1 + r * D + c) = x1; ss += (x1[0] * x1[0] + x1[1] * x1[1]) + (x1[2] * x1[2] + x1[3] * x1[3]);
                        const f32x4 a = x1 * gm; v2u w; w.x = pkbf(a[0], a[1]); w.y = pkbf(a[2], a[3]); *(v2u*)(A2 + r * D + c) = w; }
                asm volatile("" ::: "memory");
                ss += __shfl_xor(ss, 16); ss += __shfl_xor(ss, 32);
                if (fq == 0) atomicAdd(rowss + r, ss); }
    }
};
struct EpiFF1 {
    static constexpr bool PERM = true, AFTER_DRAIN = false;
    const float* rowss; const float* c1; bf16* ACT;
    __device__ __forceinline__ void operator()(const f32x4 (&acc)[2][2][4][2], const pg8::Unit& u, int wr, int wc, int fr, int fq) const {
        const int ci = cvec_of_row(u.pm * 256);
        const int row0 = u.pm * 256 + wr * 64 + fr, col0 = u.pn * 256 + wc * 32 + 8 * fq;
        f32x4 cb[2][2];
#pragma unroll
        for (int bj = 0; bj < 2; ++bj)
#pragma unroll
            for (int n = 0; n < 2; ++n) cb[bj][n] = *(const f32x4*)(c1 + ci * FF + col0 + bj * 128 + 4 * n);
#pragma unroll
        for (int ai = 0; ai < 2; ++ai)
#pragma unroll
            for (int m = 0; m < 4; ++m) { const int r = row0 + ai * 128 + m * 16; const float rstd = rsqrtf(rowss[r] * (1.0f / D) + 1e-6f);
                bf16* rowp = ACT + (size_t)r * FF + col0;
#pragma unroll
                for (int bj = 0; bj < 2; ++bj) { f32x4 v0 = acc[ai][bj][m][0] * rstd + cb[bj][0], v1 = acc[ai][bj][m][1] * rstd + cb[bj][1];
#pragma unroll
                    for (int e = 0; e < 4; ++e) { const float a = fmaxf(v0[e], 0.f), b = fmaxf(v1[e], 0.f); v0[e] = a * a; v1[e] = b * b; }
                    v4u w; w.x = pkbf(v0[0], v0[1]); w.y = pkbf(v0[2], v0[3]); w.z = pkbf(v1[0], v1[1]); w.w = pkbf(v1[2], v1[3]);
                    *(v4u*)(rowp + bj * 128) = w; } }
    }
};
struct EpiOut2 {
    static constexpr bool PERM = false, AFTER_DRAIN = false;
    float* X; const float* mod; float* rowss;
    __device__ __forceinline__ void operator()(const f32x4 (&acc)[2][2][4][2], const pg8::Unit& u, int wr, int wc, int fr, int fq) const {
        const int ci = cvec_of_row(u.pm * 256);
        const int col0 = u.pn * 256 + wc * 32 + 4 * fq;
        f32x4 ga[2][2];
#pragma unroll
        for (int bj = 0; bj < 2; ++bj)
#pragma unroll
            for (int n = 0; n < 2; ++n) ga[bj][n] = *(const f32x4*)(mod + ci * NMOD + 5 * D + col0 + bj * 128 + n * 16);
#pragma unroll
        for (int ai = 0; ai < 2; ++ai)
#pragma unroll
            for (int m = 0; m < 4; ++m) { const size_t r = (size_t)u.pm * 256 + ai * 128 + wr * 64 + m * 16 + fr; float ss = 0.f;
#pragma unroll
                for (int bj = 0; bj < 2; ++bj)
#pragma unroll
                    for (int n = 0; n < 2; ++n) { const int c = col0 + bj * 128 + n * 16;
                        const f32x4 x = *(const f32x4*)(X + r * D + c); const f32x4 x2 = x + ga[bj][n] * acc[ai][bj][m][n];
                        *(f32x4*)(X + r * D + c) = x2; ss += (x2[0] * x2[0] + x2[1] * x2[1]) + (x2[2] * x2[2] + x2[3] * x2[3]); }
                ss += __shfl_xor(ss, 16); ss += __shfl_xor(ss, 32);
                if (fq == 0) atomicAdd(rowss + r, ss); }
    }
};

struct Args { const float* in[31]; float* out; unsigned char* ws; int ph_lo, ph_hi; };
struct Frame {
    LAS unsigned char* lds;
    int tid, lane, wave, G, bid;
    const float* const* in;
    float* out; unsigned char* ws;
};

__device__ __forceinline__ void tr_item(const float* W, int ldw, const float* mu, int mode, bf16* WT, int ldk, LAS float* scr, int kb, int nb, int lane) {
    const int k0 = 64 * kb, n0 = 32 * nb;
#pragma unroll 8
    for (int i = 0; i < 32; ++i) { const int kk = 2 * i + (lane >> 5); float v = W[(size_t)(k0 + kk) * ldw + n0 + (lane & 31)];
        if (mode) { const float mm = mu[k0 + kk]; v *= (mode == 1) ? (1.0f - mm) : mm; }
        scr[kk * 33 + (lane & 31)] = v; }
    LDS_WAIT(); asm volatile("" ::: "memory");
    const int c = lane & 7;
#pragma unroll
    for (int j = 0; j < 4; ++j) { const int n = (lane >> 3) + 8 * j; const LAS float* s = scr + (8 * c) * 33 + n;
        v4u o; o.x = pkbf(s[0 * 33], s[1 * 33]); o.y = pkbf(s[2 * 33], s[3 * 33]); o.z = pkbf(s[4 * 33], s[5 * 33]); o.w = pkbf(s[6 * 33], s[7 * 33]);
        *(GAS v4u*)(WT + (size_t)(n0 + n) * ldk + k0 + 8 * c) = o; }
    LDS_WAIT(); asm volatile("" ::: "memory");
}
__device__ __forceinline__ void p0_prologue(Frame& F) {
    const float* const* in = F.in;
    {
        LAS float* sl = (LAS float*)(F.lds + 98304);
        LAS float* red = (LAS float*)(F.lds + 98304 + 20480);
        if (F.bid < 192 || F.G < 192) {
            for (int i = F.tid; i < 5 * D; i += NWAVES * 64) { const int ci = i >> 10, k = i & 1023; const float x = ci == 0 ? in[4][k] : in[3][(ci - 1) * D + k]; sl[i] = x * frcp(1.0f + __expf(-x)); }
            __syncthreads();
            float* mod = (float*)(F.ws + WS_MOD);
            for (int item = F.bid; item < 192; item += F.G) {
                const int col = F.tid & 31, ks = F.tid >> 5, n = item * 32 + col;
                float a0 = 0.f, a1 = 0.f, a2 = 0.f, a3 = 0.f, a4 = 0.f;
                const float* wp = in[5] + (size_t)(ks * 64) * NMOD + n;
#pragma unroll 8
                for (int k = 0; k < 64; ++k) { const float w = wp[(size_t)k * NMOD]; const int kk = ks * 64 + k;
                    a0 += sl[kk] * w; a1 += sl[1024 + kk] * w; a2 += sl[2048 + kk] * w; a3 += sl[3072 + kk] * w; a4 += sl[4096 + kk] * w; }
                LAS float* rp = red + (ks * 32 + col) * 5; rp[0] = a0; rp[1] = a1; rp[2] = a2; rp[3] = a3; rp[4] = a4;
                __syncthreads();
                if (F.tid < 160) { const int ci = F.tid >> 5, cc = F.tid & 31; float s = in[6][item * 32 + cc];
#pragma unroll
                    for (int q = 0; q < 16; ++q) s += red[(q * 32 + cc) * 5 + ci];
                    mod[ci * NMOD + item * 32 + cc] = s; }
                __syncthreads();
            }
        }
    }
    LAS float* scr = (LAS float*)(F.lds + F.wave * 12288);
    const int gw = F.bid * NWAVES + F.wave, NGW = F.G * NWAVES;
    bf16* WcatT = (bf16*)(F.ws + WS_WCAT); bf16* WoutT = (bf16*)(F.ws + WS_WOUT); bf16* Wff1T = (bf16*)(F.ws + WS_WFF1); bf16* Wff2T = (bf16*)(F.ws + WS_WFF2);
    bf16* poolWT = (bf16*)(F.ws + WS_POOLW); bf16* gw2T = (bf16*)(F.ws + WS_GW2T);
    constexpr int I_IN = 16 * 176, I_LORA = 6 * 64, I_OUT = 16 * 32, I_F1 = 16 * 128, I_F2 = 64 * 32, I_POOL = 4 * 16, I_G2 = 2 * 32;
    constexpr int NITEMS = I_IN + I_LORA + I_OUT + I_F1 + I_F2 + I_POOL + I_G2;
    for (int it = gw; it < NITEMS; it += NGW) {
        int r = it;
        if (r < I_IN) { tr_item(in[9], 5632, nullptr, 0, WcatT, D, scr, r / 176, r % 176, F.lane); continue; } r -= I_IN;
        if (r < I_LORA) { const int qs = r / 64, q = qs >> 1, s = qs & 1, rr = r % 64, kb = rr / 4, nb = rr % 4;
            const float* W; int ldw;
            if (q < 2) { W = (q == 0 ? in[13] : in[16]) + (size_t)(nb >> 1) * D * 64 + (nb & 1) * 32; ldw = 64; } else { W = in[18] + nb * 32; ldw = 128; }
            tr_item(W, ldw, in[11] + q * D, s + 1, WcatT + (size_t)(ZC_LW_A + q * 256 + s * 128 + nb * 32) * D, D, scr, kb, 0, F.lane); continue; } r -= I_LORA;
        if (r < I_OUT) { tr_item(in[27], D, nullptr, 0, WoutT, D, scr, r / 32, r % 32, F.lane); continue; } r -= I_OUT;
        if (r < I_F1) { tr_item(in[28], FF, nullptr, 0, Wff1T, D, scr, r / 128, r % 128, F.lane); continue; } r -= I_F1;
        if (r < I_F2) { tr_item(in[29], D, nullptr, 0, Wff2T, FF, scr, r / 32, r % 32, F.lane); continue; } r -= I_F2;
        if (r < I_POOL) { const int g = r / 16, rr = r % 16; tr_item(in[25] + (size_t)g * 128 * 256, 256, nullptr, 0, poolWT + (size_t)g * 256 * 128, 128, scr, rr / 8, rr % 8, F.lane); continue; } r -= I_POOL;
        tr_item(in[19], D, nullptr, 0, gw2T, 128, scr, r / 32, r % 32, F.lane);
    }
}

__device__ __forceinline__ void p1_hprep(Frame& F) {
    const float* const* in = F.in;
    const int gw = F.bid * NWAVES + F.wave, NGW = F.G * NWAVES;
    const float* mod = (const float*)(F.ws + WS_MOD);
    bf16* H = (bf16*)(F.ws + WS_H);
    for (int m = gw; m < M; m += NGW) {
        const float* xrow = m < M_CTX ? in[0] + (size_t)m * D : in[1] + (size_t)(m - M_CTX) * D;
        const int ci = cvec_of_row(m);
        f32x4 v[4]; float s = 0.f;
#pragma unroll
        for (int j = 0; j < 4; ++j) { v[j] = *(const f32x4*)(xrow + 4 * (F.lane + 64 * j)); s += (v[j].x * v[j].x + v[j].y * v[j].y) + (v[j].z * v[j].z + v[j].w * v[j].w); }
        const float rstd = rsqrtf(wave_sum(s) * (1.0f / D) + 1e-6f);
#pragma unroll
        for (int j = 0; j < 4; ++j) { const int c = 4 * (F.lane + 64 * j);
            const f32x4 g = *(const f32x4*)(in[7] + c), sh = *(const f32x4*)(mod + ci * NMOD + c), sc = *(const f32x4*)(mod + ci * NMOD + D + c);
            const f32x4 y = (v[j] * rstd) * g * (sc + 1.0f) + sh;
            v2u w; w.x = pkbf(y.x, y.y); w.y = pkbf(y.z, y.w); *(v2u*)(H + (size_t)m * D + c) = w; }
    }
    const bf16* Wff1T = (const bf16*)(F.ws + WS_WFF1); float* c1 = (float*)(F.ws + WS_C1);
    for (int n = gw; n < FF; n += NGW) {
        const bf16* wr = Wff1T + (size_t)n * D + F.lane * 16;
        const v4u w0 = *(const v4u*)wr, w1 = *(const v4u*)(wr + 8);
        float w[16];
#pragma unroll
        for (int e = 0; e < 4; ++e) { w[2 * e] = __builtin_bit_cast(float, w0[e] << 16); w[2 * e + 1] = __builtin_bit_cast(float, w0[e] & 0xffff0000u);
            w[8 + 2 * e] = __builtin_bit_cast(float, w1[e] << 16); w[8 + 2 * e + 1] = __builtin_bit_cast(float, w1[e] & 0xffff0000u); }
#pragma unroll
        for (int ci = 0; ci < 5; ++ci) { const float* sh = mod + ci * NMOD + 3 * D + F.lane * 16; float s = 0.f;
#pragma unroll
            for (int q = 0; q < 4; ++q) { const f32x4 x = *(const f32x4*)(sh + 4 * q); s += x.x * w[4 * q] + x.y * w[4 * q + 1] + x.z * w[4 * q + 2] + x.w * w[4 * q + 3]; }
            s = wave_sum(s); if (F.lane == 0) c1[ci * FF + n] = s; }
    }
}

constexpr int SC = 32;
__device__ __forceinline__ void p3_scan(Frame& F) {
    const float* const* in = F.in;
    const f16* Z = (const f16*)(F.ws + WS_Z);
    LAS float* OPS = (LAS float*)(F.lds);
    LAS float* HW = (LAS float*)(F.lds + 49152);
    LAS float* HA = (LAS float*)(F.lds + 57344);
    LAS float* WD2 = (LAS float*)(F.lds + 65536);
    LAS float* WA2 = (LAS float*)(F.lds + 81920);
    LAS float* YB = (LAS float*)(F.lds + 98304);
    const int tid = F.tid, i = tid >> 3, g = tid & 7;
    const int ptt = tid >> 4, pc4 = (tid & 15) * 4;
    constexpr int NLAT = 4 * NH * 2, NCTX = 16 * NH * 2, NCH = NLAT + NCTX;
    for (int slot = 0;; ++slot) {
        int chain;
        if (F.G == 256) { if (F.bid < 128) { if (slot > 0) break; chain = F.bid; } else { if (slot > 3) break; chain = NLAT + (F.bid - 128) + 128 * slot; } }
        else { chain = F.bid + slot * F.G; if (chain >= NCH) break; }
        const bool isLat = chain < NLAT; const int cid = isLat ? chain : chain - NLAT;
        const int b = cid / 32, head = (cid >> 1) & 15, d = cid & 1;
        const int L = isLat ? L_LAT : L_CTX, m0 = isLat ? M_CTX + b * L_LAT : b * L_CTX;
        bf16* Y = (bf16*)F.out + (size_t)d * M * D;
        __syncthreads();
        for (int idx = tid; idx < 4096; idx += NWAVES * 64) { const int k = idx >> 6, c = idx & 63;
            WD2[idx] = in[14][(size_t)(d * 64 + k) * D + head * 64 + c]; WA2[idx] = in[17][(size_t)(d * 64 + k) * D + head * 64 + c]; }
        float S[8];
        if (isLat) { const float* sp = in[2] + ((size_t)((b * 2 + d) * NH + head)) * 4096 + i * 64 + g * 8; const f32x4 s0 = *(const f32x4*)sp, s1 = *(const f32x4*)(sp + 4);
            S[0] = s0.x; S[1] = s0.y; S[2] = s0.z; S[3] = s0.w; S[4] = s1.x; S[5] = s1.y; S[6] = s1.z; S[7] = s1.w; }
        else {
#pragma unroll
            for (int j = 0; j < 8; ++j) S[j] = 0.f; }
        const int hc = head * 64 + pc4;
        const f32x4 mu_r = *(const f32x4*)(in[10] + hc), mu_k = *(const f32x4*)(in[10] + D + hc), mu_v = *(const f32x4*)(in[10] + 2 * D + hc);
        const f32x4 kkw = *(const f32x4*)(in[20] + hc), kaw = *(const f32x4*)(in[21] + hc);
        const f32x4 wd0 = *(const f32x4*)(in[12] + d * D + hc), a0v = *(const f32x4*)(in[15] + d * D + hc);
        const int nch = L / SC;
        for (int ch = 0; ch < nch; ++ch) {
            const int t0 = d == 0 ? SC * ch : L - SC * (ch + 1);
            f32x4 k4, kk4;
            {
                const int t = t0 + ptt; const f16* zr = Z + (size_t)(m0 + t) * NZ;
                const float fp = t > 0 ? 0.5f : 0.f, fn = t < L - 1 ? 0.5f : 0.f;
                const f16* zp = t > 0 ? zr - NZ : zr; const f16* zn = t < L - 1 ? zr + NZ : zr;
                const f32x4 rz = ld_h4(zr + ZC_R + hc), kz = ld_h4(zr + ZC_K + hc), vz = ld_h4(zr + ZC_V + hc);
                const f32x4 rs = ld_h4(zp + ZC_R + hc) * fp + ld_h4(zn + ZC_R + hc) * fn;
                const f32x4 ks = ld_h4(zp + ZC_K + hc) * fp + ld_h4(zn + ZC_K + hc) * fn;
                const f32x4 vs = ld_h4(zp + ZC_V + hc) * fp + ld_h4(zn + ZC_V + hc) * fn;
                const f32x4 r4 = rz + (rs - rz) * mu_r; k4 = kz + (ks - kz) * mu_k; const f32x4 v4 = vz + (vs - vz) * mu_v;
                const int lc = d * 64 + pc4;
                f32x4 hw = ld_h4(zr + ZC_LW_A + lc) + ld_h4(zp + ZC_LW_B + lc) * fp + ld_h4(zn + ZC_LW_B + lc) * fn;
                const f32x4 ha = ld_h4(zr + ZC_LA_A + lc) + ld_h4(zp + ZC_LA_B + lc) * fp + ld_h4(zn + ZC_LA_B + lc) * fn;
#pragma unroll
                for (int e = 0; e < 4; ++e) hw[e] = 1.0f - 2.0f * frcp(__expf(2.0f * hw[e]) + 1.0f);
                const f32x4 ku = k4 * kkw; float ssq = (ku.x * ku.x + ku.y * ku.y) + (ku.z * ku.z + ku.w * ku.w);
                ssq += __shfl_xor(ssq, 1); ssq += __shfl_xor(ssq, 2); ssq += __shfl_xor(ssq, 4); ssq += __shfl_xor(ssq, 8);
                kk4 = ku * rsqrtf(ssq + 1e-12f);
                *(LAS f32x4*)(HW + ptt * 64 + pc4) = hw; *(LAS f32x4*)(HA + ptt * 64 + pc4) = ha;
                *(LAS f32x4*)(OPS + ptt * 384 + 64 + pc4) = kk4; *(LAS f32x4*)(OPS + ptt * 384 + 256 + pc4) = r4; *(LAS f32x4*)(OPS + ptt * 384 + 320 + pc4) = v4;
            }
            __syncthreads();
            {
                f32x4 aw = {0.f, 0.f, 0.f, 0.f}, aa = {0.f, 0.f, 0.f, 0.f};
#pragma unroll 8
                for (int k = 0; k < 64; ++k) { const float hwk = HW[ptt * 64 + k], hak = HA[ptt * 64 + k];
                    aw += *(const LAS f32x4*)(WD2 + k * 64 + pc4) * hwk; aa += *(const LAS f32x4*)(WA2 + k * 64 + pc4) * hak; }
                f32x4 dec, av, kd, bb;
#pragma unroll
                for (int e = 0; e < 4; ++e) { dec[e] = __expf(-0.6065306597126334f * sigmoidf_(wd0[e] + aw[e])); av[e] = sigmoidf_(a0v[e] + aa[e]); }
                kd = k4 * ((av - 1.0f) * kaw + 1.0f); bb = kk4 * av;
                *(LAS f32x4*)(OPS + ptt * 384 + pc4) = dec; *(LAS f32x4*)(OPS + ptt * 384 + 128 + pc4) = bb; *(LAS f32x4*)(OPS + ptt * 384 + 192 + pc4) = kd;
            }
            __syncthreads();
#pragma unroll 2
            for (int s = 0; s < SC; ++s) {
                const int tt = d == 0 ? s : SC - 1 - s;
                const LAS float* op = OPS + tt * 384 + g * 8;
                const f32x4 w0 = *(const LAS f32x4*)(op), w1 = *(const LAS f32x4*)(op + 4);
                const f32x4 q0 = *(const LAS f32x4*)(op + 64), q1 = *(const LAS f32x4*)(op + 68);
                const f32x4 b0 = *(const LAS f32x4*)(op + 128), b1 = *(const LAS f32x4*)(op + 132);
                const f32x4 d0 = *(const LAS f32x4*)(op + 192), d1 = *(const LAS f32x4*)(op + 196);
                const f32x4 r0 = *(const LAS f32x4*)(op + 256), r1 = *(const LAS f32x4*)(op + 260);
                const float v = OPS[tt * 384 + 320 + i];
                float p = (S[0] * q0.x + S[1] * q0.y) + (S[2] * q0.z + S[3] * q0.w) + (S[4] * q1.x + S[5] * q1.y) + (S[6] * q1.z + S[7] * q1.w);
                p += __shfl_xor(p, 1); p += __shfl_xor(p, 2); p += __shfl_xor(p, 4);
                S[0] = S[0] * w0.x - p * b0.x + v * d0.x; S[1] = S[1] * w0.y - p * b0.y + v * d0.y; S[2] = S[2] * w0.z - p * b0.z + v * d0.z; S[3] = S[3] * w0.w - p * b0.w + v * d0.w;
                S[4] = S[4] * w1.x - p * b1.x + v * d1.x; S[5] = S[5] * w1.y - p * b1.y + v * d1.y; S[6] = S[6] * w1.z - p * b1.z + v * d1.z; S[7] = S[7] * w1.w - p * b1.w + v * d1.w;
                float y = (S[0] * r0.x + S[1] * r0.y) + (S[2] * r0.z + S[3] * r0.w) + (S[4] * r1.x + S[5] * r1.y) + (S[6] * r1.z + S[7] * r1.w);
                y += __shfl_xor(y, 1); y += __shfl_xor(y, 2); y += __shfl_xor(y, 4);
                if (g == 0) YB[tt * 64 + i] = y;
            }
            __syncthreads();
            { const f32x4 y4 = *(const LAS f32x4*)(YB + ptt * 64 + pc4); v2u w; w.x = pkbf(y4.x, y4.y); w.y = pkbf(y4.z, y4.w);
              *(v2u*)(Y + (size_t)(m0 + t0 + ptt) * D + hc) = w; }
        }
        if (!isLat) { float* so = F.out + (size_t)M * D + ((size_t)((b * 2 + d) * NH + head)) * 4096 + i * 64 + g * 8;
            *(f32x4*)so = (f32x4){S[0], S[1], S[2], S[3]}; *(f32x4*)(so + 4) = (f32x4){S[4], S[5], S[6], S[7]}; }
    }
}

typedef short s16x4 __attribute__((ext_vector_type(4)));
__device__ __forceinline__ int sw(int row, int col) { return row * 64 + ((((col >> 3) ^ (row >> 1)) & 7) << 3) + (col & 7); }
__device__ __forceinline__ bf16x8 ldfrag(const LAS bf16* buf, int row, int col) { return *(const LAS bf16x8*)(buf + sw(row, col)); }
__device__ __forceinline__ void mm_blk(f32x4 (&acc)[2][2], const LAS bf16* X, int xr0, const LAS bf16* Yt, int yr0, int fr, int fq) {
#pragma unroll
    for (int ks = 0; ks < 2; ++ks) {
        bf16x8 a[2], b[2];
#pragma unroll
        for (int t = 0; t < 2; ++t) { a[t] = ldfrag(X, xr0 + 16 * t + fr, 32 * ks + 8 * fq); b[t] = ldfrag(Yt, yr0 + 16 * t + fr, 32 * ks + 8 * fq); }
#pragma unroll
        for (int ti = 0; ti < 2; ++ti)
#pragma unroll
            for (int tj = 0; tj < 2; ++tj) acc[ti][tj] = __builtin_amdgcn_mfma_f32_16x16x32_bf16(a[ti], b[tj], acc[ti][tj], 0, 0, 0);
    }
}
__device__ __forceinline__ void zero_blk(f32x4 (&acc)[2][2]) {
#pragma unroll
    for (int ti = 0; ti < 2; ++ti)
#pragma unroll
        for (int tj = 0; tj < 2; ++tj) acc[ti][tj] = (f32x4){0.f, 0.f, 0.f, 0.f};
}
__device__ __forceinline__ void st_blk_t(LAS bf16* dst, const f32x4 (&acc)[2][2], int xr0, int yr0, int fr, int fq) {
#pragma unroll
    for (int ti = 0; ti < 2; ++ti)
#pragma unroll
        for (int tj = 0; tj < 2; ++tj) { v2u w; w.x = pkbf(acc[ti][tj][0], acc[ti][tj][1]); w.y = pkbf(acc[ti][tj][2], acc[ti][tj][3]);
            *(LAS v2u*)(dst + sw(yr0 + 16 * tj + fr, xr0 + 16 * ti + 4 * fq)) = w; }
}
#ifndef SREP_MASK
#define SREP_MASK 0
#endif
#ifndef SREP_N
#define SREP_N 2
#endif
#define SREP(k) for (int srep_ = 0; srep_ < (((SREP_MASK >> (k)) & 1) ? 1 + SREP_N : 1); ++srep_)
constexpr int CS = 64;
__device__ __forceinline__ void p3_scan2(Frame& F) {
    const float* const* in = F.in;
    const f16* Z = (const f16*)(F.ws + WS_Z);
    LAS bf16* const B0 = (LAS bf16*)(F.lds);
#define MB(n) (B0 + (n) * 4096)
    LAS bf16* const KKg = MB(0); LAS bf16* const Rg = MB(1); LAS bf16* const Bi = MB(2); LAS bf16* const Ki = MB(3);
    LAS bf16* const Bct = MB(4); LAS bf16* const Kct = MB(5); LAS bf16* const Vt = MB(6); LAS bf16* const Sb = MB(7);
    LAS bf16* const Aab = MB(8); LAS bf16* const Aak = MB(9); LAS bf16* const Arb = MB(10); LAS bf16* const Ark = MB(11); LAS bf16* const Minv = MB(12);
    LAS bf16* const RHSt = Bi; LAS bf16* const Ut = Ki; LAS bf16* const YB = KKg; LAS bf16* const HW = Bi; LAS bf16* const HA = Ki;
    LAS f16* const r16 = (LAS f16*)MB(8); LAS f16* const k16 = (LAS f16*)MB(9); LAS f16* const v16 = (LAS f16*)MB(10); LAS f16* const kk16 = (LAS f16*)MB(11); LAS f16* const a16 = (LAS f16*)MB(12);
    LAS bf16* const Wd2t = MB(13); LAS bf16* const Wa2t = MB(14);
    LAS float* const LW = (LAS float*)(F.lds + 15 * 8192);
    LAS float* const AD = LW;
    LAS float* const SEG = (LAS float*)(F.lds + 15 * 8192 + 16384);
    LAS float* const GC = SEG + 512;
    LAS bf16* const XT = (LAS bf16*)(GC + 64);
    LAS f16* const CSTH = (LAS f16*)(XT + 1024 + 768);
    LAS float* const CST = (LAS float*)(XT + 1024);
    const int tid = F.tid, lane = F.lane, wave = F.wave;
#define OPQ_LANE() int ln_ = lane; asm volatile("" : "+v"(ln_)); const int fr = ln_ & 15, fq = ln_ >> 4
#define OPQ_TID() int td_ = tid; asm volatile("" : "+v"(td_)); const int ptt = td_ >> 3, pc8 = (td_ & 7) * 8, cch = td_ & 63, cseg = td_ >> 6; (void)ptt; (void)pc8; (void)cch; (void)cseg
    constexpr int NLAT = 4 * NH * 2, NCTX = 16 * NH * 2, NCH = NLAT + NCTX;
    for (int slot = 0;; ++slot) {
        int chain;
        if (F.G == 256) { if (F.bid < 128) { if (slot > 0) break; chain = F.bid; } else { if (slot > 3) break; chain = NLAT + (F.bid - 128) + 128 * slot; } }
        else { chain = F.bid + slot * F.G; if (chain >= NCH) break; }
        const bool isLat = chain < NLAT; const int cid = isLat ? chain : chain - NLAT;
        const int b = cid / 32, head = (cid >> 1) & 15, d = cid & 1;
        const int L = isLat ? L_LAT : L_CTX, m0 = isLat ? M_CTX + b * L_LAT : b * L_CTX;
        bf16* Y = (bf16*)F.out + (size_t)d * M * D;
        __syncthreads();
        for (int idx = tid; idx < 4096; idx += NWAVES * 64) { const int k = idx >> 6, c = idx & 63;
            const float wv = in[14][(size_t)(d * 64 + k) * D + head * 64 + c], av = in[17][(size_t)(d * 64 + k) * D + head * 64 + c];
            Wd2t[sw(c, k)] = (bf16)(pkbf(wv, 0.f) & 0xffffu); Wa2t[sw(c, k)] = (bf16)(pkbf(av, 0.f) & 0xffffu); }
        const int v4 = wave & 3, bi = v4 >> 1, bj = v4 & 1;
        f32x4 Tacc[2][2]; zero_blk(Tacc);
        if (wave >= 4) { OPQ_LANE();
            if (isLat) { const float* sp = in[2] + ((size_t)((b * 2 + d) * NH + head)) * 4096;
#pragma unroll
                for (int ti = 0; ti < 2; ++ti)
#pragma unroll
                    for (int tj = 0; tj < 2; ++tj) Tacc[ti][tj] = *(const f32x4*)(sp + (32 * bj + 16 * tj + fr) * 64 + 32 * bi + 16 * ti + 4 * fq); }
            st_blk_t(Sb, Tacc, 32 * bi, 32 * bj, fr, fq);
        }
        if (tid < 384) { const int q = tid >> 6, c = tid & 63; const float cv = q < 3 ? in[10][q * D + head * 64 + c] : q == 3 ? in[20][head * 64 + c] : q == 4 ? in[12][d * D + head * 64 + c] : in[15][d * D + head * 64 + c];
            CST[tid] = cv; if (tid < 256) CSTH[tid] = (f16)cv; }
        const float kac = in[21][head * 64 + (tid & 63)];
        const int nch = L / CS;
        f16x8 pz[15];
#define ZLOAD(chn) do { OPQ_TID(); const int tau_ = CS * (chn) + ptt, t_ = d == 0 ? tau_ : L - 1 - tau_; const int hc8_ = head * 64 + pc8, lc_ = d * 64 + pc8; \
            const f16* zr_ = Z + (size_t)(m0 + t_) * NZ; const f16* zp_ = t_ > 0 ? zr_ - NZ : zr_; const f16* zn_ = t_ < L - 1 ? zr_ + NZ : zr_; \
            pz[0] = *(const f16x8*)(zr_ + ZC_R + hc8_); pz[1] = *(const f16x8*)(zp_ + ZC_R + hc8_); pz[2] = *(const f16x8*)(zn_ + ZC_R + hc8_); \
            pz[3] = *(const f16x8*)(zr_ + ZC_K + hc8_); pz[4] = *(const f16x8*)(zp_ + ZC_K + hc8_); pz[5] = *(const f16x8*)(zn_ + ZC_K + hc8_); \
            pz[6] = *(const f16x8*)(zr_ + ZC_V + hc8_); pz[7] = *(const f16x8*)(zp_ + ZC_V + hc8_); pz[8] = *(const f16x8*)(zn_ + ZC_V + hc8_); \
            pz[9] = *(const f16x8*)(zr_ + ZC_LW_A + lc_); pz[10] = *(const f16x8*)(zp_ + ZC_LW_B + lc_); pz[11] = *(const f16x8*)(zn_ + ZC_LW_B + lc_); \
            pz[12] = *(const f16x8*)(zr_ + ZC_LA_A + lc_); pz[13] = *(const f16x8*)(zp_ + ZC_LA_B + lc_); pz[14] = *(const f16x8*)(zn_ + ZC_LA_B + lc_); } while (0)
        ZLOAD(0);
        __syncthreads();
        for (int ch = 0; ch < nch; ++ch) {
            SREP(0) {
                OPQ_TID();
                const int tau = CS * ch + ptt, t = d == 0 ? tau : L - 1 - tau;
                const float fp = t > 0 ? 0.5f : 0.f, fn = t < L - 1 ? 0.5f : 0.f;
                const f16x8 rz = pz[0], rp = pz[1], rn = pz[2], kz = pz[3], kp = pz[4], kn = pz[5], vz = pz[6], vp = pz[7], vn = pz[8];
                const f16x8 wa = pz[9], wbp = pz[10], wbn = pz[11], aa = pz[12], abp = pz[13], abn = pz[14];
                const f16x8 mur = *(const LAS f16x8*)(CSTH + pc8), muk = *(const LAS f16x8*)(CSTH + 64 + pc8), muv = *(const LAS f16x8*)(CSTH + 128 + pc8), kkw = *(const LAS f16x8*)(CSTH + 192 + pc8);
                const f16 fph = (f16)fp, fnh = (f16)fn;
                const f16x8 rr = rz + ((rp * fph + rn * fnh) - rz) * mur;
                const f16x8 kx = kz + ((kp * fph + kn * fnh) - kz) * muk;
                const f16x8 vv = vz + ((vp * fph + vn * fnh) - vz) * muv;
                const f16x8 ku = kx * kkw;
                float ssq = 0.f;
#pragma unroll
                for (int e = 0; e < 4; ++e) { const f16x2 pr = {ku[2 * e], ku[2 * e + 1]}; ssq = __builtin_amdgcn_fdot2(pr, pr, ssq, false); }
                ssq += __shfl_xor(ssq, 1); ssq += __shfl_xor(ssq, 2); ssq += __shfl_xor(ssq, 4);
                const f16 rnh = (f16)rsqrtf(ssq + 1e-12f);
                const f16x8 kkv = ku * rnh;
                const f16x8 hwh = wa + wbp * fph + wbn * fnh, hah = aa + abp * fph + abn * fnh;
                float hw[8], ha[8];
#pragma unroll
                for (int e = 0; e < 8; ++e) { hw[e] = 1.0f - 2.0f * frcp(__expf(2.0f * (float)hwh[e]) + 1.0f); ha[e] = (float)hah[e]; }
                *(LAS f16x8*)(r16 + ptt * 64 + pc8) = rr; *(LAS f16x8*)(k16 + ptt * 64 + pc8) = kx; *(LAS f16x8*)(v16 + ptt * 64 + pc8) = vv; *(LAS f16x8*)(kk16 + ptt * 64 + pc8) = kkv;
                v4u o;
                o.x = pkbf(hw[0], hw[1]); o.y = pkbf(hw[2], hw[3]); o.z = pkbf(hw[4], hw[5]); o.w = pkbf(hw[6], hw[7]); *(LAS v4u*)(HW + sw(ptt, pc8)) = o;
                o.x = pkbf(ha[0], ha[1]); o.y = pkbf(ha[2], ha[3]); o.z = pkbf(ha[4], ha[5]); o.w = pkbf(ha[6], ha[7]); *(LAS v4u*)(HA + sw(ptt, pc8)) = o;
            }
            if (ch + 1 < nch) ZLOAD(ch + 1);
            __syncthreads();
            SREP(1) {
                OPQ_LANE();
                f32x4 acc[2][2]; zero_blk(acc);
                mm_blk(acc, wave < 4 ? Wd2t : Wa2t, 32 * bi, wave < 4 ? HW : HA, 32 * bj, fr, fq);
#pragma unroll
                for (int ti = 0; ti < 2; ++ti) { const int c0 = 32 * bi + 16 * ti + 4 * fq;
                    const f32x4 bias = *(const LAS f32x4*)(CST + (wave < 4 ? 256 : 320) + c0);
#pragma unroll
                    for (int tj = 0; tj < 2; ++tj) { const int tt = 32 * bj + 16 * tj + fr; f32x4 x = acc[ti][tj] + bias;
#pragma unroll
                        for (int e = 0; e < 4; ++e) x[e] = sigmoidf_(x[e]);
                        if (wave < 4) *(LAS f32x4*)(LW + tt * 64 + c0) = x * (-0.6065306597126334f);
                        else { v2u w; w.x = pkh(x[0], x[1]); w.y = pkh(x[2], x[3]); *(LAS v2u*)(a16 + tt * 64 + c0) = w; } } }
            }
            __syncthreads();
            float lwv[8];
            { OPQ_TID(); float run = 0.f;
#pragma unroll
              for (int e = 0; e < 8; ++e) { lwv[e] = LW[(8 * cseg + e) * 64 + cch]; run += lwv[e]; }
              SEG[cseg * 64 + cch] = run; }
            __syncthreads();
            SREP(2) {
                OPQ_TID();
                float pre = 0.f, tot = 0.f;
#pragma unroll
                for (int s = 0; s < 8; ++s) { const float x = SEG[s * 64 + cch]; tot += x; pre += (s < cseg) ? x : 0.f; }
                const float gC = __expf(tot); float E = __expf(pre);
                if (cseg == 0) GC[cch] = gC;
                float nb[8], kc[8], vt[8];
#pragma unroll
                for (int e = 0; e < 8; ++e) { const int tt = 8 * cseg + e;
                    const float gprev = E; E *= __expf(lwv[e]); const float inv = frcp(E), e4 = gC * inv;
                    const float kkv = (float)kk16[tt * 64 + cch], rv = (float)r16[tt * 64 + cch], kv = (float)k16[tt * 64 + cch], vv = (float)v16[tt * 64 + cch], av = (float)a16[tt * 64 + cch];
                    const float kd = kv * (1.0f + (av - 1.0f) * kac), bb = kkv * av;
                    KKg[sw(tt, cch)] = (bf16)(pkbf(kkv * gprev, 0.f) & 0xffffu); Rg[sw(tt, cch)] = (bf16)(pkbf(rv * E, 0.f) & 0xffffu);
                    Bi[sw(tt, cch)] = (bf16)(pkbf(bb * inv, 0.f) & 0xffffu); Ki[sw(tt, cch)] = (bf16)(pkbf(kd * inv, 0.f) & 0xffffu);
                    nb[e] = bb * e4; kc[e] = kd * e4; vt[e] = vv; }
                v4u o;
                o.x = pkbf(nb[0], nb[1]); o.y = pkbf(nb[2], nb[3]); o.z = pkbf(nb[4], nb[5]); o.w = pkbf(nb[6], nb[7]); *(LAS v4u*)(Bct + sw(cch, 8 * cseg)) = o;
                o.x = pkbf(kc[0], kc[1]); o.y = pkbf(kc[2], kc[3]); o.z = pkbf(kc[4], kc[5]); o.w = pkbf(kc[6], kc[7]); *(LAS v4u*)(Kct + sw(cch, 8 * cseg)) = o;
                o.x = pkbf(vt[0], vt[1]); o.y = pkbf(vt[2], vt[3]); o.z = pkbf(vt[4], vt[5]); o.w = pkbf(vt[6], vt[7]); *(LAS v4u*)(Vt + sw(cch, 8 * cseg)) = o;
            }
            __syncthreads();
            SREP(3) {
                OPQ_LANE();
                const int mtx = wave >> 1, sb = wave & 1;
                const LAS bf16* X = (mtx & 1) ? Ki : Bi; const LAS bf16* Yt = (mtx >> 1) ? Rg : KKg;
                LAS bf16* dst = mtx == 0 ? Aab : mtx == 1 ? Aak : mtx == 2 ? Arb : Ark;
                f32x4 mk;
#pragma unroll
                for (int e = 0; e < 4; ++e) mk[e] = (mtx >= 2 ? (4 * fq + e <= fr) : (4 * fq + e < fr)) ? 1.0f : 0.0f;
                {
                    f32x4 a00 = {0.f, 0.f, 0.f, 0.f}, a01 = a00, a11 = a00;
#pragma unroll
                    for (int ks = 0; ks < 2; ++ks) {
                        const bf16x8 x0 = ldfrag(X, 32 * sb + fr, 32 * ks + 8 * fq), x1 = ldfrag(X, 32 * sb + 16 + fr, 32 * ks + 8 * fq);
                        const bf16x8 y0 = ldfrag(Yt, 32 * sb + fr, 32 * ks + 8 * fq), y1 = ldfrag(Yt, 32 * sb + 16 + fr, 32 * ks + 8 * fq);
                        a00 = __builtin_amdgcn_mfma_f32_16x16x32_bf16(x0, y0, a00, 0, 0, 0);
                        a01 = __builtin_amdgcn_mfma_f32_16x16x32_bf16(x0, y1, a01, 0, 0, 0);
                        a11 = __builtin_amdgcn_mfma_f32_16x16x32_bf16(x1, y1, a11, 0, 0, 0); }
                    a00 *= mk; a11 *= mk;
                    const int r0 = 32 * sb + fr, c0 = 32 * sb + 4 * fq;
                    v2u w;
                    w.x = pkbf(a00[0], a00[1]); w.y = pkbf(a00[2], a00[3]); *(LAS v2u*)(dst + sw(r0, c0)) = w;
                    w.x = pkbf(a01[0], a01[1]); w.y = pkbf(a01[2], a01[3]); *(LAS v2u*)(dst + sw(r0 + 16, c0)) = w;
                    w.x = pkbf(a11[0], a11[1]); w.y = pkbf(a11[2], a11[3]); *(LAS v2u*)(dst + sw(r0 + 16, c0 + 16)) = w;
                    *(LAS v2u*)(dst + sw(r0, c0 + 16)) = (v2u){0u, 0u};
                    if (mtx == 0) { *(LAS f32x4*)(AD + (2 * sb) * 256 + fr * 16 + 4 * fq) = a00; *(LAS f32x4*)(AD + (2 * sb + 1) * 256 + fr * 16 + 4 * fq) = a11; }
                }
                if (sb == 0) {
                    f32x4 acc[2][2]; zero_blk(acc);
                    mm_blk(acc, X, 0, Yt, 32, fr, fq);
                    st_blk_t(dst, acc, 0, 32, fr, fq);
                } else {
#pragma unroll
                    for (int ti = 0; ti < 2; ++ti)
#pragma unroll
                        for (int tj = 0; tj < 2; ++tj) *(LAS v2u*)(dst + sw(16 * tj + fr, 32 + 16 * ti + 4 * fq)) = (v2u){0u, 0u};
                }
            }
            __syncthreads();
            f32x4 Yacc[2][2]; zero_blk(Yacc);
            SREP(4) if (wave < 3) {
                OPQ_LANE();
                float x[16];
#pragma unroll
                for (int r = 0; r < 16; ++r) x[r] = (r == fr) ? 1.0f : 0.0f;
#pragma unroll
                for (int r = 1; r < 16; ++r) { float s = 0.f;
#pragma unroll
                    for (int k4 = 0; k4 < (r + 3) / 4; ++k4) { const f32x4 nr = *(const LAS f32x4*)(AD + fq * 256 + r * 16 + 4 * k4);
#pragma unroll
                        for (int e = 0; e < 4; ++e) if (4 * k4 + e < r) s += nr[e] * x[4 * k4 + e]; }
                    x[r] = (r > fr) ? -s : x[r]; }
#pragma unroll
                for (int r = 0; r < 16; ++r) Minv[sw(16 * fq + r, 16 * fq + fr)] = (bf16)(pkbf(-x[r], 0.f) & 0xffffu);
                { v4u o; o.x = pkbf(x[0], x[1]); o.y = pkbf(x[2], x[3]); o.z = pkbf(x[4], x[5]); o.w = pkbf(x[6], x[7]); *(LAS v4u*)(XT + fq * 256 + fr * 16) = o;
                  o.x = pkbf(x[8], x[9]); o.y = pkbf(x[10], x[11]); o.z = pkbf(x[12], x[13]); o.w = pkbf(x[14], x[15]); *(LAS v4u*)(XT + fq * 256 + fr * 16 + 8) = o; }
                const int j = wave;
                s16x4 xb[3];
                xb[0] = *(const LAS s16x4*)(XT + j * 256 + fr * 16 + 4 * fq);
                xb[1] = xb[0]; xb[2] = xb[0];
#pragma unroll
                for (int dl = 1; dl <= 3; ++dl) { if (j + dl <= 3) { const int i = j + dl;
                    f32x4 p = {0.f, 0.f, 0.f, 0.f};
#pragma unroll
                    for (int mm = 0; mm < dl; ++mm) { const s16x4 n = *(const LAS s16x4*)(Aab + sw(16 * i + fr, 16 * (j + mm) + 4 * fq));
                        p = __builtin_amdgcn_mfma_f32_16x16x16bf16_1k(n, xb[mm], p, 0, 0, 0); }
                    v2u pw; pw.x = pkbf(p[0], p[1]); pw.y = pkbf(p[2], p[3]);
                    const s16x4 xi = *(const LAS s16x4*)(Minv + sw(16 * i + fr, 16 * i + 4 * fq));
                    f32x4 z = {0.f, 0.f, 0.f, 0.f};
                    z = __builtin_amdgcn_mfma_f32_16x16x16bf16_1k(xi, __builtin_bit_cast(s16x4, pw), z, 0, 0, 0);
                    { v2u zp; zp.x = pkbf(z[0], z[1]); zp.y = pkbf(z[2], z[3]); if (dl < 3) xb[dl] = __builtin_bit_cast(s16x4, zp); }
                    v2u zw; zw.x = pkbf(-z[0], -z[1]); zw.y = pkbf(-z[2], -z[3]);
                    Minv[sw(16 * i + 4 * fq + 0, 16 * j + fr)] = (bf16)(zw.x & 0xffffu); Minv[sw(16 * i + 4 * fq + 1, 16 * j + fr)] = (bf16)(zw.x >> 16);
                    Minv[sw(16 * i + 4 * fq + 2, 16 * j + fr)] = (bf16)(zw.y & 0xffffu); Minv[sw(16 * i + 4 * fq + 3, 16 * j + fr)] = (bf16)(zw.y >> 16); } }
            }
            if (wave == 3) { OPQ_LANE();
#pragma unroll
                for (int bc = 1; bc < 4; ++bc)
                    for (int r = 0; r < 16 * bc; r += 4) *(LAS unsigned short*)(Minv + sw(r + fq, 16 * bc + fr)) = 0; }
            if (wave >= 4) {
                OPQ_LANE();
                f32x4 R[2][2]; zero_blk(R);
                mm_blk(R, Aak, 32 * bi, Vt, 32 * bj, fr, fq);
                mm_blk(R, KKg, 32 * bi, Sb, 32 * bj, fr, fq);
                st_blk_t(RHSt, R, 32 * bi, 32 * bj, fr, fq);
#pragma unroll
                for (int ti = 0; ti < 2; ++ti) { const f32x4 g = *(const LAS f32x4*)(GC + 32 * bi + 16 * ti + 4 * fq);
#pragma unroll
                    for (int tj = 0; tj < 2; ++tj) Tacc[ti][tj] *= g; }
                mm_blk(Tacc, Kct, 32 * bi, Vt, 32 * bj, fr, fq);
                mm_blk(Yacc, Sb, 32 * bi, Rg, 32 * bj, fr, fq);
                mm_blk(Yacc, Vt, 32 * bi, Ark, 32 * bj, fr, fq);
            }
            __syncthreads();
            SREP(6) if (wave >= 4) {
                OPQ_LANE();
                f32x4 Uc[2][2]; zero_blk(Uc);
                mm_blk(Uc, Minv, 32 * bi, RHSt, 32 * bj, fr, fq);
                st_blk_t(Ut, Uc, 32 * bi, 32 * bj, fr, fq);
            }
            __syncthreads();
            if (wave >= 4) {
                OPQ_LANE();
                mm_blk(Tacc, Bct, 32 * bi, Ut, 32 * bj, fr, fq);
                mm_blk(Yacc, Ut, 32 * bi, Arb, 32 * bj, fr, fq);
                st_blk_t(Sb, Tacc, 32 * bi, 32 * bj, fr, fq);
                st_blk_t(YB, Yacc, 32 * bi, 32 * bj, fr, fq);
            }
            __syncthreads();
            { OPQ_TID(); const int tau = CS * ch + ptt, t = d == 0 ? tau : L - 1 - tau;
              *(v4u*)(Y + (size_t)(m0 + t) * D + head * 64 + pc8) = *(const LAS v4u*)(YB + sw(ptt, pc8)); }
        }
        if (!isLat && wave >= 4) { OPQ_LANE(); float* so = F.out + (size_t)M * D + ((size_t)((b * 2 + d) * NH + head)) * 4096;
#pragma unroll
            for (int ti = 0; ti < 2; ++ti)
#pragma unroll
                for (int tj = 0; tj < 2; ++tj) *(f32x4*)(so + (32 * bj + 16 * tj + fr) * 64 + 32 * bi + 16 * ti + 4 * fq) = Tacc[ti][tj]; }
    }
#undef MB
#undef ZLOAD
#undef OPQ_LANE
#undef OPQ_TID
}
constexpr int MXS = 136;
constexpr int TT = 32, NMIXT = M / TT;
constexpr size_t WS_P2 = 208 * MiB, WS_GBL = 232 * MiB;
constexpr int CW_TQ = 2048;
__device__ __forceinline__ void mixA_tile(Frame& F, int tile) {
    const float* const* in = F.in;
    const f16* Z = (const f16*)(F.ws + WS_Z);
    bf16* P2 = (bf16*)(F.ws + WS_P2); bf16* GBL = (bf16*)(F.ws + WS_GBL);
    const bf16* poolWT = (const bf16*)(F.ws + WS_POOLW); const bf16* gw2T = (const bf16*)(F.ws + WS_GW2T);
    LAS bf16* SG = (LAS bf16*)(F.lds);
    LAS float* RK = (LAS float*)(F.lds + 8704);
    LAS f16* ZP = (LAS f16*)(F.lds + 8704 + 2048);
    LAS bf16* MX = (LAS bf16*)(F.lds + 8704 + 2048 + 12288);
    const int tid = F.tid, lane = F.lane, wave = F.wave;
    const int m0t = tile * TT;
    const bool isCtx = m0t < M_CTX;
    const int ms = isCtx ? (m0t / L_CTX) * L_CTX : M_CTX + ((m0t - M_CTX) / L_LAT) * L_LAT, L = isCtx ? L_CTX : L_LAT;
    const int prow = isCtx ? ms : (m0t & ~63);
    const int vlo = prow - m0t, vhi = vlo + (isCtx ? L_CTX : 64);
    __syncthreads();
    { const int tt = tid >> 4, c8 = (tid & 15) * 8; const int m = m0t + tt, t = m - ms;
      const f16* zr = Z + (size_t)m * NZ; const f16* zp = t > 0 ? zr - NZ : zr; const f16* zn = t < L - 1 ? zr + NZ : zr;
      const float fp = t > 0 ? 0.5f : 0.f, fn = t < L - 1 ? 0.5f : 0.f;
      const f16x8 a = *(const f16x8*)(zr + ZC_LG_A + c8), bp = *(const f16x8*)(zp + ZC_LG_B + c8), bn = *(const f16x8*)(zn + ZC_LG_B + c8);
      float h[8];
#pragma unroll
      for (int e = 0; e < 8; ++e) h[e] = sigmoidf_((float)a[e] + (float)bp[e] * fp + (float)bn[e] * fn);
      *(LAS v4u*)(SG + tt * MXS + c8) = (v4u){pkbf(h[0], h[1]), pkbf(h[2], h[3]), pkbf(h[4], h[5]), pkbf(h[6], h[7])}; }
#pragma unroll 1
    for (int it = 0; it < 4; ++it) { const int item = it * 512 + tid, pair = item >> 2, q = item & 3, tt = pair >> 4, head = pair & 15; const int m = m0t + tt, t = m - ms, c0 = head * 64 + q * 16;
        const f16* zr = Z + (size_t)m * NZ; const f16* zp = t > 0 ? zr - NZ : zr; const f16* zn = t < L - 1 ? zr + NZ : zr;
        const float fp = t > 0 ? 0.5f : 0.f, fn = t < L - 1 ? 0.5f : 0.f;
        float rk = 0.f;
#pragma unroll
        for (int e = 0; e < 4; ++e) { const int c = c0 + 4 * e;
            const f32x4 rz = ld_h4(zr + ZC_R + c), kz = ld_h4(zr + ZC_K + c);
            const f32x4 rs = ld_h4(zp + ZC_R + c) * fp + ld_h4(zn + ZC_R + c) * fn, ks = ld_h4(zp + ZC_K + c) * fp + ld_h4(zn + ZC_K + c) * fn;
            const f32x4 r4 = rz + (rs - rz) * *(const f32x4*)(in[10] + c), k4 = kz + (ks - kz) * *(const f32x4*)(in[10] + D + c), w4 = *(const f32x4*)(in[22] + c);
            rk += (r4.x * k4.x * w4.x + r4.y * k4.y * w4.y) + (r4.z * k4.z * w4.z + r4.w * k4.w * w4.w); }
        rk += __shfl_xor(rk, 1); rk += __shfl_xor(rk, 2);
        if (q == 0) RK[tt * 16 + head] = rk; }
#pragma unroll 1
    for (int g = 0; g < 4; ++g) {
        __syncthreads();
        for (int idx = tid; idx < (TT + 16) * 16; idx += NWAVES * 64) { const int rr = idx >> 4, c8 = (idx & 15) * 8, tl = rr - 8;
            v4u val = {0u, 0u, 0u, 0u};
            if (tl >= vlo && tl < vhi) val = *(const v4u*)(Z + (size_t)(m0t + tl) * NZ + ZC_POOL + g * 128 + c8);
            *(LAS v4u*)(ZP + rr * 128 + c8) = val; }
        __syncthreads();
        { const int win = 2 << g; const int tt = tid >> 4, c8 = (tid & 15) * 8;
          int lo = tt - win / 2, hi = tt + win - win / 2; lo = lo < vlo ? vlo : lo; hi = hi > vhi ? vhi : hi;
          float acc8[8];
#pragma unroll
          for (int e = 0; e < 8; ++e) acc8[e] = 0.f;
          for (int u = lo; u < hi; ++u) { const f16x8 zv = *(const LAS f16x8*)(ZP + (u + 8) * 128 + c8);
#pragma unroll
              for (int e = 0; e < 8; ++e) acc8[e] += (float)zv[e]; }
          const float inv = frcp((float)(hi - lo)); const f16x8 zc = *(const LAS f16x8*)(ZP + (tt + 8) * 128 + c8);
          unsigned o[4];
#pragma unroll
          for (int e = 0; e < 4; ++e) o[e] = pkbf(acc8[2 * e] * inv - (float)zc[2 * e], acc8[2 * e + 1] * inv - (float)zc[2 * e + 1]);
          *(LAS v4u*)(MX + tt * MXS + c8) = (v4u){o[0], o[1], o[2], o[3]}; }
        __syncthreads();
        const int ch0 = wave * 32;
        bf16x8 wP[4][2], wG[4][2];
#pragma unroll
        for (int ks = 0; ks < 4; ++ks)
#pragma unroll
            for (int ct = 0; ct < 2; ++ct) { const int chl = ch0 + ct * 16 + (lane & 15);
                wP[ks][ct] = *(const bf16x8*)(poolWT + ((size_t)g * 256 + chl) * 128 + ks * 32 + 8 * (lane >> 4));
                wG[ks][ct] = *(const bf16x8*)(gw2T + ((size_t)g * 256 + chl) * 128 + ks * 32 + 8 * (lane >> 4)); }
#pragma unroll 1
        for (int tk = 0; tk < TT / 16; ++tk) {
            f32x4 aP[2], aG[2];
            aP[0] = aP[1] = aG[0] = aG[1] = (f32x4){0.f, 0.f, 0.f, 0.f};
            const int tt = tk * 16 + (lane & 15), m = m0t + tt, t = m - ms;
#pragma unroll
            for (int ks = 0; ks < 4; ++ks) {
                const bf16x8 bm = *(const LAS bf16x8*)(MX + tt * MXS + ks * 32 + 8 * (lane >> 4));
                const bf16x8 bg = *(const LAS bf16x8*)(SG + tt * MXS + ks * 32 + 8 * (lane >> 4));
#pragma unroll
                for (int ct = 0; ct < 2; ++ct) { aP[ct] = __builtin_amdgcn_mfma_f32_16x16x32_bf16(wP[ks][ct], bm, aP[ct], 0, 0, 0);
                                                 aG[ct] = __builtin_amdgcn_mfma_f32_16x16x32_bf16(wG[ks][ct], bg, aG[ct], 0, 0, 0); }
            }
            const f16* zr = Z + (size_t)m * NZ; const f16* zp = t > 0 ? zr - NZ : zr; const f16* zn = t < L - 1 ? zr + NZ : zr;
            const float fp = t > 0 ? 0.5f : 0.f, fn = t < L - 1 ? 0.5f : 0.f;
#pragma unroll
            for (int ct = 0; ct < 2; ++ct) { const int c = g * 256 + ch0 + ct * 16 + 4 * (lane >> 4), head = c >> 6;
                const f32x4 lw = *(const f32x4*)(in[23] + c), lb = *(const f32x4*)(in[24] + c), muv = *(const f32x4*)(in[10] + 2 * D + c), psc = *(const f32x4*)(in[26] + c);
                const float rk = RK[tt * 16 + head];
                const f32x4 vz = ld_h4(zr + ZC_V + c), vs = ld_h4(zp + ZC_V + c) * fp + ld_h4(zn + ZC_V + c) * fn; const f32x4 v4 = vz + (vs - vz) * muv;
                const f32x4 ga = ld_h4(zr + ZC_GA + c), gb = ld_h4(zr + ZC_GB + c);
                const f32x4 gg = gb * aG[ct];
                const f32x4 p2 = ga * (aP[ct] * psc) + gg * (lb + v4 * rk), gl = gg * lw;
                v2u w; w.x = pkbf(p2.x, p2.y); w.y = pkbf(p2.z, p2.w); *(v2u*)(P2 + (size_t)m * D + c) = w;
                w.x = pkbf(gl.x, gl.y); w.y = pkbf(gl.z, gl.w); *(v2u*)(GBL + (size_t)m * D + c) = w; }
        }
    }
}
__device__ __forceinline__ void mixA_queue(Frame& F) {
    unsigned* head = (unsigned*)(F.ws + WS_CTL) + CW_TQ;
    volatile LAS unsigned* slot = (volatile LAS unsigned*)(F.lds + MISC_OFF) + 16;
    for (;;) {
        __syncthreads();
        if (F.tid == 0) *slot = __hip_atomic_fetch_add(head, 1u, __ATOMIC_RELAXED, __HIP_MEMORY_SCOPE_AGENT);
        __syncthreads();
        const unsigned tile = *slot;
        if (tile >= (unsigned)NMIXT) break;
        mixA_tile(F, (int)tile);
    }
}
__device__ __forceinline__ void p4_mixB(Frame& F) {
    const int gw = F.bid * NWAVES + F.wave, NGW = F.G * NWAVES;
    const bf16* Y0 = (const bf16*)F.out; const bf16* Y1 = Y0 + (size_t)M * D;
    const bf16* P2 = (const bf16*)(F.ws + WS_P2); const bf16* GBL = (const bf16*)(F.ws + WS_GBL);
    bf16* MIX = (bf16*)(F.ws + WS_H);
    for (int m = gw; m < M; m += NGW) { const size_t o = (size_t)m * D + F.lane * 16;
        float y[16], p[16], gl[16];
#pragma unroll
        for (int q = 0; q < 4; ++q) { const f32x4 a = ld_bf4(Y0 + o + 4 * q) + ld_bf4(Y1 + o + 4 * q), b = ld_bf4(P2 + o + 4 * q), c = ld_bf4(GBL + o + 4 * q);
#pragma unroll
            for (int e = 0; e < 4; ++e) { y[4 * q + e] = a[e]; p[4 * q + e] = b[e]; gl[4 * q + e] = c[e]; } }
        float s1 = 0.f;
#pragma unroll
        for (int e = 0; e < 16; ++e) s1 += y[e];
        s1 += __shfl_xor(s1, 1); s1 += __shfl_xor(s1, 2);
        const float mean = s1 * (1.0f / 64.0f); float s2 = 0.f;
#pragma unroll
        for (int e = 0; e < 16; ++e) { y[e] -= mean; s2 += y[e] * y[e]; }
        s2 += __shfl_xor(s2, 1); s2 += __shfl_xor(s2, 2);
        const float rstd = rsqrtf(s2 * (1.0f / 64.0f) + 64e-5f);
        unsigned w[8];
#pragma unroll
        for (int e = 0; e < 8; ++e) w[e] = pkbf(p[2 * e] + gl[2 * e] * (y[2 * e] * rstd), p[2 * e + 1] + gl[2 * e + 1] * (y[2 * e + 1] * rstd));
        *(v4u*)(MIX + o) = (v4u){w[0], w[1], w[2], w[3]}; *(v4u*)(MIX + o + 8) = (v4u){w[4], w[5], w[6], w[7]}; }
}

__device__ __forceinline__ void p8_final(Frame& F) {
    const int gw = F.bid * NWAVES + F.wave, NGW = F.G * NWAVES;
    const float* rss = (const float*)(F.ws + WS_RSS2); const float* gf = F.in[30];
    for (int m = gw; m < M; m += NGW) { const float rstd = rsqrtf(rss[m] * (1.0f / D) + 1e-6f); float* row = F.out + (size_t)m * D;
#pragma unroll
        for (int j = 0; j < 4; ++j) { const int c = 4 * (F.lane + 64 * j); const f32x4 x = *(const f32x4*)(row + c), g = *(const f32x4*)(gf + c); *(f32x4*)(row + c) = x * rstd * g; } }
}

__global__ void __launch_bounds__(NWAVES * 64, 2) fwd(Args args) {
    extern __shared__ __attribute__((aligned(16))) unsigned char lds_raw[];
    Frame F;
    F.lds = (LAS unsigned char*)lds_raw;
    F.tid = threadIdx.x; F.lane = F.tid & 63; F.wave = __builtin_amdgcn_readfirstlane(F.tid >> 6);
    F.G = gridDim.x; F.bid = blockIdx.x;
    F.in = args.in; F.out = args.out; F.ws = args.ws;
    volatile LAS unsigned* MISC = (volatile LAS unsigned*)(F.lds + MISC_OFF);
    if (F.tid < 32) MISC[F.tid] = 0u;
    __syncthreads();
    const int lo = args.ph_lo, hi = args.ph_hi;
    unsigned* ctl = (unsigned*)(F.ws + WS_CTL);
    XcdBarrier bar; bar.bar = ctl + CW_BAR; bar.x = 0; bar.st = nullptr;
    if (hi - lo > 1) bar = xcd_barrier_post(ctl + CW_BAR, MISC + 8);
#ifndef PH_MASK
#define PH_MASK 0x1ff
#endif
#ifndef REPEAT_MASK
#define REPEAT_MASK 0
#endif
#define REP(k) (((REPEAT_MASK >> (k)) & 1) ? 2 : 1)
#define IN(k) (((PH_MASK >> (k)) & 1) && lo <= (k) && (k) < hi)
#define BOTH(k) (IN(k) && IN((k) + 1))
#define GRID_BAR() xcd_barrier(bar)
    bf16* H = (bf16*)(F.ws + WS_H);
    float* mod = (float*)(F.ws + WS_MOD);
    if (IN(0)) { for (int rep = 0; rep < REP(0); ++rep) p0_prologue(F); if (BOTH(0)) GRID_BAR(); }
    if (IN(1)) { for (int rep = 0; rep < REP(1); ++rep) p1_hprep(F); if (BOTH(1)) GRID_BAR(); }
    if (IN(2)) {
        pg8::Gemm g{H, (const bf16*)(F.ws + WS_WCAT), M, NZ, D}; pg8::StaticOrder S; S.init(M, NZ, F.G, F.bid);
        EpiZ E{(f16*)(F.ws + WS_Z)};
        for (int rep = 0; rep < REP(2); ++rep) pg8::gemm_phase<EpiZ, pg8::StaticOrder, true, true>(F.lds, g, S, E);
        if (BOTH(2)) GRID_BAR();
    }
    if (IN(3)) { for (int rep = 0; rep < REP(3); ++rep) p3_scan2(F); mixA_queue(F); if (BOTH(3)) GRID_BAR(); }
    if (IN(4)) { for (int rep = 0; rep < REP(4); ++rep) p4_mixB(F); if (BOTH(4)) GRID_BAR(); }
    if (IN(5)) {
        pg8::Gemm g{H, (const bf16*)(F.ws + WS_WOUT), M, D, D}; pg8::StaticOrder S; S.init(M, D, F.G, F.bid);
        EpiOut1 E{args.in[0], args.in[1], F.out, (bf16*)(F.ws + WS_A2), mod, args.in[8], (float*)(F.ws + WS_RSS1)};
        pg8::gemm_phase<EpiOut1, pg8::StaticOrder, true, true>(F.lds, g, S, E);
        if (BOTH(5)) GRID_BAR();
    }
    if (IN(6)) {
        pg8::Gemm g{(const bf16*)(F.ws + WS_A2), (const bf16*)(F.ws + WS_WFF1), M, FF, D}; pg8::StaticOrder S; S.init(M, FF, F.G, F.bid);
        EpiFF1 E{(const float*)(F.ws + WS_RSS1), (const float*)(F.ws + WS_C1), (bf16*)(F.ws + WS_ACT)};
        for (int rep = 0; rep < REP(6); ++rep) pg8::gemm_phase<EpiFF1, pg8::StaticOrder, true, true>(F.lds, g, S, E);
        if (BOTH(6)) GRID_BAR();
    }
    if (IN(7)) {
        pg8::Gemm g{(const bf16*)(F.ws + WS_ACT), (const bf16*)(F.ws + WS_WFF2), M, D, FF}; pg8::StaticOrder S; S.init(M, D, F.G, F.bid);
        EpiOut2 E{F.out, mod, (float*)(F.ws + WS_RSS2)};
        pg8::gemm_phase<EpiOut2, pg8::StaticOrder, true, true>(F.lds, g, S, E);
        if (BOTH(7)) GRID_BAR();
    }
    if (IN(8)) { p8_final(F); }
#undef IN
#undef BOTH
#undef GRID_BAR
}

extern "C" void kernel_launch(void* const* d_in, const int* in_sizes, int n_in, void* d_out, int out_size, void* d_ws, size_t ws_size, hipStream_t stream) {
    static int grid = 0;
    if (grid == 0) {
        if (n_in != 31 || ws_size < WS_END) { fprintf(stderr, "kernel_launch: expected 31 inputs and >= %zu bytes of workspace; got %d, %zu\n", (size_t)WS_END, n_in, ws_size); grid = -1; return; }
        int dev = 0, cus = 0, per_cu = 0;
        if (hipGetDevice(&dev) != hipSuccess || hipDeviceGetAttribute(&cus, hipDeviceAttributeMultiprocessorCount, dev) != hipSuccess) { grid = -1; return; }
        if (hipFuncSetAttribute((const void*)fwd, hipFuncAttributeMaxDynamicSharedMemorySize, LDS_BYTES) != hipSuccess) { fprintf(stderr, "kernel_launch: hipFuncSetAttribute failed\n"); grid = -1; return; }
        if (hipOccupancyMaxActiveBlocksPerMultiprocessor(&per_cu, (const void*)fwd, NWAVES * 64, LDS_BYTES) != hipSuccess || per_cu < 1) { fprintf(stderr, "kernel_launch: occupancy query says %d workgroups per CU\n", per_cu); (void)hipGetLastError(); grid = -1; return; }
        grid = cus;
    }
    if (grid < 0) return;
    if (hipMemsetAsync((char*)d_ws + WS_CTL, 0, CTL_ZERO_BYTES, stream) != hipSuccess) return;
    Args a{};
    for (int i = 0; i < 31; ++i) a.in[i] = (const float*)d_in[i];
    a.out = (float*)d_out; a.ws = (unsigned char*)d_ws;
    if (MK_N_LAUNCHES == 1) {
        a.ph_lo = 0; a.ph_hi = NPHASE;
        void* kargs[] = {&a};
        hipError_t e = hipLaunchCooperativeKernel((const void*)fwd, dim3(grid), dim3(NWAVES * 64), kargs, LDS_BYTES, stream);
        if (e != hipSuccess) fprintf(stderr, "kernel_launch: cooperative launch failed: %s (grid %d)\n", hipGetErrorString(e), grid);
    } else {
        for (int p = 0; p < NPHASE; ++p) { a.ph_lo = p; a.ph_hi = p + 1; hipLaunchKernelGGL(fwd, dim3(grid), dim3(NWAVES * 64), LDS_BYTES, stream, a); }
    }
}
```
